# Optimizing an MI355X kernel written in HIP

```python
import jax, jax.numpy as jnp
from jax import lax
import numpy as np

D_MODEL = 1024
BATCH = 32
SEQ = 2048
DEPTH = 1

N_META = 16
GDN_HEADS = 8
GDN_DK = 128
GDN_DV = 128
CONV_WIDTH = 4
CHUNK = 64
SWA_Q_HEADS = 16
SWA_KV_HEADS = 4
SWA_HEAD_DIM = 64
SWA_GROUP = SWA_Q_HEADS // SWA_KV_HEADS
WINDOW = 128
ATTN_BLOCK = 128
N_EXPERTS = 32
TOP_K = 4
D_FF = 1024
SWIGLU_ALPHA = 1.702
SWIGLU_LIMIT = 7.0
MOE_BLOCK = 512
LN_EPS = 1e-5
RMS_EPS = 1e-6
DEEPNORM_ALPHA = (2.0 * DEPTH) ** 0.25
DEEPNORM_BETA = (8.0 * DEPTH) ** -0.25

GDN_QK = GDN_HEADS * GDN_DK
GDN_VD = GDN_HEADS * GDN_DV
SWA_QD = SWA_Q_HEADS * SWA_HEAD_DIM
SWA_KVD = SWA_KV_HEADS * SWA_HEAD_DIM
SPLIT_SIZES = (GDN_QK, GDN_QK, GDN_VD, GDN_VD, GDN_HEADS, GDN_HEADS, SWA_QD, SWA_KVD, SWA_KVD, D_MODEL, D_MODEL)
C_IN = sum(SPLIT_SIZES)
SPLIT_POINTS = tuple(int(p) for p in np.cumsum(SPLIT_SIZES)[:-1])

kernel_name = 'hybrid_gdn_swa_sink_moe_block'


def layer_norm(x, g, b):
    xf = x.astype(jnp.float32)
    mu = jnp.mean(xf, -1, keepdims=True)
    var = jnp.mean(jnp.square(xf - mu), -1, keepdims=True)
    y = (xf - mu) * lax.rsqrt(var + LN_EPS) * g.astype(jnp.float32) + b.astype(jnp.float32)
    return y.astype(x.dtype)


def l2_normalize(t):
    tf = t.astype(jnp.float32)
    return tf * lax.rsqrt(jnp.sum(tf * tf, -1, keepdims=True) + RMS_EPS)


def causal_dwconv_silu(x, w):
    L = x.shape[1]
    xp = jnp.pad(x, ((0, 0), (CONV_WIDTH - 1, 0), (0, 0)))
    y = xp[:, 0:L] * w[:, 0]
    for i in range(1, CONV_WIDTH):
        y = y + xp[:, i:i + L] * w[:, i]
    return jax.nn.silu(y)


def gated_deltanet(q, k, v, z, b, a, conv_w, a_log, dt_bias, norm_w):
    f32 = jnp.float32
    bsz, L, _ = q.shape
    qkv = causal_dwconv_silu(jnp.concatenate([q, k, v], -1), conv_w)
    q, k, v = jnp.split(qkv, [GDN_QK, 2 * GDN_QK], axis=-1)
    q = l2_normalize(q.reshape(bsz, L, GDN_HEADS, GDN_DK)) * GDN_DK ** -0.5
    k = l2_normalize(k.reshape(bsz, L, GDN_HEADS, GDN_DK))
    v = v.reshape(bsz, L, GDN_HEADS, GDN_DV).astype(f32)
    beta = jax.nn.sigmoid(b.astype(f32))
    log_g = -jnp.exp(a_log.astype(f32)) * jax.nn.softplus(a.astype(f32) + dt_bias.astype(f32))
    n_pad = (-N_META) % CHUNK

    def to_chunks(t):
        t = jnp.pad(t, ((0, 0), (n_pad, 0)) + ((0, 0),) * (t.ndim - 2))
        t = t.reshape((bsz, -1, CHUNK) + t.shape[2:])
        return jnp.moveaxis(t, 3, 1)

    qc, kc, vc, bc, gc = [to_chunks(t) for t in (q, k, v, beta, log_g)]
    gam = jnp.cumsum(gc, axis=-1)
    pos = jnp.arange(CHUNK)
    strict = pos[:, None] > pos[None, :]
    incl = pos[:, None] >= pos[None, :]
    decay = jnp.exp(jnp.where(incl, gam[..., :, None] - gam[..., None, :], -jnp.inf))
    kk = jnp.einsum('bhnck,bhnsk->bhncs', kc, kc)
    a_mat = jnp.where(strict, kk * decay, 0.0) * bc[..., :, None]
    eye = jnp.eye(CHUNK, dtype=f32)
    rhs = jnp.concatenate([vc * bc[..., None], kc * (bc * jnp.exp(gam))[..., None]], -1)
    sol = lax.linalg.triangular_solve(a_mat + eye, rhs, left_side=True, lower=True, unit_diagonal=True)
    u_v, w = sol[..., :GDN_DV], sol[..., GDN_DV:]
    qk = jnp.einsum('bhnck,bhnsk->bhncs', qc, kc) * decay
    q_dec = qc * jnp.exp(gam)[..., None]
    k_dec = kc * jnp.exp(gam[..., -1:] - gam)[..., None]
    g_tot = jnp.exp(gam[..., -1])

    def chunk_step(state, inp):
        u_v_c, w_c, qk_c, q_c, k_c, g_c = inp
        u = u_v_c - jnp.einsum('bhck,bhkv->bhcv', w_c, state)
        o = jnp.einsum('bhck,bhkv->bhcv', q_c, state) + jnp.einsum('bhcs,bhsv->bhcv', qk_c, u)
        state = state * g_c[..., None, None] + jnp.einsum('bhck,bhcv->bhkv', k_c, u)
        return state, o

    xs = tuple(jnp.moveaxis(t, 2, 0) for t in (u_v, w, qk, q_dec, k_dec, g_tot))
    state0 = jnp.zeros((bsz, GDN_HEADS, GDN_DK, GDN_DV), f32)
    _, o = lax.scan(chunk_step, state0, xs)
    o = jnp.moveaxis(o, 0, 2).reshape(bsz, GDN_HEADS, -1, GDN_DV).transpose(0, 2, 1, 3)[:, n_pad:]
    o = o * lax.rsqrt(jnp.mean(o * o, -1, keepdims=True) + RMS_EPS) * norm_w.astype(f32)
    o = o * jax.nn.silu(z.reshape(bsz, L, GDN_HEADS, GDN_DV).astype(f32))
    return o.reshape(bsz, L, GDN_VD).astype(z.dtype)


def sliding_window_attention(q, k, v, sinks):
    f32 = jnp.float32
    bsz, L, _ = q.shape
    nb = -(-L // ATTN_BLOCK)
    lp = nb * ATTN_BLOCK
    q = q.reshape(bsz, L, SWA_KV_HEADS, SWA_GROUP, SWA_HEAD_DIM) * SWA_HEAD_DIM ** -0.5
    k = k.reshape(bsz, L, SWA_KV_HEADS, SWA_HEAD_DIM)
    v = v.reshape(bsz, L, SWA_KV_HEADS, SWA_HEAD_DIM)
    k_meta, v_meta = k[:, :N_META], v[:, :N_META]
    qb = jnp.pad(q, ((0, 0), (0, lp - L), (0, 0), (0, 0), (0, 0)))
    qb = jnp.moveaxis(qb.reshape(bsz, nb, ATTN_BLOCK, SWA_KV_HEADS, SWA_GROUP, SWA_HEAD_DIM), 1, 0)

    def band(t):
        tp = jnp.pad(t, ((0, 0), (ATTN_BLOCK, lp - L), (0, 0), (0, 0)))
        tp = tp.reshape(bsz, nb + 1, ATTN_BLOCK, SWA_KV_HEADS, SWA_HEAD_DIM)
        return jnp.moveaxis(jnp.concatenate([tp[:, :-1], tp[:, 1:]], axis=2), 1, 0)

    kb, vb = band(k), band(v)
    slopes = jnp.exp2(-8.0 * jnp.arange(1, SWA_Q_HEADS + 1, dtype=f32) / SWA_Q_HEADS)
    slopes = slopes.reshape(SWA_KV_HEADS, SWA_GROUP)[:, :, None, None]
    sink = sinks.astype(f32).reshape(SWA_KV_HEADS, SWA_GROUP)[:, :, None, None]
    s_meta = jnp.arange(N_META)

    def block_attn(args):
        qi, ki, vi, bidx = args
        t = bidx * ATTN_BLOCK + jnp.arange(ATTN_BLOCK)
        s_band = (bidx - 1) * ATTN_BLOCK + jnp.arange(2 * ATTN_BLOCK)
        d_band = t[:, None] - s_band[None, :]
        d_meta = t[:, None] - s_meta[None, :]
        m_band = (s_band[None, :] >= N_META) & (d_band >= 0) & (d_band < WINDOW)
        m_meta = d_meta >= 0
        sc_band = jnp.einsum('bqhgd,bshd->bhgqs', qi, ki).astype(f32) - slopes * d_band.astype(f32)
        sc_meta = jnp.einsum('bqhgd,bshd->bhgqs', qi, k_meta).astype(f32) - slopes * d_meta.astype(f32)
        sc_band = jnp.where(m_band, sc_band, -jnp.inf)
        sc_meta = jnp.where(m_meta, sc_meta, -jnp.inf)
        sink_col = jnp.broadcast_to(sink, sc_band.shape[:-1] + (1,))
        p = jax.nn.softmax(jnp.concatenate([sc_meta, sc_band, sink_col], -1), axis=-1)
        p_meta = p[..., :N_META].astype(vi.dtype)
        p_band = p[..., N_META:N_META + 2 * ATTN_BLOCK].astype(vi.dtype)
        return (jnp.einsum('bhgqs,bshd->bqhgd', p_meta, v_meta)
                + jnp.einsum('bhgqs,bshd->bqhgd', p_band, vi))

    o = lax.map(block_attn, (qb, kb, vb, jnp.arange(nb)))
    o = jnp.moveaxis(o, 0, 1).reshape(bsz, lp, SWA_QD)[:, :L]
    return o


def moe_ffn(x, w_router, b_router, w1, b1, w2, b2):
    n_tok = x.shape[0]
    logits = (x @ w_router + b_router).astype(jnp.float32)
    top_logit, top_idx = lax.top_k(logits, TOP_K)
    top_w = jax.nn.softmax(top_logit, axis=-1)
    n_asg = n_tok * TOP_K
    flat_e = top_idx.reshape(-1)
    flat_tok = jnp.arange(n_asg, dtype=jnp.int32) // TOP_K
    order = jnp.argsort(flat_e)
    se, st, sw = flat_e[order], flat_tok[order], top_w.reshape(-1)[order]
    counts = jnp.zeros((N_EXPERTS,), jnp.int32).at[flat_e].add(1)
    padded = (counts + MOE_BLOCK - 1) // MOE_BLOCK * MOE_BLOCK
    grp_start = jnp.cumsum(counts) - counts
    pad_end = jnp.cumsum(padded)
    pad_start = pad_end - padded
    dest = pad_start[se] + (jnp.arange(n_asg, dtype=jnp.int32) - grp_start[se])
    n_blk = -(-n_asg // MOE_BLOCK) + N_EXPERTS
    n_rows = n_blk * MOE_BLOCK
    row_tok = jnp.full((n_rows,), n_tok, jnp.int32).at[dest].set(st)
    row_w = jnp.zeros((n_rows,), jnp.float32).at[dest].set(sw)
    x_pad = jnp.concatenate([x, jnp.zeros((1, x.shape[1]), x.dtype)], 0)
    xs = x_pad[row_tok].reshape(n_blk, MOE_BLOCK, x.shape[1])
    blk_e = jnp.minimum(jnp.searchsorted(pad_end, jnp.arange(n_blk) * MOE_BLOCK, side='right'), N_EXPERTS - 1)

    def expert_block(args):
        xb, e = args
        hdn = xb @ w1[e] + b1[e]
        gate, up = hdn[:, :D_FF], hdn[:, D_FF:]
        gate = jnp.minimum(gate, SWIGLU_LIMIT)
        up = jnp.clip(up, -SWIGLU_LIMIT, SWIGLU_LIMIT)
        return (gate * jax.nn.sigmoid(SWIGLU_ALPHA * gate) * (up + 1.0)) @ w2[e] + b2[e]

    ys = lax.map(expert_block, (xs, blk_e)).reshape(n_rows, x.shape[1])
    ys = (ys * row_w[:, None]).astype(x.dtype)
    return jax.ops.segment_sum(ys, row_tok, num_segments=n_tok + 1)[:n_tok]


def setup_inputs(seed: int = 0) -> dict:
    key = jax.random.key(seed)
    ks = jax.random.split(key, 24)
    f32 = jnp.float32
    nrm = lambda k, shape, s: jax.random.normal(k, shape, f32) * s
    dt = jnp.exp(jax.random.uniform(ks[6], (DEPTH, GDN_HEADS), f32, np.log(1e-3), np.log(1e-1)))
    return {
        'x': nrm(ks[0], (BATCH, SEQ, D_MODEL), 1.0),
        'meta_tokens': nrm(ks[1], (N_META, D_MODEL), 1.0),
        'emb_ln_g': 1.0 + nrm(ks[2], (D_MODEL,), 0.02),
        'emb_ln_b': nrm(ks[3], (D_MODEL,), 0.02),
        'w_in': nrm(ks[4], (DEPTH, D_MODEL, C_IN), D_MODEL ** -0.5),
        'conv_w': nrm(ks[5], (DEPTH, 2 * GDN_QK + GDN_VD, CONV_WIDTH), CONV_WIDTH ** -0.5),
        'a_log': jnp.log(jax.random.uniform(ks[7], (DEPTH, GDN_HEADS), f32, 1.0, 16.0)),
        'dt_bias': dt + jnp.log(-jnp.expm1(-dt)),
        'gdn_norm_w': 1.0 + nrm(ks[8], (DEPTH, GDN_DV), 0.02),
        'attn_sinks': nrm(ks[9], (DEPTH, SWA_Q_HEADS), 0.5),
        'w_br_gdn': nrm(ks[10], (DEPTH, GDN_VD, D_MODEL), GDN_VD ** -0.5),
        'w_br_swa': nrm(ks[11], (DEPTH, SWA_QD, D_MODEL), SWA_QD ** -0.5),
        'w_out': nrm(ks[12], (DEPTH, D_MODEL, D_MODEL), D_MODEL ** -0.5 * DEEPNORM_BETA),
        'ln1_g': 1.0 + nrm(ks[13], (DEPTH, D_MODEL), 0.02),
        'ln1_b': nrm(ks[14], (DEPTH, D_MODEL), 0.02),
        'w_router': nrm(ks[15], (DEPTH, D_MODEL, N_EXPERTS), D_MODEL ** -0.5),
        'b_router': nrm(ks[16], (DEPTH, N_EXPERTS), 0.01),
        'w_moe1': nrm(ks[17], (DEPTH, N_EXPERTS, D_MODEL, 2 * D_FF), D_MODEL ** -0.5),
        'b_moe1': nrm(ks[18], (DEPTH, N_EXPERTS, 2 * D_FF), 0.02),
        'w_moe2': nrm(ks[19], (DEPTH, N_EXPERTS, D_FF, D_MODEL), D_FF ** -0.5 * DEEPNORM_BETA),
        'b_moe2': nrm(ks[20], (DEPTH, N_EXPERTS, D_MODEL), 0.02),
        'ln2_g': 1.0 + nrm(ks[21], (DEPTH, D_MODEL), 0.02),
        'ln2_b': nrm(ks[22], (DEPTH, D_MODEL), 0.02),
    }


def reference(x, meta_tokens, emb_ln_g, emb_ln_b, w_in, conv_w, a_log, dt_bias, gdn_norm_w, attn_sinks,
              w_br_gdn, w_br_swa, w_out, ln1_g, ln1_b, w_router, b_router, w_moe1, b_moe1, w_moe2, b_moe2,
              ln2_g, ln2_b):
    bsz = x.shape[0]
    meta = jnp.broadcast_to(meta_tokens[None].astype(x.dtype), (bsz, N_META, D_MODEL))
    h = layer_norm(jnp.concatenate([meta, x], axis=1), emb_ln_g, emb_ln_b)
    for l in range(DEPTH):
        proj = h @ w_in[l]
        q_g, k_g, v_g, z_g, b_g, a_g, q_s, k_s, v_s, gate_g, gate_s = jnp.split(proj, SPLIT_POINTS, axis=-1)
        y_gdn = gated_deltanet(q_g, k_g, v_g, z_g, b_g, a_g, conv_w[l], a_log[l], dt_bias[l], gdn_norm_w[l]) @ w_br_gdn[l]
        y_swa = sliding_window_attention(q_s, k_s, v_s, attn_sinks[l]) @ w_br_swa[l]
        mixed = (jax.nn.sigmoid(gate_g) * y_gdn + jax.nn.sigmoid(gate_s) * y_swa) @ w_out[l]
        h = layer_norm(DEEPNORM_ALPHA * h + mixed, ln1_g[l], ln1_b[l])
        if l == DEPTH - 1:
            h = h[:, N_META:]
        n_pos = h.shape[1]
        ffn = moe_ffn(h.reshape(-1, D_MODEL), w_router[l], b_router[l], w_moe1[l], b_moe1[l],
                      w_moe2[l], b_moe2[l]).reshape(bsz, n_pos, D_MODEL)
        h = layer_norm(DEEPNORM_ALPHA * h + ffn, ln2_g[l], ln2_b[l])
    return h
```

```cpp
#include <hip/hip_runtime.h>
#include <cstdio>
#include <cstdint>
#ifndef MK_SINGLE
#define MK_SINGLE 0
#endif
namespace pg8 {
#define PG8_LAS __attribute__((address_space(3)))
typedef unsigned short bf16_t;
typedef short bf16x8 __attribute__((ext_vector_type(8)));
typedef float f32x4 __attribute__((ext_vector_type(4)));
typedef unsigned u32x4 __attribute__((ext_vector_type(4)));
typedef unsigned u32x2 __attribute__((ext_vector_type(2)));
constexpr int BM = 256, BK = 64, HALF = 128, HTB = HALF * BK * 2  , STAGE_BYTES = 8 * HTB, NXCD = 8, WGM = 8;
__host__ __device__ __forceinline__ int lds_byte(int r, int c) { const int st = (r >> 4) * 2 + (c >> 5), rr = r & 15, cc = c & 31, ob = rr * 64 + cc * 2; return st * 1024 + (ob ^ (((ob >> 9) & 1) << 5)); }
__host__ __device__ __forceinline__ void stage_rc(int b, int& R, int& C) { const int st = b / 1024, sb = b % 1024, swz = sb ^ (((sb >> 9) & 1) << 5); R = (st >> 1) * 16 + swz / 64; C = (st & 1) * 32 + (swz % 64) / 2; }
__host__ __device__ __forceinline__ int perm32(int rho) { const int n = rho >> 4, i = rho & 15; return 8 * (i >> 2) + 4 * n + (i & 3); }
struct Unit { int pm, pn, e, kind; const char* A; const char* B; };
__device__ __forceinline__ unsigned cvt_pk_bf16(float lo, float hi) { unsigned r; asm volatile("v_cvt_pk_bf16_f32 %0, %1, %2" : "=v"(r) : "v"(lo), "v"(hi)); return r; }
template <class Epi, class Sched, bool ALIGN_EPI = false, bool SP2 = false>
__device__ __forceinline__ void gemm_phase(PG8_LAS unsigned char* lds, const int K, const Sched& S, const Epi& E) {
    int tid_ = threadIdx.x; asm volatile("" : "+v"(tid_));
    const int tid = tid_, wid = __builtin_amdgcn_readfirstlane(tid >> 6), lane = tid & 63, wr = wid >> 2, wc = wid & 3, fr = lane & 15, fq = lane >> 4;
    const int nt = K / BK;
    unsigned voffA[2], voffB[2];
#pragma unroll
    for (int i = 0; i < 2; ++i) { int R, C; stage_rc(tid * 16 + i * 8192, R, C); const int Rb = Epi::PERM ? ((R & ~31) + perm32(R & 31)) : R;
        voffA[i] = (unsigned)(R * K + C) * 2u; voffB[i] = (unsigned)(Rb * K + C) * 2u; }
    const size_t kstep = (size_t)(BK * 2);
    const size_t hstep = (size_t)HALF * K * 2;
    const size_t tstep = 2 * hstep;
    const unsigned ldsw = (unsigned)wid * 1024u;
    const int aoff = lds_byte(wr * 64 + fr, fq * 8), boff = lds_byte(wc * 32 + fr, fq * 8);
#define PG8_SA(b, h) (((b) * 2 + (h)) * HTB)
#define PG8_SB(b, h) ((4 + (b) * 2 + (h)) * HTB)
#define PG8_STAGE(bufoff, gbase, voff) do { _Pragma("unroll") for (int _i = 0; _i < 2; ++_i) \
        __builtin_amdgcn_global_load_lds((const unsigned*)((const char*)(gbase) + (voff)[_i]), (PG8_LAS unsigned*)(lds + (bufoff) + ldsw + _i * 8192), 16, 0, 0); } while (0)
#define PG8_LDA(dst, b, h) do { _Pragma("unroll") for (int m = 0; m < 4; ++m) _Pragma("unroll") for (int k = 0; k < 2; ++k) dst[m][k] = *(const PG8_LAS bf16x8*)(lds + PG8_SA(b, h) + aoff + m * 2048 + k * 1024); } while (0)
#define PG8_LDB(dst, b, h) do { _Pragma("unroll") for (int n = 0; n < 2; ++n) _Pragma("unroll") for (int k = 0; k < 2; ++k) dst[n][k] = *(const PG8_LAS bf16x8*)(lds + PG8_SB(b, h) + boff + n * 2048 + k * 1024); } while (0)
#define PG8_MMA(ai, bj, At, Bt) do { __builtin_amdgcn_s_setprio(1); _Pragma("unroll") for (int m = 0; m < 4; ++m) _Pragma("unroll") for (int n = 0; n < 2; ++n) _Pragma("unroll") for (int k = 0; k < 2; ++k) \
        acc[ai][bj][m][n] = __builtin_amdgcn_mfma_f32_16x16x32_bf16(Bt[n][k], At[m][k], acc[ai][bj][m][n], 0, 0, 0); __builtin_amdgcn_s_setprio(0); } while (0)
#define PG8_WAIT_V(n) asm volatile("s_waitcnt vmcnt(" #n ")" ::: "memory")
#define PG8_WAIT_L(n) asm volatile("s_waitcnt lgkmcnt(" #n ")" ::: "memory")
#define PG8_BAR __builtin_amdgcn_s_barrier()
#define PG8_SCHED __builtin_amdgcn_sched_barrier(0)
    Unit cur, nxt; int ui = 0;
    if (!S.next(0, cur)) return;
    f32x4 acc[2][2][4][2];
#pragma unroll
    for (int a = 0; a < 2; ++a)
#pragma unroll
        for (int b = 0; b < 2; ++b)
#pragma unroll
            for (int m = 0; m < 4; ++m)
#pragma unroll
                for (int n = 0; n < 2; ++n) acc[a][b][m][n] = (f32x4){0.f, 0.f, 0.f, 0.f};
    bf16x8 At[4][2], B0[2][2], B1[2][2];
    const char* cA = cur.A; const char* cB = cur.B;
    S.a_ready(cur);
    if constexpr (SP2) {
        PG8_STAGE(PG8_SB(0, 0), cB, voffB); PG8_STAGE(PG8_SB(0, 1), cB + hstep, voffB); PG8_STAGE(PG8_SA(0, 0), cA, voffA); PG8_STAGE(PG8_SA(0, 1), cA + hstep, voffA);
        if (wr == 1) PG8_BAR;
        PG8_WAIT_V(2); PG8_BAR;
        PG8_STAGE(PG8_SB(1, 0), cB + kstep, voffB); PG8_STAGE(PG8_SA(1, 0), cA + kstep, voffA); PG8_STAGE(PG8_SB(1, 1), cB + hstep + kstep, voffB);
        PG8_WAIT_V(6); PG8_BAR;
    } else {
        PG8_STAGE(PG8_SB(0, 0), cB, voffB); PG8_STAGE(PG8_SA(0, 0), cA, voffA); PG8_STAGE(PG8_SB(0, 1), cB + hstep, voffB); PG8_STAGE(PG8_SA(0, 1), cA + hstep, voffA);
        if (wr == 1) PG8_BAR;
        PG8_WAIT_V(4); PG8_BAR;
        PG8_STAGE(PG8_SB(1, 0), cB + kstep, voffB); PG8_STAGE(PG8_SA(1, 0), cA + kstep, voffA); PG8_STAGE(PG8_SB(1, 1), cB + hstep + kstep, voffB);
        PG8_WAIT_V(6); PG8_BAR;
    }
    for (;;) {
        const bool has_next = S.next(ui + 1, nxt);
        const char* nA = has_next ? nxt.A : cA; const char* nB = has_next ? nxt.B : cB;
        for (int t = 0; t < nt; t += 2) {
            const bool last = (t == nt - 2);
            const char* a1 = cA + (size_t)(t + 1) * kstep;
            const char* a2 = last ? nA : cA + (size_t)(t + 2) * kstep; const char* b2 = last ? nB : cB + (size_t)(t + 2) * kstep;
            const char* a3 = a2 + kstep; const char* b3 = b2 + kstep;
            if (last && has_next) S.a_ready(nxt);
            if constexpr (SP2) {
            PG8_LDB(B0, 0, 0); PG8_LDB(B1, 0, 1); PG8_SCHED; PG8_LDA(At, 0, 0); PG8_STAGE(PG8_SA(1, 1), a1 + hstep, voffA);
            PG8_WAIT_V(8); PG8_WAIT_L(0); PG8_BAR; PG8_MMA(0, 0, At, B0); PG8_MMA(0, 1, At, B1); PG8_BAR; PG8_SCHED;
            PG8_LDA(At, 0, 1); PG8_STAGE(PG8_SB(0, 0), b2, voffB); PG8_STAGE(PG8_SB(0, 1), b2 + hstep, voffB); PG8_STAGE(PG8_SA(0, 0), a2, voffA);
            PG8_WAIT_V(8); PG8_WAIT_L(0); PG8_BAR; PG8_MMA(1, 0, At, B0); PG8_MMA(1, 1, At, B1); PG8_BAR; PG8_SCHED;
            PG8_LDB(B0, 1, 0); PG8_LDB(B1, 1, 1); PG8_SCHED; PG8_LDA(At, 1, 0); PG8_STAGE(PG8_SA(0, 1), a2 + hstep, voffA);
            PG8_WAIT_V(8); PG8_WAIT_L(0); PG8_BAR; PG8_MMA(0, 0, At, B0); PG8_MMA(0, 1, At, B1); PG8_BAR; PG8_SCHED;
            PG8_LDA(At, 1, 1); PG8_STAGE(PG8_SB(1, 0), b3, voffB); PG8_STAGE(PG8_SB(1, 1), b3 + hstep, voffB); PG8_STAGE(PG8_SA(1, 0), a3, voffA);
            PG8_WAIT_V(8); PG8_WAIT_L(0); PG8_BAR; PG8_MMA(1, 0, At, B0); PG8_MMA(1, 1, At, B1); PG8_BAR; PG8_SCHED;
            } else {
            PG8_LDB(B0, 0, 0); PG8_SCHED; PG8_LDA(At, 0, 0); PG8_STAGE(PG8_SA(1, 1), a1 + hstep, voffA);
            PG8_WAIT_L(8); PG8_BAR; PG8_WAIT_L(0); PG8_MMA(0, 0, At, B0); PG8_BAR; PG8_SCHED;
            PG8_LDB(B1, 0, 1); PG8_STAGE(PG8_SB(0, 0), b2, voffB);
            PG8_BAR; PG8_WAIT_L(0); PG8_MMA(0, 1, At, B1); PG8_BAR;
            PG8_LDA(At, 0, 1); PG8_STAGE(PG8_SA(0, 0), a2, voffA);
            PG8_BAR; PG8_WAIT_L(0); PG8_MMA(1, 0, At, B0); PG8_BAR; PG8_SCHED;
            PG8_STAGE(PG8_SB(0, 1), b2 + hstep, voffB);
            PG8_WAIT_V(6); PG8_BAR; PG8_MMA(1, 1, At, B1); PG8_BAR;
            PG8_LDB(B0, 1, 0); PG8_SCHED; PG8_LDA(At, 1, 0); PG8_STAGE(PG8_SA(0, 1), a2 + hstep, voffA);
            PG8_WAIT_L(8); PG8_BAR; PG8_WAIT_L(0); PG8_MMA(0, 0, At, B0); PG8_BAR; PG8_SCHED;
            PG8_LDB(B1, 1, 1); PG8_STAGE(PG8_SB(1, 0), b3, voffB);
            PG8_BAR; PG8_WAIT_L(0); PG8_MMA(0, 1, At, B1); PG8_BAR;
            PG8_LDA(At, 1, 1); PG8_STAGE(PG8_SA(1, 0), a3, voffA);
            PG8_BAR; PG8_WAIT_L(0); PG8_MMA(1, 0, At, B0); PG8_BAR; PG8_SCHED;
            PG8_STAGE(PG8_SB(1, 1), b3 + hstep, voffB);
            PG8_WAIT_V(6); PG8_BAR; PG8_MMA(1, 1, At, B1); PG8_BAR;
            }
        }
        if constexpr (ALIGN_EPI) { if (wr == 0) PG8_BAR; }
        if constexpr (!Epi::AFTER_DRAIN) { E(acc, cur, wr, wc, fr, fq); S.done(cur); }
        if (!has_next) break;
#pragma unroll
        for (int a = 0; a < 2; ++a)
#pragma unroll
            for (int b = 0; b < 2; ++b)
#pragma unroll
                for (int m = 0; m < 4; ++m)
#pragma unroll
                    for (int n = 0; n < 2; ++n) acc[a][b][m][n] = (f32x4){0.f, 0.f, 0.f, 0.f};
        cur = nxt; cA = nA; cB = nB; ++ui;
        if constexpr (ALIGN_EPI) { if (wr == 1) PG8_BAR; }
    }
    PG8_WAIT_V(0);
    if constexpr (!ALIGN_EPI) { if (wr == 0) PG8_BAR; }
    PG8_BAR;
    if constexpr (Epi::AFTER_DRAIN) { E.fused(acc, cur, wr, wc, fr, fq, lds, wid, lane); S.done(cur); }
#undef PG8_SA
#undef PG8_SB
#undef PG8_STAGE
#undef PG8_LDA
#undef PG8_LDB
#undef PG8_MMA
#undef PG8_WAIT_V
#undef PG8_WAIT_L
#undef PG8_BAR
#undef PG8_SCHED
}
}

constexpr int D = 1024, BATCH = 32, SEQ = 2048, NMETA = 16, CIN = 7696;
constexpr int NB = 8, NG = BATCH / NB, TOK = NB * SEQ;
constexpr int C_QG = 0, C_KG = 1024, C_VG = 2048, C_ZG = 3072, C_BG = 4096, C_AG = 4104, C_QS = 4112, C_KS = 5136, C_VS = 5392, C_GG = 5648, C_GS = 6672;
constexpr int N1 = 7680;
constexpr int NEXP = 32, TOPK = 4, DFF = 1024, NHG = 8, NHQ = 16, NHK = 4;
constexpr int NASG = TOK * TOPK, MAXROWS = NASG + NEXP * 256, MAXTILES = MAXROWS / 256;
constexpr float LN_EPS = 1e-5f, RMS_EPS = 1e-6f;
constexpr float DN_ALPHA = 1.189207115002721f;
constexpr int NWAVES = 8, NTHR = 512;
constexpr size_t MiB = 1u << 20;
constexpr size_t WS_CTL = 0, CTL_ZERO_BYTES = 64 * 1024;
constexpr size_t WS_PM = 1 * MiB, WS_S1 = 2 * MiB, WS_WIN = 3 * MiB, WS_WBG = 18 * MiB, WS_WBS = 20 * MiB, WS_WOUT = 22 * MiB, WS_W1 = 24 * MiB, WS_W2 = 152 * MiB;
constexpr size_t WS_H1 = 216 * MiB, WS_TOPI = 248 * MiB, WS_TOPW = WS_TOPI + 256 * 1024, WS_RANK = WS_TOPW + 256 * 1024, WS_SLOT = WS_RANK + 256 * 1024;
constexpr size_t WS_ROWW = 249 * MiB, WS_BETA = 250 * MiB, WS_LOGG = WS_BETA + 512 * 1024;
constexpr size_t GR = 252 * MiB;
constexpr size_t WS_H0 = GR, WS_QKVG = GR + 32 * MiB, WS_ZS = GR + 128 * MiB, WS_QS = GR + 160 * MiB, WS_KS = GR + 192 * MiB, WS_VS = GR + 200 * MiB;
constexpr size_t WS_SG = GR + 208 * MiB, WS_SS = GR + 240 * MiB, WS_OG = GR + 272 * MiB, WS_OSW = GR + 304 * MiB, WS_Y = GR + 336 * MiB, WS_PRE1 = GR + 368 * MiB;
constexpr size_t WS_XS = GR, WS_HID = GR + 144 * MiB, WS_YS = GR + 288 * MiB;
constexpr size_t WS_END = GR + 576 * MiB;
static_assert((size_t)MAXROWS * 2048 == 144 * MiB, "moe row buffers");
constexpr int CW_TMO = 0, CW_BAR = 4096, CW_CNT = 8192;
constexpr int RING_BYTES = 131072, MISC_OFF = RING_BYTES, LDS_BYTES = 147456;
constexpr int MI_OFF = 16, MI_TE = 64;

#define GAS __attribute__((address_space(1)))
#define LAS __attribute__((address_space(3)))
typedef unsigned short bf16_t;
typedef float f32x4 __attribute__((ext_vector_type(4)));
typedef float f32x2 __attribute__((ext_vector_type(2)));
typedef unsigned u32x4 __attribute__((ext_vector_type(4)));
typedef unsigned u32x2 __attribute__((ext_vector_type(2)));
#define LDS_WAIT() asm volatile("s_waitcnt lgkmcnt(0)" ::: "memory")
#define VM_WAIT() asm volatile("s_waitcnt vmcnt(0)" ::: "memory")
__device__ __forceinline__ unsigned f2bf(float f) { unsigned u = __builtin_bit_cast(unsigned, f); return (u + 0x7fffu + ((u >> 16) & 1u)) >> 16; }
__device__ __forceinline__ unsigned pk2(float lo, float hi) { return f2bf(lo) | (f2bf(hi) << 16); }
__device__ __forceinline__ float bflo(unsigned w) { return __builtin_bit_cast(float, w << 16); }
__device__ __forceinline__ float bfhi(unsigned w) { return __builtin_bit_cast(float, w & 0xffff0000u); }
__device__ __forceinline__ float bf1(bf16_t h) { return __builtin_bit_cast(float, (unsigned)h << 16); }
__device__ __forceinline__ float fexp(float x) { return __builtin_amdgcn_exp2f(x * 1.4426950408889634f); }
__device__ __forceinline__ float frcp(float x) { return __builtin_amdgcn_rcpf(x); }
__device__ __forceinline__ float frsq(float x) { return __builtin_amdgcn_rsqf(x); }
__device__ __forceinline__ float sigmoidf_(float x) { return frcp(1.0f + fexp(-x)); }
__device__ __forceinline__ float siluf_(float x) { return x * frcp(1.0f + fexp(-x)); }
__device__ __forceinline__ float softplusf_(float x) { const float e = fexp(-fabsf(x)); const float l = e < 1e-3f ? e * (1.0f - 0.5f * e) : __builtin_amdgcn_logf(1.0f + e) * 0.6931471805599453f; return fmaxf(x, 0.f) + l; }
__device__ __forceinline__ float wave_sum(float v) {
#pragma unroll
    for (int o = 1; o < 64; o <<= 1) v += __shfl_xor(v, o);
    return v;
}

#define XB_TMO      128
#define XB_XCNT(j)  (256  + 64 * (j))
#define XB_XSUB(j)  (1280 + 64 * (j))
#define XB_XGEN(j)  (2304 + 64 * (j))
#define XB_TOP      3328
#define XB_TOPGEN   3392
#define XCD_BAR_WORDS 3456
#define XB_SPIN_CAP (1u << 18)
__device__ __forceinline__ unsigned xb_ld(unsigned* p)              { return __hip_atomic_load(p, __ATOMIC_RELAXED, __HIP_MEMORY_SCOPE_AGENT); }
__device__ __forceinline__ unsigned xb_add(unsigned* p, unsigned v) { return __hip_atomic_fetch_add(p, v, __ATOMIC_RELAXED, __HIP_MEMORY_SCOPE_AGENT); }
__device__ __forceinline__ unsigned xb_xcc_id() { return (unsigned)__builtin_amdgcn_s_getreg((3 << 11) | 20) & 0xFu; }
#define XB_SPIN(cond, bar) do { unsigned _sp = 0; while (cond) { __builtin_amdgcn_s_sleep(1); \
    if ((++_sp & 255u) == 0u) { if (xb_ld(&(bar)[XB_TMO])) break; if (_sp > XB_SPIN_CAP) { atomicAdd(&(bar)[XB_TMO], 1u); break; } } } } while (0)
struct XcdBarrier { unsigned* bar; unsigned x; volatile LAS unsigned* st; };
__device__ __forceinline__ XcdBarrier xcd_barrier_post(unsigned* bar, volatile LAS unsigned* st) {
    XcdBarrier b; b.bar = bar; b.x = xb_xcc_id(); b.st = st;
    if (threadIdx.x == 0) (void)xb_add(&bar[XB_XCNT(b.x)], 1u);
    return b;
}
__device__ __forceinline__ void xcd_barrier_complete(unsigned* bar, unsigned x, unsigned& nloc, unsigned& nx) {
    const unsigned G = gridDim.x * gridDim.y * gridDim.z;
    unsigned sum, cnt, mine, sp = 0u;
    for (;;) {
        sum = 0u; cnt = 0u; mine = 0u;
#pragma unroll
        for (unsigned j = 0; j < 16; ++j) { const unsigned c = xb_ld(&bar[XB_XCNT(j)]); sum += c; cnt += (c > 0u) ? 1u : 0u; mine = (j == x) ? c : mine; }
        if (sum == G) break;
        __builtin_amdgcn_s_sleep(1);
        if ((++sp & 255u) == 0u) { if (xb_ld(&bar[XB_TMO])) break; if (sp > XB_SPIN_CAP) { atomicAdd(&bar[XB_TMO], 1u); break; } }
    }
    nloc = mine > 0u ? mine : 1u; nx = cnt > 0u ? cnt : 1u;
}
__device__ __forceinline__ void xcd_barrier(const XcdBarrier& b) {
    asm volatile("s_waitcnt vmcnt(0)" ::: "memory");
    __syncthreads();
    if (threadIdx.x == 0) {
        unsigned* bar = b.bar;
        __builtin_amdgcn_s_waitcnt(0);
        unsigned nloc = b.st[0], nx = b.st[1];
        if (nloc == 0u) { xcd_barrier_complete(bar, b.x, nloc, nx); b.st[0] = nloc; b.st[1] = nx; }
        const unsigned old = xb_add(&bar[XB_XSUB(b.x)], 1u);
        const unsigned gen = old / nloc;
        if (old + 1u == (gen + 1u) * nloc) {
            __builtin_amdgcn_fence(__ATOMIC_RELEASE, "agent");
            asm volatile("s_waitcnt vmcnt(0)" ::: "memory");
            const unsigned og = xb_add(&bar[XB_TOP], 1u);
            const unsigned tg = og / nx;
            if (og + 1u == (tg + 1u) * nx) xb_add(&bar[XB_TOPGEN], 1u);
            else XB_SPIN(xb_ld(&bar[XB_TOPGEN]) == tg, bar);
            __builtin_amdgcn_fence(__ATOMIC_ACQUIRE, "agent");
            xb_add(&bar[XB_XGEN(b.x)], 1u);
            asm volatile("s_waitcnt vmcnt(0)" ::: "memory");
        } else {
            XB_SPIN(xb_ld(&bar[XB_XGEN(b.x)]) == gen, bar);
            __builtin_amdgcn_fence(__ATOMIC_ACQUIRE, "agent");
            asm volatile("s_waitcnt vmcnt(0)" ::: "memory");
        }
    }
    __syncthreads();
}

struct P { const float* in[23]; float* out; unsigned char* ws; int ph_lo, ph_hi; };
enum { I_X = 0, I_META, I_ELG, I_ELB, I_WIN, I_CONVW, I_ALOG, I_DTB, I_GNW, I_SINK, I_WBG, I_WBS, I_WOUT, I_L1G, I_L1B, I_WR, I_BR, I_W1, I_B1, I_W2, I_B2, I_L2G, I_L2B };

__device__ __forceinline__ void std_tile(int L, int nwg, int nM, int nN, int& pm, int& pn) {
    int wgid = L; { const int q = nwg / pg8::NXCD, r = nwg % pg8::NXCD, xcd = wgid % pg8::NXCD, off = wgid / pg8::NXCD; wgid = (xcd < r ? xcd * (q + 1) : r * (q + 1) + (xcd - r) * q) + off; }
    const int nig = pg8::WGM * nN, gid = wgid / nig, fm = gid * pg8::WGM, gsz = (nM - fm) < pg8::WGM ? (nM - fm) : pg8::WGM;
    pm = fm + ((wgid % nig) % gsz); pn = (wgid % nig) / gsz;
}
struct SchedStd {
    int nM, nN, nwg, G, c; const char* A; const char* B; size_t tstep;
    __device__ __forceinline__ void init(int M, int N, int K, int G_, int c_, const void* A_, const void* B_) { nM = M / 256; nN = N / 256; nwg = nM * nN; G = G_; c = c_; A = (const char*)A_; B = (const char*)B_; tstep = (size_t)256 * K * 2; }
    __device__ __forceinline__ bool next(int i, pg8::Unit& u) const {
        const int L = i * G + c; if (L >= nwg) return false;
        int pm, pn; std_tile(L, nwg, nM, nN, pm, pn);
        u.pm = pm; u.pn = pn; u.e = 0; u.kind = 0; u.A = A + (size_t)pm * tstep; u.B = B + (size_t)pn * tstep; return true;
    }
    __device__ __forceinline__ void a_ready(const pg8::Unit&) const {}
    __device__ __forceinline__ void done(const pg8::Unit&) const {}
};
struct SchedPair {
    int nM, nN, nwg, G, c; const char *A0, *B0, *A1, *B1; size_t tstep;
    __device__ __forceinline__ void init(int M, int N, int K, int G_, int c_, const void* A0_, const void* B0_, const void* A1_, const void* B1_) { nM = M / 256; nN = N / 256; nwg = nM * nN; G = G_; c = c_;
        A0 = (const char*)A0_; B0 = (const char*)B0_; A1 = (const char*)A1_; B1 = (const char*)B1_; tstep = (size_t)256 * K * 2; }
    __device__ __forceinline__ bool next(int i, pg8::Unit& u) const {
        const int L = (i >> 1) * G + c, kind = i & 1; if (L >= nwg) return false;
        int pm, pn; std_tile(L, nwg, nM, nN, pm, pn);
        u.pm = pm; u.pn = pn; u.e = 0; u.kind = kind; u.A = (kind ? A1 : A0) + (size_t)pm * tstep; u.B = (kind ? B1 : B0) + (size_t)pn * tstep; return true;
    }
    __device__ __forceinline__ void a_ready(const pg8::Unit&) const {}
    __device__ __forceinline__ void done(const pg8::Unit&) const {}
};
struct SchedMoe {
    int nN, nwg, G, c; const char* A; const char* W; size_t tstep, wexp; const volatile LAS unsigned* te;
    __device__ __forceinline__ void init(int ntiles, int N, int K, int G_, int c_, const void* A_, const void* W_, const volatile LAS unsigned* te_) { nN = N / 256; nwg = ntiles * nN; G = G_; c = c_;
        A = (const char*)A_; W = (const char*)W_; tstep = (size_t)256 * K * 2; wexp = (size_t)N * K * 2; te = te_; }
    __device__ __forceinline__ bool next(int i, pg8::Unit& u) const {
        const int L = i * G + c; if (L >= nwg) return false;
        const int rt = L / nN, pn = L - rt * nN; const int e = __builtin_amdgcn_readfirstlane((int)te[rt]);
        u.pm = rt; u.pn = pn; u.e = e; u.kind = 0; u.A = A + (size_t)rt * tstep; u.B = W + (size_t)e * wexp + (size_t)pn * tstep; return true;
    }
    __device__ __forceinline__ void a_ready(const pg8::Unit&) const {}
    __device__ __forceinline__ void done(const pg8::Unit&) const {}
};

using pg8::Unit;
typedef pg8::f32x4 (AccT)[2][2][4][2];
__device__ __forceinline__ u32x4 pack8(f32x4 v0, f32x4 v1) { u32x4 w; w.x = pg8::cvt_pk_bf16(v0[0], v0[1]); w.y = pg8::cvt_pk_bf16(v0[2], v0[3]); w.z = pg8::cvt_pk_bf16(v1[0], v1[1]); w.w = pg8::cvt_pk_bf16(v1[2], v1[3]); return w; }
__device__ __forceinline__ void unpack8(u32x4 w, f32x4& v0, f32x4& v1) { v0 = (f32x4){bflo(w.x), bfhi(w.x), bflo(w.y), bfhi(w.y)}; v1 = (f32x4){bflo(w.z), bfhi(w.z), bflo(w.w), bfhi(w.w)}; }
struct EpiG1 {
    static constexpr bool PERM = true, AFTER_DRAIN = false;
    bf16_t *qkvg, *zs, *qs, *ks, *vs, *sg, *ss;
    __device__ __forceinline__ void operator()(const AccT& acc, const Unit& u, int wr, int wc, int fr, int fq) const {
        const int pn = u.pn; bf16_t* base; int ldc, colt, act = 0; float sc = 1.f;
        if (pn < 12) { base = qkvg; ldc = 3072; colt = pn * 256; }
        else if (pn < 16) { base = zs; ldc = 1024; colt = (pn - 12) * 256; act = 1; }
        else if (pn < 20) { base = qs; ldc = 1024; colt = (pn - 16) * 256; sc = 0.125f; }
        else if (pn == 20) { base = ks; ldc = 256; colt = 0; }
        else if (pn == 21) { base = vs; ldc = 256; colt = 0; }
        else if (pn < 26) { base = sg; ldc = 1024; colt = (pn - 22) * 256; act = 2; }
        else { base = ss; ldc = 1024; colt = (pn - 26) * 256; act = 2; }
        const int row0 = u.pm * 256 + wr * 64 + fr, col0 = colt + wc * 32 + 8 * fq;
#pragma unroll
        for (int ai = 0; ai < 2; ++ai)
#pragma unroll
            for (int m = 0; m < 4; ++m) { bf16_t* rowp = base + (size_t)(row0 + ai * 128 + m * 16) * ldc + col0;
#pragma unroll
                for (int bj = 0; bj < 2; ++bj) { f32x4 v0 = acc[ai][bj][m][0], v1 = acc[ai][bj][m][1];
                    if (act == 1) {
#pragma unroll
                        for (int j = 0; j < 4; ++j) { v0[j] = siluf_(v0[j]); v1[j] = siluf_(v1[j]); } }
                    else if (act == 2) {
#pragma unroll
                        for (int j = 0; j < 4; ++j) { v0[j] = sigmoidf_(v0[j]); v1[j] = sigmoidf_(v1[j]); } }
                    v0 = v0 * sc; v1 = v1 * sc;
                    *(u32x4*)(rowp + bj * 128) = pack8(v0, v1); } }
    }
};
struct EpiBr {
    static constexpr bool PERM = true, AFTER_DRAIN = false;
    const bf16_t *sg, *ss; bf16_t* y;
    __device__ __forceinline__ void operator()(const AccT& acc, const Unit& u, int wr, int wc, int fr, int fq) const {
        const int row0 = u.pm * 256 + wr * 64 + fr, col0 = u.pn * 256 + wc * 32 + 8 * fq; const bf16_t* gate = u.kind ? ss : sg;
#pragma unroll
        for (int ai = 0; ai < 2; ++ai)
#pragma unroll
            for (int m = 0; m < 4; ++m) { const size_t off = (size_t)(row0 + ai * 128 + m * 16) * D + col0;
#pragma unroll
                for (int bj = 0; bj < 2; ++bj) { f32x4 g0, g1; unpack8(*(const u32x4*)(gate + off + bj * 128), g0, g1);
                    f32x4 v0 = acc[ai][bj][m][0] * g0, v1 = acc[ai][bj][m][1] * g1;
                    if (u.kind) { f32x4 y0, y1; unpack8(*(const u32x4*)(y + off + bj * 128), y0, y1); v0 = v0 + y0; v1 = v1 + y1; }
                    *(u32x4*)(y + off + bj * 128) = pack8(v0, v1); } }
    }
};
struct EpiOut {
    static constexpr bool PERM = false, AFTER_DRAIN = false;
    const bf16_t* h0; float* pre1;
    __device__ __forceinline__ void operator()(const AccT& acc, const Unit& u, int wr, int wc, int fr, int fq) const {
        const int row0 = u.pm * 256 + wr * 64 + fr, col0 = u.pn * 256 + wc * 32 + 4 * fq;
#pragma unroll
        for (int ai = 0; ai < 2; ++ai)
#pragma unroll
            for (int m = 0; m < 4; ++m) { const size_t off = (size_t)(row0 + ai * 128 + m * 16) * D + col0;
#pragma unroll
                for (int bj = 0; bj < 2; ++bj)
#pragma unroll
                    for (int n = 0; n < 2; ++n) { const u32x2 hw = *(const u32x2*)(h0 + off + bj * 128 + n * 16);
                        const f32x4 hv = (f32x4){bflo(hw.x), bfhi(hw.x), bflo(hw.y), bfhi(hw.y)};
                        *(f32x4*)(pre1 + off + bj * 128 + n * 16) = hv * DN_ALPHA + acc[ai][bj][m][n]; } }
    }
};
struct EpiMoe1 {
    static constexpr bool PERM = true, AFTER_DRAIN = false;
    const float* b1; bf16_t* hid;
    __device__ __forceinline__ void operator()(const AccT& acc, const Unit& u, int wr, int wc, int fr, int fq) const {
        const int row0 = u.pm * 256 + wr * 64 + fr, j0 = u.pn * 128 + wc * 32 + 8 * fq; const float* bb = b1 + (size_t)u.e * 2048 + j0;
        const f32x4 bg0 = *(const f32x4*)(bb), bg1 = *(const f32x4*)(bb + 4), bu0 = *(const f32x4*)(bb + 1024), bu1 = *(const f32x4*)(bb + 1028);
#pragma unroll
        for (int ai = 0; ai < 2; ++ai)
#pragma unroll
            for (int m = 0; m < 4; ++m) { f32x4 o[2];
#pragma unroll
                for (int n = 0; n < 2; ++n) { const f32x4 g = acc[ai][0][m][n] + (n ? bg1 : bg0), up = acc[ai][1][m][n] + (n ? bu1 : bu0);
#pragma unroll
                    for (int j = 0; j < 4; ++j) { const float gg = fminf(g[j], 7.0f), uu = fminf(fmaxf(up[j], -7.0f), 7.0f); o[n][j] = gg * sigmoidf_(1.702f * gg) * (uu + 1.0f); } }
                *(u32x4*)(hid + (size_t)(row0 + ai * 128 + m * 16) * DFF + j0) = pack8(o[0], o[1]); }
    }
};
struct EpiMoe2 {
    static constexpr bool PERM = true, AFTER_DRAIN = false;
    const float* b2; const float* roww; bf16_t* ys;
    __device__ __forceinline__ void operator()(const AccT& acc, const Unit& u, int wr, int wc, int fr, int fq) const {
        const int row0 = u.pm * 256 + wr * 64 + fr, col0 = u.pn * 256 + wc * 32 + 8 * fq; const float* bb = b2 + (size_t)u.e * D + col0;
        f32x4 bv[2][2];
#pragma unroll
        for (int bj = 0; bj < 2; ++bj)
#pragma unroll
            for (int n = 0; n < 2; ++n) bv[bj][n] = *(const f32x4*)(bb + bj * 128 + 4 * n);
#pragma unroll
        for (int ai = 0; ai < 2; ++ai)
#pragma unroll
            for (int m = 0; m < 4; ++m) { const int row = row0 + ai * 128 + m * 16; const float w = roww[row];
#pragma unroll
                for (int bj = 0; bj < 2; ++bj) *(u32x4*)(ys + (size_t)row * D + col0 + bj * 128) = pack8((acc[ai][bj][m][0] + bv[bj][0]) * w, (acc[ai][bj][m][1] + bv[bj][1]) * w); }
    }
};

struct Ctx { LAS unsigned char* lds; volatile LAS unsigned* MISC; int tid, lane, wave, G, gw, NGW; unsigned char* ws; };

__device__ __forceinline__ void transpose_item(const float* W, int ldw, int k0, int srccol, bf16_t* WT, int ldt, int dstrow, LAS float* scr, int lane) {
#pragma unroll 8
    for (int i = 0; i < 32; ++i) { const int kk = 2 * i + (lane >> 5); scr[kk * 33 + (lane & 31)] = W[(size_t)(k0 + kk) * ldw + srccol + (lane & 31)]; }
    LDS_WAIT(); asm volatile("" ::: "memory");
    const int c = lane & 7;
#pragma unroll
    for (int j = 0; j < 4; ++j) { const int n = (lane >> 3) + 8 * j; const LAS float* s = scr + (8 * c) * 33 + n;
        u32x4 o; o.x = pk2(s[0 * 33], s[1 * 33]); o.y = pk2(s[2 * 33], s[3 * 33]); o.z = pk2(s[4 * 33], s[5 * 33]); o.w = pk2(s[6 * 33], s[7 * 33]);
        *(u32x4*)(WT + (size_t)(dstrow + n) * ldt + k0 + 8 * c) = o; }
    LDS_WAIT(); asm volatile("" ::: "memory");
}
__device__ __forceinline__ void ln_row(const float* xrow, const float* gam, const float* bet, int lane, f32x4 (&y)[4]) {
    const f32x4* xr = (const f32x4*)xrow + lane; float s = 0.f;
#pragma unroll
    for (int j = 0; j < 4; ++j) { y[j] = xr[64 * j]; s += (y[j].x + y[j].y) + (y[j].z + y[j].w); }
    const float mean = wave_sum(s) * (1.f / D); float s2 = 0.f;
#pragma unroll
    for (int j = 0; j < 4; ++j) { y[j] = y[j] - mean; s2 += (y[j].x * y[j].x + y[j].y * y[j].y) + (y[j].z * y[j].z + y[j].w * y[j].w); }
    const float rstd = frsq(wave_sum(s2) * (1.f / D) + LN_EPS);
#pragma unroll
    for (int j = 0; j < 4; ++j) { const f32x4 gv = ((const f32x4*)gam)[lane + 64 * j], bv = ((const f32x4*)bet)[lane + 64 * j]; y[j] = y[j] * rstd * gv + bv; }
}
__device__ __forceinline__ void store_row_bf16(bf16_t* orow, int lane, const f32x4 (&y)[4]) {
    u32x2* o8 = (u32x2*)orow + lane;
#pragma unroll
    for (int j = 0; j < 4; ++j) { u32x2 w; w.x = pk2(y[j].x, y[j].y); w.y = pk2(y[j].z, y[j].w); o8[64 * j] = w; }
}
__device__ __forceinline__ void phase_prep(const P& p, const Ctx& c) {
    const float* w_in = p.in[I_WIN];
    if ((int)blockIdx.x * 32 < CIN) {
        LAS float* h0m = (LAS float*)c.lds; LAS float* red = (LAS float*)(c.lds + 65536);
#pragma unroll
        for (int rr = 0; rr < 2; ++rr) { const int m = 2 * c.wave + rr; f32x4 y[4]; ln_row(p.in[I_META] + (size_t)m * D, p.in[I_ELG], p.in[I_ELB], c.lane, y);
#pragma unroll
            for (int j = 0; j < 4; ++j) *(LAS f32x4*)(h0m + m * D + 4 * c.lane + 256 * j) = y[j]; }
        __syncthreads();
        const int cc = c.tid & 31, ks = c.tid >> 5, col = blockIdx.x * 32 + cc; float acc[16];
#pragma unroll
        for (int m = 0; m < 16; ++m) acc[m] = 0.f;
        if (col < CIN) for (int k = ks * 64; k < ks * 64 + 64; ++k) { const float w = w_in[(size_t)k * CIN + col];
#pragma unroll
            for (int m = 0; m < 16; ++m) acc[m] += h0m[m * D + k] * w; }
#pragma unroll
        for (int m = 0; m < 16; ++m) red[(ks * 16 + m) * 32 + cc] = acc[m];
        __syncthreads();
        { const int m = c.tid >> 5; float s = 0.f;
#pragma unroll
          for (int k2 = 0; k2 < 16; ++k2) s += red[(k2 * 16 + m) * 32 + cc];
          if (col < CIN) ((float*)(c.ws + WS_PM))[(size_t)m * CIN + col] = s; }
        __syncthreads();
    }
    LAS float* scr = (LAS float*)(c.lds + c.wave * 16384);
    constexpr int I_IN = 240 * 16, I_SQ = 512, I_1 = 32 * 1024, I_2 = 32 * 512, NITEMS = I_IN + 3 * I_SQ + I_1 + I_2;
    bf16_t* WIN = (bf16_t*)(c.ws + WS_WIN);
    for (int it = c.gw; it < NITEMS; it += c.NGW) {
        int r = it;
        if (r < I_IN) { const int nb = r % 240, kb = r / 240, dr = 32 * nb; transpose_item(w_in, CIN, 64 * kb, dr < 4096 ? dr : dr + 16, WIN, D, dr, scr, c.lane); continue; } r -= I_IN;
        if (r < I_SQ) { const int nb = r % 32, kb = r / 32; transpose_item(p.in[I_WBG], D, 64 * kb, 32 * nb, (bf16_t*)(c.ws + WS_WBG), D, 32 * nb, scr, c.lane); continue; } r -= I_SQ;
        if (r < I_SQ) { const int nb = r % 32, kb = r / 32; transpose_item(p.in[I_WBS], D, 64 * kb, 32 * nb, (bf16_t*)(c.ws + WS_WBS), D, 32 * nb, scr, c.lane); continue; } r -= I_SQ;
        if (r < I_SQ) { const int nb = r % 32, kb = r / 32; transpose_item(p.in[I_WOUT], D, 64 * kb, 32 * nb, (bf16_t*)(c.ws + WS_WOUT), D, 32 * nb, scr, c.lane); continue; } r -= I_SQ;
        if (r < I_1) { const int e = r / 1024, q = r % 1024, nb = q % 64, kb = q / 64, dr = 32 * nb; const int src = ((dr >> 7) & 1) * 1024 + (dr >> 8) * 128 + (dr & 127);
            transpose_item(p.in[I_W1] + (size_t)e * D * 2048, 2048, 64 * kb, src, (bf16_t*)(c.ws + WS_W1) + (size_t)e * 2048 * D, D, dr, scr, c.lane); continue; } r -= I_1;
        { const int e = r / 512, q = r % 512, nb = q % 32, kb = q / 32;
            transpose_item(p.in[I_W2] + (size_t)e * DFF * D, D, 64 * kb, 32 * nb, (bf16_t*)(c.ws + WS_W2) + (size_t)e * D * DFF, DFF, 32 * nb, scr, c.lane); }
    }
}

__device__ __forceinline__ void conv8(const float (&w)[8][4], const float (&r)[4][8], float (&y)[8]) {
#pragma unroll
    for (int j = 0; j < 8; ++j) { const float a = w[j][0] * r[0][j] + w[j][1] * r[1][j] + w[j][2] * r[2][j] + w[j][3] * r[3][j]; y[j] = siluf_(a); }
}
__device__ __forceinline__ void meta_state(const P& p, const Ctx& c, int h, LAS unsigned char* lb) {
    LAS float* kf = (LAS float*)lb; LAS float* vf = kf + 16 * 128; LAS float* red = vf + 16 * 128; LAS float* bet = red + 2 * 4 * 128; LAS float* gg = bet + 16;
    const float* PM = (const float*)(c.ws + WS_PM); const float* cw = p.in[I_CONVW];
    { const int tl = c.tid >> 5, cg = c.tid & 31; float kk[4], vv[4]; float ss = 0.f;
#pragma unroll
      for (int j = 0; j < 4; ++j) { const int ch = h * 128 + 4 * cg + j; float ak = 0.f, av = 0.f;
#pragma unroll
          for (int i = 0; i < 4; ++i) { const int tt = tl - 3 + i; if (tt >= 0) { ak += cw[(size_t)(1024 + ch) * 4 + i] * PM[(size_t)tt * CIN + C_KG + ch]; av += cw[(size_t)(2048 + ch) * 4 + i] * PM[(size_t)tt * CIN + C_VG + ch]; } }
          kk[j] = siluf_(ak); vv[j] = siluf_(av); ss += kk[j] * kk[j]; }
#pragma unroll
      for (int o = 1; o < 32; o <<= 1) ss += __shfl_xor(ss, o);
      const float rn = frsq(ss + RMS_EPS);
#pragma unroll
      for (int j = 0; j < 4; ++j) { kf[tl * 128 + 4 * cg + j] = kk[j] * rn; vf[tl * 128 + 4 * cg + j] = vv[j]; }
      if (cg == 0) { bet[tl] = sigmoidf_(PM[(size_t)tl * CIN + C_BG + h]); gg[tl] = fexp(-fexp(p.in[I_ALOG][h]) * softplusf_(PM[(size_t)tl * CIN + C_AG + h] + p.in[I_DTB][h])); } }
    __syncthreads();
    float S[32];
#pragma unroll
    for (int k = 0; k < 32; ++k) S[k] = 0.f;
    const int v = c.tid & 127, rg = c.tid >> 7;
#pragma unroll 1
    for (int t = 0; t < 16; ++t) { float pk = 0.f;
#pragma unroll
        for (int k = 0; k < 32; ++k) pk += S[k] * kf[t * 128 + rg * 32 + k];
        red[((t & 1) * 4 + rg) * 128 + v] = pk;
        __syncthreads();
        const float sk = (red[((t & 1) * 4 + 0) * 128 + v] + red[((t & 1) * 4 + 1) * 128 + v]) + (red[((t & 1) * 4 + 2) * 128 + v] + red[((t & 1) * 4 + 3) * 128 + v]);
        const float g = gg[t], u = bet[t] * (vf[t * 128 + v] - g * sk);
#pragma unroll
        for (int k = 0; k < 32; ++k) S[k] = g * S[k] + kf[t * 128 + rg * 32 + k] * u; }
    float* S1 = (float*)(c.ws + WS_S1) + (size_t)h * 128 * 128;
#pragma unroll
    for (int k = 0; k < 32; ++k) S1[(rg * 32 + k) * 128 + v] = S[k];
    __syncthreads();
}

__device__ __forceinline__ void phase_ln0(const P& p, Ctx c, int g) {
    LAS float* wba = (LAS float*)c.lds;
    const float* w_in = p.in[I_WIN];
    for (int idx = c.tid; idx < 16 * 1024; idx += NTHR) { const int k = idx >> 4, cc = idx & 15; wba[cc * 1024 + k] = w_in[(size_t)k * CIN + C_BG + cc]; }
    __syncthreads();
#ifndef NO_META
    if (g == 0 && blockIdx.x < NHG) meta_state(p, c, blockIdx.x, c.lds + 65536);
#endif
    asm volatile("" : "+v"(c.tid), "+v"(c.lane));
    bf16_t* H0 = (bf16_t*)(c.ws + WS_H0); float* BETA = (float*)(c.ws + WS_BETA); float* LOGG = (float*)(c.ws + WS_LOGG);
    for (int r = c.gw; r < TOK; r += c.NGW) {
        f32x4 y[4]; ln_row(p.in[I_X] + ((size_t)g * TOK + r) * D, p.in[I_ELG], p.in[I_ELB], c.lane, y);
        store_row_bf16(H0 + (size_t)r * D, c.lane, y);
        float mine = 0.f;
#pragma unroll
        for (int cc = 0; cc < 16; ++cc) { float s = 0.f;
#pragma unroll
            for (int j = 0; j < 4; ++j) { const f32x4 w = *(const LAS f32x4*)(wba + cc * 1024 + 4 * c.lane + 256 * j); s += (y[j].x * w.x + y[j].y * w.y) + (y[j].z * w.z + y[j].w * w.w); }
            s = wave_sum(s); if (c.lane == cc) mine = s; asm volatile("" ::: "memory"); }
        if (c.lane < 8) BETA[(size_t)r * 8 + c.lane] = sigmoidf_(mine);
        else if (c.lane < 16) { const int h = c.lane - 8; LOGG[(size_t)r * 8 + h] = -fexp(p.in[I_ALOG][h]) * softplusf_(mine + p.in[I_DTB][h]); }
    }
}

__device__ __forceinline__ void gdn_feat8(const float* cw, const bf16_t* QKVG, const float* PM, int bl, int tok, int h, int cg, int which, float (&y)[8]) {
    const int ch0 = which * 1024 + h * 128 + 8 * cg; float r[4][8];
#pragma unroll
    for (int i = 0; i < 4; ++i) { const int tt = tok - 3 + i; const int tc = tt < 0 ? 0 : tt;
        f32x4 a0, a1; unpack8(*(const u32x4*)(QKVG + ((size_t)bl * SEQ + tc) * 3072 + ch0), a0, a1);
#pragma unroll
        for (int j = 0; j < 4; ++j) { r[i][j] = a0[j]; r[i][4 + j] = a1[j]; }
        if (tt < 0) { const float* mp = PM + (size_t)(NMETA + tt) * CIN + ch0;
            const f32x4 m0 = *(const f32x4*)mp, m1 = *(const f32x4*)(mp + 4);
#pragma unroll
            for (int j = 0; j < 4; ++j) { r[i][j] = m0[j]; r[i][4 + j] = m1[j]; } } }
#pragma unroll
    for (int j = 0; j < 8; ++j) { const f32x4 w = *(const f32x4*)(cw + (size_t)(ch0 + j) * 4); y[j] = siluf_(w[0] * r[0][j] + w[1] * r[1][j] + w[2] * r[2][j] + w[3] * r[3][j]); }
}
__device__ __forceinline__ void gdn_seq_unit(const P& p, const Ctx& c, int bl, int h) {
    LAS float* qf = (LAS float*)c.lds; LAS float* kf = qf + 32 * 128; LAS float* vf = kf + 32 * 128; LAS float* ob = vf + 32 * 128;
    LAS float* red = ob + 32 * 128; LAS float* bet = red + 2 * 2 * 4 * 128; LAS float* gg = bet + 32; LAS float* kqs = gg + 32;
    const float* PM = (const float*)(c.ws + WS_PM); const float* cw = p.in[I_CONVW];
    const bf16_t* QKVG = (const bf16_t*)(c.ws + WS_QKVG); const bf16_t* ZS = (const bf16_t*)(c.ws + WS_ZS); bf16_t* OG = (bf16_t*)(c.ws + WS_OG);
    const float* BETA = (const float*)(c.ws + WS_BETA); const float* LOGG = (const float*)(c.ws + WS_LOGG);
    const int v = c.tid & 127, rg = c.tid >> 7, tl = c.tid >> 4, cg = c.tid & 15;
    float S[32];
    { const float* S1 = (const float*)(c.ws + WS_S1) + (size_t)h * 128 * 128;
#pragma unroll
      for (int k = 0; k < 32; ++k) S[k] = S1[(rg * 32 + k) * 128 + v]; }
#pragma unroll 1
    for (int t0 = 0; t0 < SEQ; t0 += 32) {
        { const int tok = t0 + tl; const size_t row = (size_t)bl * SEQ + tok; float yq[8], yk[8], yv[8];
          gdn_feat8(cw, QKVG, PM, bl, tok, h, cg, 0, yq); asm volatile("" ::: "memory");
          gdn_feat8(cw, QKVG, PM, bl, tok, h, cg, 1, yk); asm volatile("" ::: "memory");
          gdn_feat8(cw, QKVG, PM, bl, tok, h, cg, 2, yv); asm volatile("" ::: "memory");
          float sq = 0.f, sk = 0.f;
#pragma unroll
          for (int j = 0; j < 8; ++j) { sq += yq[j] * yq[j]; sk += yk[j] * yk[j]; }
#pragma unroll
          for (int o = 1; o < 16; o <<= 1) { sq += __shfl_xor(sq, o); sk += __shfl_xor(sk, o); }
          const float rq_ = 0.08838834764831845f * frsq(sq + RMS_EPS), rk_ = frsq(sk + RMS_EPS); float kq = 0.f;
#pragma unroll
          for (int j = 0; j < 8; ++j) { yq[j] *= rq_; yk[j] *= rk_; kq += yq[j] * yk[j]; qf[tl * 128 + 8 * cg + j] = yq[j]; kf[tl * 128 + 8 * cg + j] = yk[j]; vf[tl * 128 + 8 * cg + j] = yv[j]; }
#pragma unroll
          for (int o = 1; o < 16; o <<= 1) kq += __shfl_xor(kq, o);
          if (cg == 0) { bet[tl] = BETA[row * 8 + h]; gg[tl] = fexp(LOGG[row * 8 + h]); kqs[tl] = kq; } }
        __syncthreads();
#pragma unroll 1
        for (int t = 0; t < 32; ++t) { float pk = 0.f, pq = 0.f; const LAS float* kr = kf + t * 128 + rg * 32; const LAS float* qr = qf + t * 128 + rg * 32;
#pragma unroll
            for (int k = 0; k < 32; ++k) pk += S[k] * kr[k];
            asm volatile("" ::: "memory");
#pragma unroll
            for (int k = 0; k < 32; ++k) pq += S[k] * qr[k];
            asm volatile("" ::: "memory");
            LAS float* rb = red + (t & 1) * 1024; rb[rg * 128 + v] = pk; rb[512 + rg * 128 + v] = pq;
            __syncthreads();
            const float sk = (rb[v] + rb[128 + v]) + (rb[256 + v] + rb[384 + v]), sq = (rb[512 + v] + rb[640 + v]) + (rb[768 + v] + rb[896 + v]);
            const float g = gg[t], u = bet[t] * (vf[t * 128 + v] - g * sk);
            if (rg == 0) ob[t * 128 + v] = g * sq + kqs[t] * u;
            asm volatile("" ::: "memory");
#pragma unroll
            for (int k = 0; k < 32; ++k) S[k] = g * S[k] + kr[k] * u; }
        __syncthreads();
        { const size_t row = (size_t)bl * SEQ + t0 + tl; float o[8]; float ss = 0.f;
#pragma unroll
          for (int j = 0; j < 8; ++j) { o[j] = ob[tl * 128 + 8 * cg + j]; ss += o[j] * o[j]; }
#pragma unroll
          for (int o2 = 1; o2 < 16; o2 <<= 1) ss += __shfl_xor(ss, o2);
          const float rn = frsq(ss * (1.f / 128.f) + RMS_EPS); f32x4 z0, z1; unpack8(*(const u32x4*)(ZS + row * D + h * 128 + 8 * cg), z0, z1);
          const float* nw = p.in[I_GNW] + 8 * cg; f32x4 r0, r1;
#pragma unroll
          for (int j = 0; j < 4; ++j) { r0[j] = o[j] * rn * nw[j] * z0[j]; r1[j] = o[4 + j] * rn * nw[4 + j] * z1[j]; }
          *(u32x4*)(OG + row * D + h * 128 + 8 * cg) = pack8(r0, r1); }
        __syncthreads();
    }
}
__device__ __forceinline__ void swa_naive(const P& p, const Ctx& c, int first_block) {
    const float* PM = (const float*)(c.ws + WS_PM); const bf16_t* QS = (const bf16_t*)(c.ws + WS_QS); const bf16_t* KS = (const bf16_t*)(c.ws + WS_KS); const bf16_t* VS = (const bf16_t*)(c.ws + WS_VS);
    bf16_t* OS = (bf16_t*)(c.ws + WS_OSW);
    const int nthreads = (c.G - first_block) * NTHR;
    for (int idx = ((int)blockIdx.x - first_block) * NTHR + c.tid; idx < TOK * NHQ * 2; idx += nthreads) {
        const int half = idx & 1, hq = (idx >> 1) & 15, row = idx >> 5, hk = hq >> 2, bl = row / SEQ, i = row - bl * SEQ, dofs = hk * 64 + half * 32;
        float q[32], o[32];
#pragma unroll
        for (int d8 = 0; d8 < 4; ++d8) { f32x4 a0, a1; unpack8(*(const u32x4*)(QS + (size_t)row * D + hq * 64 + half * 32 + 8 * d8), a0, a1);
#pragma unroll
            for (int j = 0; j < 4; ++j) { q[8 * d8 + j] = a0[j]; q[8 * d8 + 4 + j] = a1[j]; } }
#pragma unroll
        for (int d = 0; d < 32; ++d) o[d] = 0.f;
        const float slope = __builtin_amdgcn_exp2f(-0.5f * (float)(hq + 1)); float m = p.in[I_SINK][hq], l = 1.0f;
        for (int mt = 0; mt < NMETA; ++mt) { const float* kp = PM + (size_t)mt * CIN + C_KS + dofs; const float* vp = PM + (size_t)mt * CIN + C_VS + dofs; float s = 0.f;
#pragma unroll
            for (int d = 0; d < 32; ++d) s += q[d] * kp[d];
            s += __shfl_xor(s, 1); s -= slope * (float)(NMETA + i - mt); asm volatile("" ::: "memory");
            if (s > m) { const float sc = fexp(m - s); l *= sc;
#pragma unroll
                for (int d = 0; d < 32; ++d) o[d] *= sc;
                m = s; }
            const float pe = fexp(s - m); l += pe;
#pragma unroll
            for (int d = 0; d < 32; ++d) o[d] += pe * vp[d]; }
        for (int j = (i > 127 ? i - 127 : 0); j <= i; ++j) { const bf16_t* kp = KS + ((size_t)bl * SEQ + j) * 256 + dofs; const bf16_t* vp = VS + ((size_t)bl * SEQ + j) * 256 + dofs; float s = 0.f;
#pragma unroll
            for (int d8 = 0; d8 < 4; ++d8) { f32x4 a0, a1; unpack8(*(const u32x4*)(kp + 8 * d8), a0, a1);
#pragma unroll
                for (int jj = 0; jj < 4; ++jj) s += q[8 * d8 + jj] * a0[jj] + q[8 * d8 + 4 + jj] * a1[jj]; }
            s += __shfl_xor(s, 1); s -= slope * (float)(i - j); asm volatile("" ::: "memory");
            if (s > m) { const float sc = fexp(m - s); l *= sc;
#pragma unroll
                for (int d = 0; d < 32; ++d) o[d] *= sc;
                m = s; }
            const float pe = fexp(s - m); l += pe;
#pragma unroll
            for (int d8 = 0; d8 < 4; ++d8) { f32x4 a0, a1; unpack8(*(const u32x4*)(vp + 8 * d8), a0, a1);
#pragma unroll
                for (int jj = 0; jj < 4; ++jj) { o[8 * d8 + jj] += pe * a0[jj]; o[8 * d8 + 4 + jj] += pe * a1[jj]; } } }
        const float il = frcp(l);
#pragma unroll
        for (int d8 = 0; d8 < 4; ++d8) { f32x4 r0, r1;
#pragma unroll
            for (int jj = 0; jj < 4; ++jj) { r0[jj] = o[8 * d8 + jj] * il; r1[jj] = o[8 * d8 + 4 + jj] * il; }
            *(u32x4*)(OS + (size_t)row * D + hq * 64 + half * 32 + 8 * d8) = pack8(r0, r1); }
    }
}

__device__ __forceinline__ void phase_ln1_router(const P& p, const Ctx& c, int g) {
    LAS float* wrT = (LAS float*)c.lds;
    const float* wr = p.in[I_WR];
    for (int idx = c.tid; idx < 32 * 1024; idx += NTHR) { const int k = idx >> 5, e = idx & 31; wrT[e * 1024 + k] = wr[idx]; }
    __syncthreads();
    const float* PRE1 = (const float*)(c.ws + WS_PRE1); bf16_t* H1 = (bf16_t*)(c.ws + WS_H1);
    int* TOPI = (int*)(c.ws + WS_TOPI); float* TOPW = (float*)(c.ws + WS_TOPW); int* RANK = (int*)(c.ws + WS_RANK); unsigned* cnt = (unsigned*)(c.ws + WS_CTL) + CW_CNT + g * 64;
    for (int r = c.gw; r < TOK; r += c.NGW) {
        f32x4 y[4]; ln_row(PRE1 + (size_t)r * D, p.in[I_L1G], p.in[I_L1B], c.lane, y);
        store_row_bf16(H1 + (size_t)r * D, c.lane, y);
        float lg[32];
#pragma unroll
        for (int e = 0; e < 32; ++e) { float s = 0.f;
#pragma unroll
            for (int j = 0; j < 4; ++j) { const f32x4 w = *(const LAS f32x4*)(wrT + e * 1024 + 4 * c.lane + 256 * j); s += (y[j].x * w.x + y[j].y * w.y) + (y[j].z * w.z + y[j].w * w.w); }
            lg[e] = wave_sum(s) + p.in[I_BR][e]; asm volatile("" ::: "memory"); }
        int sel[4]; float val[4];
#pragma unroll
        for (int k = 0; k < 4; ++k) { float best = -3.0e38f; int bi = 0;
#pragma unroll
            for (int e = 0; e < 32; ++e) if (lg[e] > best) { best = lg[e]; bi = e; }
            sel[k] = bi; val[k] = best;
#pragma unroll
            for (int e = 0; e < 32; ++e) lg[e] = (e == bi) ? -3.0e38f : lg[e]; }
        const float e1 = fexp(val[1] - val[0]), e2 = fexp(val[2] - val[0]), e3 = fexp(val[3] - val[0]); const float inv = frcp(1.0f + e1 + e2 + e3);
        if (c.lane < 4) { const int me = c.lane == 0 ? sel[0] : c.lane == 1 ? sel[1] : c.lane == 2 ? sel[2] : sel[3]; const float mw = (c.lane == 0 ? 1.0f : c.lane == 1 ? e1 : c.lane == 2 ? e2 : e3) * inv;
            const unsigned rk = atomicAdd(cnt + me, 1u); TOPI[(size_t)r * 4 + c.lane] = me; TOPW[(size_t)r * 4 + c.lane] = mw; RANK[(size_t)r * 4 + c.lane] = (int)rk; }
    }
}
__device__ __forceinline__ int moe_tables(const Ctx& c, int g) {
    const unsigned* cnt = (const unsigned*)(c.ws + WS_CTL) + CW_CNT + g * 64;
    if (c.tid == 0) { unsigned o = 0; for (int e = 0; e < NEXP; ++e) { c.MISC[MI_OFF + e] = o; o += (__hip_atomic_load(cnt + e, __ATOMIC_RELAXED, __HIP_MEMORY_SCOPE_AGENT) + 255u) & ~255u; } c.MISC[MI_OFF + NEXP] = o; }
    __syncthreads();
    const int ntiles = (int)(c.MISC[MI_OFF + NEXP] >> 8);
    for (int t = c.tid; t < ntiles; t += NTHR) { int e = 0; for (int k = 1; k < NEXP; ++k) if ((unsigned)(t * 256) >= c.MISC[MI_OFF + k]) e = k; c.MISC[MI_TE + t] = (unsigned)e; }
    __syncthreads();
    return ntiles;
}
__device__ __forceinline__ void phase_scatter(const P& p, const Ctx& c, int g) {
    (void)moe_tables(c, g);
    const unsigned* cnt = (const unsigned*)(c.ws + WS_CTL) + CW_CNT + g * 64;
    const bf16_t* H1 = (const bf16_t*)(c.ws + WS_H1); bf16_t* XS = (bf16_t*)(c.ws + WS_XS);
    const int* TOPI = (const int*)(c.ws + WS_TOPI); const float* TOPW = (const float*)(c.ws + WS_TOPW); const int* RANK = (const int*)(c.ws + WS_RANK); int* SLOT = (int*)(c.ws + WS_SLOT); float* ROWW = (float*)(c.ws + WS_ROWW);
    for (int r = c.gw; r < TOK; r += c.NGW) {
        const u32x4* src = (const u32x4*)(H1 + (size_t)r * D); const u32x4 a = src[c.lane], b = src[c.lane + 64];
#pragma unroll
        for (int k = 0; k < 4; ++k) { const int e = TOPI[(size_t)r * 4 + k], slot = (int)c.MISC[MI_OFF + e] + RANK[(size_t)r * 4 + k];
            u32x4* dst = (u32x4*)(XS + (size_t)slot * D); dst[c.lane] = a; dst[c.lane + 64] = b;
            if (c.lane == 0) { SLOT[(size_t)r * 4 + k] = slot; ROWW[slot] = TOPW[(size_t)r * 4 + k]; } }
    }
    for (int e = 0; e < NEXP; ++e) { const int lo = (int)c.MISC[MI_OFF + e] + (int)__hip_atomic_load(cnt + e, __ATOMIC_RELAXED, __HIP_MEMORY_SCOPE_AGENT), hi = (int)c.MISC[MI_OFF + e + 1];
        for (int pr = lo + c.gw; pr < hi; pr += c.NGW) { u32x4* dst = (u32x4*)(XS + (size_t)pr * D); const u32x4 z = {0u, 0u, 0u, 0u}; dst[c.lane] = z; dst[c.lane + 64] = z; if (c.lane == 0) ROWW[pr] = 0.f; } }
}
__device__ __forceinline__ void phase_combine(const P& p, const Ctx& c, int g) {
    const bf16_t* H1 = (const bf16_t*)(c.ws + WS_H1); const bf16_t* YS = (const bf16_t*)(c.ws + WS_YS); const int* SLOT = (const int*)(c.ws + WS_SLOT);
    for (int r = c.gw; r < TOK; r += c.NGW) {
        int sl[4];
#pragma unroll
        for (int k = 0; k < 4; ++k) sl[k] = SLOT[(size_t)r * 4 + k];
        f32x4 v[4]; float s = 0.f;
#pragma unroll
        for (int j = 0; j < 4; ++j) { const u32x2 hw = ((const u32x2*)(H1 + (size_t)r * D))[c.lane + 64 * j]; v[j] = (f32x4){bflo(hw.x), bfhi(hw.x), bflo(hw.y), bfhi(hw.y)} * DN_ALPHA;
#pragma unroll
            for (int k = 0; k < 4; ++k) { const u32x2 yw = ((const u32x2*)(YS + (size_t)sl[k] * D))[c.lane + 64 * j]; v[j] = v[j] + (f32x4){bflo(yw.x), bfhi(yw.x), bflo(yw.y), bfhi(yw.y)}; }
            s += (v[j].x + v[j].y) + (v[j].z + v[j].w); }
        const float mean = wave_sum(s) * (1.f / D); float s2 = 0.f;
#pragma unroll
        for (int j = 0; j < 4; ++j) { v[j] = v[j] - mean; s2 += (v[j].x * v[j].x + v[j].y * v[j].y) + (v[j].z * v[j].z + v[j].w * v[j].w); }
        const float rstd = frsq(wave_sum(s2) * (1.f / D) + LN_EPS);
        f32x4* orow = (f32x4*)(p.out + ((size_t)g * TOK + r) * D);
#pragma unroll
        for (int j = 0; j < 4; ++j) { const f32x4 gv = ((const f32x4*)p.in[I_L2G])[c.lane + 64 * j], bv = ((const f32x4*)p.in[I_L2B])[c.lane + 64 * j]; orow[c.lane + 64 * j] = v[j] * rstd * gv + bv; }
    }
}

constexpr int NPH_G = 10, NPHASES = 1 + NG * NPH_G;
__global__ void __launch_bounds__(NTHR, 2) fwd(P p) {
    extern __shared__ __attribute__((aligned(16))) unsigned char lds_raw[];
    Ctx c; c.lds = (LAS unsigned char*)lds_raw; c.MISC = (volatile LAS unsigned*)(c.lds + MISC_OFF);
    c.tid = threadIdx.x; c.lane = c.tid & 63; c.wave = __builtin_amdgcn_readfirstlane(c.tid >> 6); c.G = gridDim.x; c.ws = p.ws;
    { const int bx = blockIdx.x; const int vcu = (c.G % 8 == 0) ? (bx % 8) * (c.G / 8) + bx / 8 : bx; c.gw = vcu * NWAVES + c.wave; c.NGW = c.G * NWAVES; }
    unsigned* ctl = (unsigned*)(p.ws + WS_CTL);
    if (c.tid < 16) c.MISC[c.tid] = 0u;
    __syncthreads();
#if MK_SINGLE
    XcdBarrier bar = xcd_barrier_post(ctl + CW_BAR, c.MISC);
#define SEAM(k) do { if (IN(k) && IN((k) + 1)) xcd_barrier(bar); } while (0)
#else
#define SEAM(k) do { } while (0)
#endif
#ifndef PHASE_MASK
#define PHASE_MASK 0xFFFF
#endif
#define IN(k) (p.ph_lo <= (k) && (k) < p.ph_hi)
#define ON(j) (((PHASE_MASK) >> (j)) & 1)
    const int bx = blockIdx.x;
#define FRESH() do { asm volatile("" : "+v"(c.tid), "+v"(c.lane)); } while (0)
    if (ON(10) && IN(0)) { FRESH(); phase_prep(p, c); }
    SEAM(0);
    for (int g = 0; g < NG; ++g) {
        const int pb = 1 + g * NPH_G;
        if (ON(0) && IN(pb + 0)) { FRESH(); phase_ln0(p, c, g); }
        SEAM(pb + 0);
        if (ON(1) && IN(pb + 1)) { FRESH();
            SchedStd S; S.init(TOK, N1, D, c.G, bx, p.ws + WS_H0, p.ws + WS_WIN);
            EpiG1 E{(bf16_t*)(p.ws + WS_QKVG), (bf16_t*)(p.ws + WS_ZS), (bf16_t*)(p.ws + WS_QS), (bf16_t*)(p.ws + WS_KS), (bf16_t*)(p.ws + WS_VS), (bf16_t*)(p.ws + WS_SG), (bf16_t*)(p.ws + WS_SS)};
            pg8::gemm_phase<EpiG1, SchedStd, true, true>(c.lds, D, S, E);
        }
        SEAM(pb + 1);
        if (ON(2) && IN(pb + 2)) { FRESH();
#ifndef NO_GDN
            if (bx < NB * NHG) gdn_seq_unit(p, c, bx / NHG, bx % NHG);
#endif
#ifndef NO_SWA
            if (bx >= NB * NHG) swa_naive(p, c, NB * NHG);
#endif
        }
        SEAM(pb + 2);
        if (ON(3) && IN(pb + 3)) { FRESH();
            SchedPair S; S.init(TOK, D, D, c.G, bx, p.ws + WS_OG, p.ws + WS_WBG, p.ws + WS_OSW, p.ws + WS_WBS);
            EpiBr E{(const bf16_t*)(p.ws + WS_SG), (const bf16_t*)(p.ws + WS_SS), (bf16_t*)(p.ws + WS_Y)};
            pg8::gemm_phase<EpiBr, SchedPair, true, true>(c.lds, D, S, E);
        }
        SEAM(pb + 3);
        if (ON(4) && IN(pb + 4)) { FRESH();
            SchedStd S; S.init(TOK, D, D, c.G, bx, p.ws + WS_Y, p.ws + WS_WOUT);
            EpiOut E{(const bf16_t*)(p.ws + WS_H0), (float*)(p.ws + WS_PRE1)};
            pg8::gemm_phase<EpiOut, SchedStd, true, true>(c.lds, D, S, E);
        }
        SEAM(pb + 4);
        if (ON(5) && IN(pb + 5)) { FRESH(); phase_ln1_router(p, c, g); }
        SEAM(pb + 5);
        if (ON(6) && IN(pb + 6)) { FRESH(); phase_scatter(p, c, g); }
        SEAM(pb + 6);
        if (ON(7) && IN(pb + 7)) { FRESH();
            const int ntiles = moe_tables(c, g);
            SchedMoe S; S.init(ntiles, 2 * DFF, D, c.G, bx, p.ws + WS_XS, p.ws + WS_W1, c.MISC + MI_TE);
            EpiMoe1 E{p.in[I_B1], (bf16_t*)(p.ws + WS_HID)};
            pg8::gemm_phase<EpiMoe1, SchedMoe, true, true>(c.lds, D, S, E);
        }
        SEAM(pb + 7);
        if (ON(8) && IN(pb + 8)) { FRESH();
            const int ntiles = moe_tables(c, g);
            SchedMoe S; S.init(ntiles, D, DFF, c.G, bx, p.ws + WS_HID, p.ws + WS_W2, c.MISC + MI_TE);
            EpiMoe2 E{p.in[I_B2], (const float*)(p.ws + WS_ROWW), (bf16_t*)(p.ws + WS_YS)};
            pg8::gemm_phase<EpiMoe2, SchedMoe, true, true>(c.lds, DFF, S, E);
        }
        SEAM(pb + 8);
        if (ON(9) && IN(pb + 9)) { FRESH(); phase_combine(p, c, g); }
        SEAM(pb + 9);
    }
#undef IN
#undef FRESH
#undef SEAM
}

extern "C" void kernel_launch(void* const* d_in, const int* in_sizes, int n_in, void* d_out, int out_size, void* d_ws, size_t ws_size, hipStream_t stream) {
    static int grid = 0;
    if (grid == 0) {
        if (n_in != 23 || in_sizes[0] != BATCH * SEQ * D || out_size != BATCH * SEQ * D || ws_size < WS_END) {
            fprintf(stderr, "kernel_launch: unexpected shapes (n_in %d, in0 %d, out %d, ws %zu, need %zu); nothing launched\n", n_in, n_in > 0 ? in_sizes[0] : -1, out_size, ws_size, (size_t)WS_END); grid = -1; return; }
        int dev = 0, cus = 0;
        if (hipGetDevice(&dev) != hipSuccess || hipDeviceGetAttribute(&cus, hipDeviceAttributeMultiprocessorCount, dev) != hipSuccess) { grid = -1; return; }
        if (hipFuncSetAttribute((const void*)fwd, hipFuncAttributeMaxDynamicSharedMemorySize, LDS_BYTES) != hipSuccess) { fprintf(stderr, "kernel_launch: hipFuncSetAttribute failed\n"); grid = -1; return; }
        int per_cu = 0; (void)hipOccupancyMaxActiveBlocksPerMultiprocessor(&per_cu, (const void*)fwd, NTHR, LDS_BYTES); (void)hipGetLastError();
        grid = cus;
    }
    if (grid < 0) return;
    if (hipMemsetAsync((char*)d_ws + WS_CTL, 0, CTL_ZERO_BYTES, stream) != hipSuccess) return;
    P a{};
    for (int i = 0; i < 23; ++i) a.in[i] = (const float*)d_in[i];
    a.out = (float*)d_out; a.ws = (unsigned char*)d_ws;
#if MK_SINGLE
    a.ph_lo = 0; a.ph_hi = NPHASES;
    hipLaunchKernelGGL(fwd, dim3(grid), dim3(NTHR), LDS_BYTES, stream, a);
#else
    for (int ph = 0; ph < NPHASES; ++ph) { a.ph_lo = ph; a.ph_hi = ph + 1; hipLaunchKernelGGL(fwd, dim3(grid), dim3(NTHR), LDS_BYTES, stream, a); }
#endif
}
```

```cpp
#include <hip/hip_runtime.h>
#include <cstdio>
#include <cstdint>
#ifndef MK_SINGLE
#define MK_SINGLE 1
#endif
namespace pg8 {
#define PG8_LAS __attribute__((address_space(3)))
typedef unsigned short bf16_t;
typedef short bf16x8 __attribute__((ext_vector_type(8)));
typedef float f32x4 __attribute__((ext_vector_type(4)));
typedef unsigned u32x4 __attribute__((ext_vector_type(4)));
typedef unsigned u32x2 __attribute__((ext_vector_type(2)));
constexpr int BM = 256, BK = 64, HALF = 128, HTB = HALF * BK * 2  , STAGE_BYTES = 8 * HTB, NXCD = 8, WGM = 8;
__host__ __device__ __forceinline__ int lds_byte(int r, int c) { const int st = (r >> 4) * 2 + (c >> 5), rr = r & 15, cc = c & 31, ob = rr * 64 + cc * 2; return st * 1024 + (ob ^ (((ob >> 9) & 1) << 5)); }
__host__ __device__ __forceinline__ void stage_rc(int b, int& R, int& C) { const int st = b / 1024, sb = b % 1024, swz = sb ^ (((sb >> 9) & 1) << 5); R = (st >> 1) * 16 + swz / 64; C = (st & 1) * 32 + (swz % 64) / 2; }
__host__ __device__ __forceinline__ int perm32(int rho) { const int n = rho >> 4, i = rho & 15; return 8 * (i >> 2) + 4 * n + (i & 3); }
struct Unit { int pm, pn, e, kind; const char* A; const char* B; };
__device__ __forceinline__ unsigned cvt_pk_bf16(float lo, float hi) { unsigned r; asm volatile("v_cvt_pk_bf16_f32 %0, %1, %2" : "=v"(r) : "v"(lo), "v"(hi)); return r; }
template <class Epi, class Sched, bool ALIGN_EPI = false, bool SP2 = false>
__device__ __forceinline__ void gemm_phase(PG8_LAS unsigned char* lds, const int K, const Sched& S, const Epi& E) {
    int tid_ = threadIdx.x; asm volatile("" : "+v"(tid_));
    const int tid = tid_, wid = __builtin_amdgcn_readfirstlane(tid >> 6), lane = tid & 63, wr = wid >> 2, wc = wid & 3, fr = lane & 15, fq = lane >> 4;
    const int nt = K / BK;
    unsigned voffA[2], voffB[2];
#pragma unroll
    for (int i = 0; i < 2; ++i) { int R, C; stage_rc(tid * 16 + i * 8192, R, C); const int Rb = Epi::PERM ? ((R & ~31) + perm32(R & 31)) : R;
        voffA[i] = (unsigned)(R * K + C) * 2u; voffB[i] = (unsigned)(Rb * K + C) * 2u; }
    const size_t kstep = (size_t)(BK * 2);
    const size_t hstep = (size_t)HALF * K * 2;
    const size_t tstep = 2 * hstep;
    const unsigned ldsw = (unsigned)wid * 1024u;
    const int aoff = lds_byte(wr * 64 + fr, fq * 8), boff = lds_byte(wc * 32 + fr, fq * 8);
#define PG8_SA(b, h) (((b) * 2 + (h)) * HTB)
#define PG8_SB(b, h) ((4 + (b) * 2 + (h)) * HTB)
#define PG8_STAGE(bufoff, gbase, voff) do { _Pragma("unroll") for (int _i = 0; _i < 2; ++_i) \
        __builtin_amdgcn_global_load_lds((const unsigned*)((const char*)(gbase) + (voff)[_i]), (PG8_LAS unsigned*)(lds + (bufoff) + ldsw + _i * 8192), 16, 0, 0); } while (0)
#define PG8_LDA(dst, b, h) do { _Pragma("unroll") for (int m = 0; m < 4; ++m) _Pragma("unroll") for (int k = 0; k < 2; ++k) dst[m][k] = *(const PG8_LAS bf16x8*)(lds + PG8_SA(b, h) + aoff + m * 2048 + k * 1024); } while (0)
#define PG8_LDB(dst, b, h) do { _Pragma("unroll") for (int n = 0; n < 2; ++n) _Pragma("unroll") for (int k = 0; k < 2; ++k) dst[n][k] = *(const PG8_LAS bf16x8*)(lds + PG8_SB(b, h) + boff + n * 2048 + k * 1024); } while (0)
#define PG8_MMA(ai, bj, At, Bt) do { __builtin_amdgcn_s_setprio(1); _Pragma("unroll") for (int m = 0; m < 4; ++m) _Pragma("unroll") for (int n = 0; n < 2; ++n) _Pragma("unroll") for (int k = 0; k < 2; ++k) \
        acc[ai][bj][m][n] = __builtin_amdgcn_mfma_f32_16x16x32_bf16(Bt[n][k], At[m][k], acc[ai][bj][m][n], 0, 0, 0); __builtin_amdgcn_s_setprio(0); } while (0)
#define PG8_WAIT_V(n) asm volatile("s_waitcnt vmcnt(" #n ")" ::: "memory")
#define PG8_WAIT_L(n) asm volatile("s_waitcnt lgkmcnt(" #n ")" ::: "memory")
#define PG8_BAR __builtin_amdgcn_s_barrier()
#define PG8_SCHED __builtin_amdgcn_sched_barrier(0)
    Unit cur, nxt; int ui = 0;
    if (!S.next(0, cur)) return;
    f32x4 acc[2][2][4][2];
#pragma unroll
    for (int a = 0; a < 2; ++a)
#pragma unroll
        for (int b = 0; b < 2; ++b)
#pragma unroll
            for (int m = 0; m < 4; ++m)
#pragma unroll
                for (int n = 0; n < 2; ++n) acc[a][b][m][n] = (f32x4){0.f, 0.f, 0.f, 0.f};
    bf16x8 At[4][2], B0[2][2], B1[2][2];
    const char* cA = cur.A; const char* cB = cur.B;
    S.a_ready(cur);
    if constexpr (SP2) {
        PG8_STAGE(PG8_SB(0, 0), cB, voffB); PG8_STAGE(PG8_SB(0, 1), cB + hstep, voffB); PG8_STAGE(PG8_SA(0, 0), cA, voffA); PG8_STAGE(PG8_SA(0, 1), cA + hstep, voffA);
        if (wr == 1) PG8_BAR;
        PG8_WAIT_V(2); PG8_BAR;
        PG8_STAGE(PG8_SB(1, 0), cB + kstep, voffB); PG8_STAGE(PG8_SA(1, 0), cA + kstep, voffA); PG8_STAGE(PG8_SB(1, 1), cB + hstep + kstep, voffB);
        PG8_WAIT_V(6); PG8_BAR;
    } else {
        PG8_STAGE(PG8_SB(0, 0), cB, voffB); PG8_STAGE(PG8_SA(0, 0), cA, voffA); PG8_STAGE(PG8_SB(0, 1), cB + hstep, voffB); PG8_STAGE(PG8_SA(0, 1), cA + hstep, voffA);
        if (wr == 1) PG8_BAR;
        PG8_WAIT_V(4); PG8_BAR;
        PG8_STAGE(PG8_SB(1, 0), cB + kstep, voffB); PG8_STAGE(PG8_SA(1, 0), cA + kstep, voffA); PG8_STAGE(PG8_SB(1, 1), cB + hstep + kstep, voffB);
        PG8_WAIT_V(6); PG8_BAR;
    }
    for (;;) {
        const bool has_next = S.next(ui + 1, nxt);
        const char* nA = has_next ? nxt.A : cA; const char* nB = has_next ? nxt.B : cB;
        for (int t = 0; t < nt; t += 2) {
            const bool last = (t == nt - 2);
            const char* a1 = cA + (size_t)(t + 1) * kstep;
            const char* a2 = last ? nA : cA + (size_t)(t + 2) * kstep; const char* b2 = last ? nB : cB + (size_t)(t + 2) * kstep;
            const char* a3 = a2 + kstep; const char* b3 = b2 + kstep;
            if (last && has_next) S.a_ready(nxt);
            if constexpr (SP2) {
            PG8_LDB(B0, 0, 0); PG8_LDB(B1, 0, 1); PG8_SCHED; PG8_LDA(At, 0, 0); PG8_STAGE(PG8_SA(1, 1), a1 + hstep, voffA);
            PG8_WAIT_V(8); PG8_WAIT_L(0); PG8_BAR; PG8_MMA(0, 0, At, B0); PG8_MMA(0, 1, At, B1); PG8_BAR; PG8_SCHED;
            PG8_LDA(At, 0, 1); PG8_STAGE(PG8_SB(0, 0), b2, voffB); PG8_STAGE(PG8_SB(0, 1), b2 + hstep, voffB); PG8_STAGE(PG8_SA(0, 0), a2, voffA);
            PG8_WAIT_V(8); PG8_WAIT_L(0); PG8_BAR; PG8_MMA(1, 0, At, B0); PG8_MMA(1, 1, At, B1); PG8_BAR; PG8_SCHED;
            PG8_LDB(B0, 1, 0); PG8_LDB(B1, 1, 1); PG8_SCHED; PG8_LDA(At, 1, 0); PG8_STAGE(PG8_SA(0, 1), a2 + hstep, voffA);
            PG8_WAIT_V(8); PG8_WAIT_L(0); PG8_BAR; PG8_MMA(0, 0, At, B0); PG8_MMA(0, 1, At, B1); PG8_BAR; PG8_SCHED;
            PG8_LDA(At, 1, 1); PG8_STAGE(PG8_SB(1, 0), b3, voffB); PG8_STAGE(PG8_SB(1, 1), b3 + hstep, voffB); PG8_STAGE(PG8_SA(1, 0), a3, voffA);
            PG8_WAIT_V(8); PG8_WAIT_L(0); PG8_BAR; PG8_MMA(1, 0, At, B0); PG8_MMA(1, 1, At, B1); PG8_BAR; PG8_SCHED;
            } else {
            PG8_LDB(B0, 0, 0); PG8_SCHED; PG8_LDA(At, 0, 0); PG8_STAGE(PG8_SA(1, 1), a1 + hstep, voffA);
            PG8_WAIT_L(8); PG8_BAR; PG8_WAIT_L(0); PG8_MMA(0, 0, At, B0); PG8_BAR; PG8_SCHED;
            PG8_LDB(B1, 0, 1); PG8_STAGE(PG8_SB(0, 0), b2, voffB);
            PG8_BAR; PG8_WAIT_L(0); PG8_MMA(0, 1, At, B1); PG8_BAR;
            PG8_LDA(At, 0, 1); PG8_STAGE(PG8_SA(0, 0), a2, voffA);
            PG8_BAR; PG8_WAIT_L(0); PG8_MMA(1, 0, At, B0); PG8_BAR; PG8_SCHED;
            PG8_STAGE(PG8_SB(0, 1), b2 + hstep, voffB);
            PG8_WAIT_V(6); PG8_BAR; PG8_MMA(1, 1, At, B1); PG8_BAR;
            PG8_LDB(B0, 1, 0); PG8_SCHED; PG8_LDA(At, 1, 0); PG8_STAGE(PG8_SA(0, 1), a2 + hstep, voffA);
            PG8_WAIT_L(8); PG8_BAR; PG8_WAIT_L(0); PG8_MMA(0, 0, At, B0); PG8_BAR; PG8_SCHED;
            PG8_LDB(B1, 1, 1); PG8_STAGE(PG8_SB(1, 0), b3, voffB);
            PG8_BAR; PG8_WAIT_L(0); PG8_MMA(0, 1, At, B1); PG8_BAR;
            PG8_LDA(At, 1, 1); PG8_STAGE(PG8_SA(1, 0), a3, voffA);
            PG8_BAR; PG8_WAIT_L(0); PG8_MMA(1, 0, At, B0); PG8_BAR; PG8_SCHED;
            PG8_STAGE(PG8_SB(1, 1), b3 + hstep, voffB);
            PG8_WAIT_V(6); PG8_BAR; PG8_MMA(1, 1, At, B1); PG8_BAR;
            }
        }
        if constexpr (ALIGN_EPI) { if (wr == 0) PG8_BAR; }
        if constexpr (!Epi::AFTER_DRAIN) { E(acc, cur, wr, wc, fr, fq); S.done(cur); }
        if (!has_next) break;
#pragma unroll
        for (int a = 0; a < 2; ++a)
#pragma unroll
            for (int b = 0; b < 2; ++b)
#pragma unroll
                for (int m = 0; m < 4; ++m)
#pragma unroll
                    for (int n = 0; n < 2; ++n) acc[a][b][m][n] = (f32x4){0.f, 0.f, 0.f, 0.f};
        cur = nxt; cA = nA; cB = nB; ++ui;
        if constexpr (ALIGN_EPI) { if (wr == 1) PG8_BAR; }
    }
    PG8_WAIT_V(0);
    if constexpr (!ALIGN_EPI) { if (wr == 0) PG8_BAR; }
    PG8_BAR;
    if constexpr (Epi::AFTER_DRAIN) { E.fused(acc, cur, wr, wc, fr, fq, lds, wid, lane); S.done(cur); }
#undef PG8_SA
#undef PG8_SB
#undef PG8_STAGE
#undef PG8_LDA
#undef PG8_LDB
#undef PG8_MMA
#undef PG8_WAIT_V
#undef PG8_WAIT_L
#undef PG8_BAR
#undef PG8_SCHED
}
}

constexpr int D = 1024, BATCH = 32, SEQ = 2048, NMETA = 16, CIN = 7696;
constexpr int NB = 8, NG = BATCH / NB, TOK = NB * SEQ;
constexpr int C_QG = 0, C_KG = 1024, C_VG = 2048, C_ZG = 3072, C_BG = 4096, C_AG = 4104, C_QS = 4112, C_KS = 5136, C_VS = 5392, C_GG = 5648, C_GS = 6672;
constexpr int N1 = 7680;
constexpr int NEXP = 32, TOPK = 4, DFF = 1024, NHG = 8, NHQ = 16, NHK = 4;
constexpr int NASG = TOK * TOPK, MAXROWS = NASG + NEXP * 256, MAXTILES = MAXROWS / 256;
constexpr float LN_EPS = 1e-5f, RMS_EPS = 1e-6f;
constexpr float DN_ALPHA = 1.189207115002721f;
constexpr int NWAVES = 8, NTHR = 512;
constexpr size_t MiB = 1u << 20;
constexpr size_t WS_CTL = 0, CTL_ZERO_BYTES = 64 * 1024;
constexpr size_t WS_PM = 1 * MiB, WS_S1 = 2 * MiB, WS_WIN = 3 * MiB, WS_WBG = 18 * MiB, WS_WBS = 20 * MiB, WS_WOUT = 22 * MiB, WS_W1 = 24 * MiB, WS_W2 = 152 * MiB;
constexpr size_t WS_H1 = 216 * MiB, WS_TOPI = 248 * MiB, WS_TOPW = WS_TOPI + 256 * 1024, WS_RANK = WS_TOPW + 256 * 1024, WS_SLOT = WS_RANK + 256 * 1024;
constexpr size_t WS_ROWW = 249 * MiB, WS_BETA = 250 * MiB, WS_LOGG = WS_BETA + 512 * 1024;
constexpr size_t GR = 252 * MiB;
constexpr size_t WS_H0 = GR, WS_QKVG = GR + 32 * MiB, WS_ZS = GR + 128 * MiB, WS_QS = GR + 160 * MiB, WS_KS = GR + 192 * MiB, WS_VS = GR + 200 * MiB;
constexpr size_t WS_SG = GR + 208 * MiB, WS_SS = GR + 240 * MiB, WS_OG = GR + 272 * MiB, WS_OSW = GR + 304 * MiB, WS_Y = GR + 336 * MiB, WS_PRE1 = GR + 368 * MiB;
constexpr size_t WS_XS = GR, WS_HID = GR + 144 * MiB, WS_YS = GR + 288 * MiB;
constexpr size_t WS_END = GR + 576 * MiB;
static_assert((size_t)MAXROWS * 2048 == 144 * MiB, "moe row buffers");
constexpr int CW_TMO = 0, CW_BAR = 4096, CW_CNT = 8192;
constexpr int RING_BYTES = 131072, MISC_OFF = RING_BYTES, LDS_BYTES = 147456;
constexpr int MI_OFF = 16, MI_TE = 64;

#define GAS __attribute__((address_space(1)))
#define LAS __attribute__((address_space(3)))
typedef unsigned short bf16_t;
typedef float f32x4 __attribute__((ext_vector_type(4)));
typedef float f32x2 __attribute__((ext_vector_type(2)));
typedef unsigned u32x4 __attribute__((ext_vector_type(4)));
typedef unsigned u32x2 __attribute__((ext_vector_type(2)));
#define LDS_WAIT() asm volatile("s_waitcnt lgkmcnt(0)" ::: "memory")
#define VM_WAIT() asm volatile("s_waitcnt vmcnt(0)" ::: "memory")
__device__ __forceinline__ unsigned f2bf(float f) { unsigned u = __builtin_bit_cast(unsigned, f); return (u + 0x7fffu + ((u >> 16) & 1u)) >> 16; }
__device__ __forceinline__ unsigned pk2(float lo, float hi) { return f2bf(lo) | (f2bf(hi) << 16); }
__device__ __forceinline__ float bflo(unsigned w) { return __builtin_bit_cast(float, w << 16); }
__device__ __forceinline__ float bfhi(unsigned w) { return __builtin_bit_cast(float, w & 0xffff0000u); }
__device__ __forceinline__ float bf1(bf16_t h) { return __builtin_bit_cast(float, (unsigned)h << 16); }
__device__ __forceinline__ float fexp(float x) { return __builtin_amdgcn_exp2f(x * 1.4426950408889634f); }
__device__ __forceinline__ float frcp(float x) { return __builtin_amdgcn_rcpf(x); }
__device__ __forceinline__ float frsq(float x) { return __builtin_amdgcn_rsqf(x); }
__device__ __forceinline__ float sigmoidf_(float x) { return frcp(1.0f + fexp(-x)); }
__device__ __forceinline__ float siluf_(float x) { return x * frcp(1.0f + fexp(-x)); }
__device__ __forceinline__ float softplusf_(float x) { const float e = fexp(-fabsf(x)); const float l = e < 1e-3f ? e * (1.0f - 0.5f * e) : __builtin_amdgcn_logf(1.0f + e) * 0.6931471805599453f; return fmaxf(x, 0.f) + l; }
__device__ __forceinline__ float wave_sum(float v) {
#pragma unroll
    for (int o = 1; o < 64; o <<= 1) v += __shfl_xor(v, o);
    return v;
}

#define XB_TMO      128
#define XB_XCNT(j)  (256  + 64 * (j))
#define XB_XSUB(j)  (1280 + 64 * (j))
#define XB_XGEN(j)  (2304 + 64 * (j))
#define XB_TOP      3328
#define XB_TOPGEN   3392
#define XCD_BAR_WORDS 3456
#define XB_SPIN_CAP (1u << 18)
__device__ __forceinline__ unsigned xb_ld(unsigned* p)              { return __hip_atomic_load(p, __ATOMIC_RELAXED, __HIP_MEMORY_SCOPE_AGENT); }
__device__ __forceinline__ unsigned xb_add(unsigned* p, unsigned v) { return __hip_atomic_fetch_add(p, v, __ATOMIC_RELAXED, __HIP_MEMORY_SCOPE_AGENT); }
__device__ __forceinline__ unsigned xb_xcc_id() { return (unsigned)__builtin_amdgcn_s_getreg((3 << 11) | 20) & 0xFu; }
#define XB_SPIN(cond, bar) do { unsigned _sp = 0; while (cond) { __builtin_amdgcn_s_sleep(1); \
    if ((++_sp & 255u) == 0u) { if (xb_ld(&(bar)[XB_TMO])) break; if (_sp > XB_SPIN_CAP) { atomicAdd(&(bar)[XB_TMO], 1u); break; } } } } while (0)
struct XcdBarrier { unsigned* bar; unsigned x; volatile LAS unsigned* st; };
__device__ __forceinline__ XcdBarrier xcd_barrier_post(unsigned* bar, volatile LAS unsigned* st) {
    XcdBarrier b; b.bar = bar; b.x = xb_xcc_id(); b.st = st;
    if (threadIdx.x == 0) (void)xb_add(&bar[XB_XCNT(b.x)], 1u);
    return b;
}
__device__ __forceinline__ void xcd_barrier_complete(unsigned* bar, unsigned x, unsigned& nloc, unsigned& nx) {
    const unsigned G = gridDim.x * gridDim.y * gridDim.z;
    unsigned sum, cnt, mine, sp = 0u;
    for (;;) {
        sum = 0u; cnt = 0u; mine = 0u;
#pragma unroll
        for (unsigned j = 0; j < 16; ++j) { const unsigned c = xb_ld(&bar[XB_XCNT(j)]); sum += c; cnt += (c > 0u) ? 1u : 0u; mine = (j == x) ? c : mine; }
        if (sum == G) break;
        __builtin_amdgcn_s_sleep(1);
        if ((++sp & 255u) == 0u) { if (xb_ld(&bar[XB_TMO])) break; if (sp > XB_SPIN_CAP) { atomicAdd(&bar[XB_TMO], 1u); break; } }
    }
    nloc = mine > 0u ? mine : 1u; nx = cnt > 0u ? cnt : 1u;
}
__device__ __forceinline__ void xcd_barrier(const XcdBarrier& b) {
    asm volatile("s_waitcnt vmcnt(0)" ::: "memory");
    __syncthreads();
    if (threadIdx.x == 0) {
        unsigned* bar = b.bar;
        __builtin_amdgcn_s_waitcnt(0);
        unsigned nloc = b.st[0], nx = b.st[1];
        if (nloc == 0u) { xcd_barrier_complete(bar, b.x, nloc, nx); b.st[0] = nloc; b.st[1] = nx; }
        const unsigned old = xb_add(&bar[XB_XSUB(b.x)], 1u);
        const unsigned gen = old / nloc;
        if (old + 1u == (gen + 1u) * nloc) {
            __builtin_amdgcn_fence(__ATOMIC_RELEASE, "agent");
            asm volatile("s_waitcnt vmcnt(0)" ::: "memory");
            const unsigned og = xb_add(&bar[XB_TOP], 1u);
            const unsigned tg = og / nx;
            if (og + 1u == (tg + 1u) * nx) xb_add(&bar[XB_TOPGEN], 1u);
            else XB_SPIN(xb_ld(&bar[XB_TOPGEN]) == tg, bar);
            __builtin_amdgcn_fence(__ATOMIC_ACQUIRE, "agent");
            xb_add(&bar[XB_XGEN(b.x)], 1u);
            asm volatile("s_waitcnt vmcnt(0)" ::: "memory");
        } else {
            XB_SPIN(xb_ld(&bar[XB_XGEN(b.x)]) == gen, bar);
            __builtin_amdgcn_fence(__ATOMIC_ACQUIRE, "agent");
            asm volatile("s_waitcnt vmcnt(0)" ::: "memory");
        }
    }
    __syncthreads();
}

struct P { const float* in[23]; float* out; unsigned char* ws; int ph_lo, ph_hi; };
enum { I_X = 0, I_META, I_ELG, I_ELB, I_WIN, I_CONVW, I_ALOG, I_DTB, I_GNW, I_SINK, I_WBG, I_WBS, I_WOUT, I_L1G, I_L1B, I_WR, I_BR, I_W1, I_B1, I_W2, I_B2, I_L2G, I_L2B };

__device__ __forceinline__ void std_tile(int L, int nwg, int nM, int nN, int& pm, int& pn) {
    int wgid = L; { const int q = nwg / pg8::NXCD, r = nwg % pg8::NXCD, xcd = wgid % pg8::NXCD, off = wgid / pg8::NXCD; wgid = (xcd < r ? xcd * (q + 1) : r * (q + 1) + (xcd - r) * q) + off; }
    const int nig = pg8::WGM * nN, gid = wgid / nig, fm = gid * pg8::WGM, gsz = (nM - fm) < pg8::WGM ? (nM - fm) : pg8::WGM;
    pm = fm + ((wgid % nig) % gsz); pn = (wgid % nig) / gsz;
}
struct SchedStd {
    int nM, nN, nwg, G, c; const char* A; const char* B; size_t tstep;
    __device__ __forceinline__ void init(int M, int N, int K, int G_, int c_, const void* A_, const void* B_) { nM = M / 256; nN = N / 256; nwg = nM * nN; G = G_; c = c_; A = (const char*)A_; B = (const char*)B_; tstep = (size_t)256 * K * 2; }
    __device__ __forceinline__ bool next(int i, pg8::Unit& u) const {
        const int L = i * G + c; if (L >= nwg) return false;
        int pm, pn; std_tile(L, nwg, nM, nN, pm, pn);
        u.pm = pm; u.pn = pn; u.e = 0; u.kind = 0; u.A = A + (size_t)pm * tstep; u.B = B + (size_t)pn * tstep; return true;
    }
    __device__ __forceinline__ void a_ready(const pg8::Unit&) const {}
    __device__ __forceinline__ void done(const pg8::Unit&) const {}
};
struct SchedPair {
    int nM, nN, nwg, G, c; const char *A0, *B0, *A1, *B1; size_t tstep;
    __device__ __forceinline__ void init(int M, int N, int K, int G_, int c_, const void* A0_, const void* B0_, const void* A1_, const void* B1_) { nM = M / 256; nN = N / 256; nwg = nM * nN; G = G_; c = c_;
        A0 = (const char*)A0_; B0 = (const char*)B0_; A1 = (const char*)A1_; B1 = (const char*)B1_; tstep = (size_t)256 * K * 2; }
    __device__ __forceinline__ bool next(int i, pg8::Unit& u) const {
        const int L = (i >> 1) * G + c, kind = i & 1; if (L >= nwg) return false;
        int pm, pn; std_tile(L, nwg, nM, nN, pm, pn);
        u.pm = pm; u.pn = pn; u.e = 0; u.kind = kind; u.A = (kind ? A1 : A0) + (size_t)pm * tstep; u.B = (kind ? B1 : B0) + (size_t)pn * tstep; return true;
    }
    __device__ __forceinline__ void a_ready(const pg8::Unit&) const {}
    __device__ __forceinline__ void done(const pg8::Unit&) const {}
};
struct SchedMoe {
    int nN, nwg, G, c; const char* A; const char* W; size_t tstep, wexp; const volatile LAS unsigned* te;
    __device__ __forceinline__ void init(int ntiles, int N, int K, int G_, int c_, const void* A_, const void* W_, const volatile LAS unsigned* te_) { nN = N / 256; nwg = ntiles * nN; G = G_; c = c_;
        A = (const char*)A_; W = (const char*)W_; tstep = (size_t)256 * K * 2; wexp = (size_t)N * K * 2; te = te_; }
    __device__ __forceinline__ bool next(int i, pg8::Unit& u) const {
        const int L = i * G + c; if (L >= nwg) return false;
        const int rt = L / nN, pn = L - rt * nN; const int e = __builtin_amdgcn_readfirstlane((int)te[rt]);
        u.pm = rt; u.pn = pn; u.e = e; u.kind = 0; u.A = A + (size_t)rt * tstep; u.B = W + (size_t)e * wexp + (size_t)pn * tstep; return true;
    }
    __device__ __forceinline__ void a_ready(const pg8::Unit&) const {}
    __device__ __forceinline__ void done(const pg8::Unit&) const {}
};

using pg8::Unit;
typedef pg8::f32x4 (AccT)[2][2][4][2];
__device__ __forceinline__ u32x4 pack8(f32x4 v0, f32x4 v1) { u32x4 w; w.x = pg8::cvt_pk_bf16(v0[0], v0[1]); w.y = pg8::cvt_pk_bf16(v0[2], v0[3]); w.z = pg8::cvt_pk_bf16(v1[0], v1[1]); w.w = pg8::cvt_pk_bf16(v1[2], v1[3]); return w; }
__device__ __forceinline__ void unpack8(u32x4 w, f32x4& v0, f32x4& v1) { v0 = (f32x4){bflo(w.x), bfhi(w.x), bflo(w.y), bfhi(w.y)}; v1 = (f32x4){bflo(w.z), bfhi(w.z), bflo(w.w), bfhi(w.w)}; }
struct EpiG1 {
    static constexpr bool PERM = true, AFTER_DRAIN = false;
    bf16_t *qkvg, *zs, *qs, *ks, *vs, *sg, *ss;
    __device__ __forceinline__ void operator()(const AccT& acc, const Unit& u, int wr, int wc, int fr, int fq) const {
        const int pn = u.pn; bf16_t* base; int ldc, colt, act = 0; float sc = 1.f;
        if (pn < 12) { base = qkvg; ldc = 3072; colt = pn * 256; }
        else if (pn < 16) { base = zs; ldc = 1024; colt = (pn - 12) * 256; act = 1; }
        else if (pn < 20) { base = qs; ldc = 1024; colt = (pn - 16) * 256; sc = 0.125f; }
        else if (pn == 20) { base = ks; ldc = 256; colt = 0; }
        else if (pn == 21) { base = vs; ldc = 256; colt = 0; }
        else if (pn < 26) { base = sg; ldc = 1024; colt = (pn - 22) * 256; act = 2; }
        else { base = ss; ldc = 1024; colt = (pn - 26) * 256; act = 2; }
        const int row0 = u.pm * 256 + wr * 64 + fr, col0 = colt + wc * 32 + 8 * fq;
#pragma unroll
        for (int ai = 0; ai < 2; ++ai)
#pragma unroll
            for (int m = 0; m < 4; ++m) { bf16_t* rowp = base + (size_t)(row0 + ai * 128 + m * 16) * ldc + col0;
#pragma unroll
                for (int bj = 0; bj < 2; ++bj) { f32x4 v0 = acc[ai][bj][m][0], v1 = acc[ai][bj][m][1];
                    if (act == 1) {
#pragma unroll
                        for (int j = 0; j < 4; ++j) { v0[j] = siluf_(v0[j]); v1[j] = siluf_(v1[j]); } }
                    else if (act == 2) {
#pragma unroll
                        for (int j = 0; j < 4; ++j) { v0[j] = sigmoidf_(v0[j]); v1[j] = sigmoidf_(v1[j]); } }
                    v0 = v0 * sc; v1 = v1 * sc;
                    *(u32x4*)(rowp + bj * 128) = pack8(v0, v1); } }
    }
};
struct EpiBr {
    static constexpr bool PERM = true, AFTER_DRAIN = false;
    const bf16_t *sg, *ss; bf16_t* y;
    __device__ __forceinline__ void operator()(const AccT& acc, const Unit& u, int wr, int wc, int fr, int fq) const {
        const int row0 = u.pm * 256 + wr * 64 + fr, col0 = u.pn * 256 + wc * 32 + 8 * fq; const bf16_t* gate = u.kind ? ss : sg;
#pragma unroll
        for (int ai = 0; ai < 2; ++ai)
#pragma unroll
            for (int m = 0; m < 4; ++m) { const size_t off = (size_t)(row0 + ai * 128 + m * 16) * D + col0;
#pragma unroll
                for (int bj = 0; bj < 2; ++bj) { f32x4 g0, g1; unpack8(*(const u32x4*)(gate + off + bj * 128), g0, g1);
                    f32x4 v0 = acc[ai][bj][m][0] * g0, v1 = acc[ai][bj][m][1] * g1;
                    if (u.kind) { f32x4 y0, y1; unpack8(*(const u32x4*)(y + off + bj * 128), y0, y1); v0 = v0 + y0; v1 = v1 + y1; }
                    *(u32x4*)(y + off + bj * 128) = pack8(v0, v1); } }
    }
};
struct EpiOut {
    static constexpr bool PERM = false, AFTER_DRAIN = false;
    const bf16_t* h0; float* pre1;
    __device__ __forceinline__ void operator()(const AccT& acc, const Unit& u, int wr, int wc, int fr, int fq) const {
        const int row0 = u.pm * 256 + wr * 64 + fr, col0 = u.pn * 256 + wc * 32 + 4 * fq;
#pragma unroll
        for (int ai = 0; ai < 2; ++ai)
#pragma unroll
            for (int m = 0; m < 4; ++m) { const size_t off = (size_t)(row0 + ai * 128 + m * 16) * D + col0;
#pragma unroll
                for (int bj = 0; bj < 2; ++bj)
#pragma unroll
                    for (int n = 0; n < 2; ++n) { const u32x2 hw = *(const u32x2*)(h0 + off + bj * 128 + n * 16);
                        const f32x4 hv = (f32x4){bflo(hw.x), bfhi(hw.x), bflo(hw.y), bfhi(hw.y)};
                        *(f32x4*)(pre1 + off + bj * 128 + n * 16) = hv * DN_ALPHA + acc[ai][bj][m][n]; } }
    }
};
struct EpiMoe1 {
    static constexpr bool PERM = true, AFTER_DRAIN = false;
    const float* b1; bf16_t* hid;
    __device__ __forceinline__ void operator()(const AccT& acc, const Unit& u, int wr, int wc, int fr, int fq) const {
        const int row0 = u.pm * 256 + wr * 64 + fr, j0 = u.pn * 128 + wc * 32 + 8 * fq; const float* bb = b1 + (size_t)u.e * 2048 + j0;
        const f32x4 bg0 = *(const f32x4*)(bb), bg1 = *(const f32x4*)(bb + 4), bu0 = *(const f32x4*)(bb + 1024), bu1 = *(const f32x4*)(bb + 1028);
#pragma unroll
        for (int ai = 0; ai < 2; ++ai)
#pragma unroll
            for (int m = 0; m < 4; ++m) { f32x4 o[2];
#pragma unroll
                for (int n = 0; n < 2; ++n) { const f32x4 g = acc[ai][0][m][n] + (n ? bg1 : bg0), up = acc[ai][1][m][n] + (n ? bu1 : bu0);
#pragma unroll
                    for (int j = 0; j < 4; ++j) { const float gg = fminf(g[j], 7.0f), uu = fminf(fmaxf(up[j], -7.0f), 7.0f); o[n][j] = gg * sigmoidf_(1.702f * gg) * (uu + 1.0f); } }
                *(u32x4*)(hid + (size_t)(row0 + ai * 128 + m * 16) * DFF + j0) = pack8(o[0], o[1]); }
    }
};
struct EpiMoe2 {
    static constexpr bool PERM = true, AFTER_DRAIN = false;
    const float* b2; const float* roww; bf16_t* ys;
    __device__ __forceinline__ void operator()(const AccT& acc, const Unit& u, int wr, int wc, int fr, int fq) const {
        const int row0 = u.pm * 256 + wr * 64 + fr, col0 = u.pn * 256 + wc * 32 + 8 * fq; const float* bb = b2 + (size_t)u.e * D + col0;
        f32x4 bv[2][2];
#pragma unroll
        for (int bj = 0; bj < 2; ++bj)
#pragma unroll
            for (int n = 0; n < 2; ++n) bv[bj][n] = *(const f32x4*)(bb + bj * 128 + 4 * n);
#pragma unroll
        for (int ai = 0; ai < 2; ++ai)
#pragma unroll
            for (int m = 0; m < 4; ++m) { const int row = row0 + ai * 128 + m * 16; const float w = roww[row];
#pragma unroll
                for (int bj = 0; bj < 2; ++bj) *(u32x4*)(ys + (size_t)row * D + col0 + bj * 128) = pack8((acc[ai][bj][m][0] + bv[bj][0]) * w, (acc[ai][bj][m][1] + bv[bj][1]) * w); }
    }
};

struct Ctx { LAS unsigned char* lds; volatile LAS unsigned* MISC; int tid, lane, wave, G, gw, NGW; unsigned char* ws; };

__device__ __forceinline__ void transpose_item(const float* W, int ldw, int k0, int srccol, bf16_t* WT, int ldt, int dstrow, LAS float* scr, int lane) {
#pragma unroll 8
    for (int i = 0; i < 32; ++i) { const int kk = 2 * i + (lane >> 5); scr[kk * 33 + (lane & 31)] = W[(size_t)(k0 + kk) * ldw + srccol + (lane & 31)]; }
    LDS_WAIT(); asm volatile("" ::: "memory");
    const int c = lane & 7;
#pragma unroll
    for (int j = 0; j < 4; ++j) { const int n = (lane >> 3) + 8 * j; const LAS float* s = scr + (8 * c) * 33 + n;
        u32x4 o; o.x = pk2(s[0 * 33], s[1 * 33]); o.y = pk2(s[2 * 33], s[3 * 33]); o.z = pk2(s[4 * 33], s[5 * 33]); o.w = pk2(s[6 * 33], s[7 * 33]);
        *(u32x4*)(WT + (size_t)(dstrow + n) * ldt + k0 + 8 * c) = o; }
    LDS_WAIT(); asm volatile("" ::: "memory");
}
__device__ __forceinline__ void ln_row(const float* xrow, const float* gam, const float* bet, int lane, f32x4 (&y)[4]) {
    const f32x4* xr = (const f32x4*)xrow + lane; float s = 0.f;
#pragma unroll
    for (int j = 0; j < 4; ++j) { y[j] = xr[64 * j]; s += (y[j].x + y[j].y) + (y[j].z + y[j].w); }
    const float mean = wave_sum(s) * (1.f / D); float s2 = 0.f;
#pragma unroll
    for (int j = 0; j < 4; ++j) { y[j] = y[j] - mean; s2 += (y[j].x * y[j].x + y[j].y * y[j].y) + (y[j].z * y[j].z + y[j].w * y[j].w); }
    const float rstd = frsq(wave_sum(s2) * (1.f / D) + LN_EPS);
#pragma unroll
    for (int j = 0; j < 4; ++j) { const f32x4 gv = ((const f32x4*)gam)[lane + 64 * j], bv = ((const f32x4*)bet)[lane + 64 * j]; y[j] = y[j] * rstd * gv + bv; }
}
__device__ __forceinline__ void store_row_bf16(bf16_t* orow, int lane, const f32x4 (&y)[4]) {
    u32x2* o8 = (u32x2*)orow + lane;
#pragma unroll
    for (int j = 0; j < 4; ++j) { u32x2 w; w.x = pk2(y[j].x, y[j].y); w.y = pk2(y[j].z, y[j].w); o8[64 * j] = w; }
}
__device__ __forceinline__ void phase_prep(const P& p, const Ctx& c) {
    const float* w_in = p.in[I_WIN];
    if ((int)blockIdx.x * 32 < CIN) {
        LAS float* h0m = (LAS float*)c.lds; LAS float* red = (LAS float*)(c.lds + 65536);
#pragma unroll
        for (int rr = 0; rr < 2; ++rr) { const int m = 2 * c.wave + rr; f32x4 y[4]; ln_row(p.in[I_META] + (size_t)m * D, p.in[I_ELG], p.in[I_ELB], c.lane, y);
#pragma unroll
            for (int j = 0; j < 4; ++j) *(LAS f32x4*)(h0m + m * D + 4 * c.lane + 256 * j) = y[j]; }
        __syncthreads();
        const int cc = c.tid & 31, ks = c.tid >> 5, col = blockIdx.x * 32 + cc; float acc[16];
#pragma unroll
        for (int m = 0; m < 16; ++m) acc[m] = 0.f;
        if (col < CIN) for (int k = ks * 64; k < ks * 64 + 64; ++k) { const float w = w_in[(size_t)k * CIN + col];
#pragma unroll
            for (int m = 0; m < 16; ++m) acc[m] += h0m[m * D + k] * w; }
#pragma unroll
        for (int m = 0; m < 16; ++m) red[(ks * 16 + m) * 32 + cc] = acc[m];
        __syncthreads();
        { const int m = c.tid >> 5; float s = 0.f;
#pragma unroll
          for (int k2 = 0; k2 < 16; ++k2) s += red[(k2 * 16 + m) * 32 + cc];
          if (col < CIN) ((float*)(c.ws + WS_PM))[(size_t)m * CIN + col] = s; }
        __syncthreads();
    }
    LAS float* scr = (LAS float*)(c.lds + c.wave * 16384);
    constexpr int I_IN = 240 * 16, I_SQ = 512, I_1 = 32 * 1024, I_2 = 32 * 512, NITEMS = I_IN + 3 * I_SQ + I_1 + I_2;
    bf16_t* WIN = (bf16_t*)(c.ws + WS_WIN);
    for (int it = c.gw; it < NITEMS; it += c.NGW) {
        int r = it;
        if (r < I_IN) { const int nb = r % 240, kb = r / 240, dr = 32 * nb; transpose_item(w_in, CIN, 64 * kb, dr < 4096 ? dr : dr + 16, WIN, D, dr, scr, c.lane); continue; } r -= I_IN;
        if (r < I_SQ) { const int nb = r % 32, kb = r / 32; transpose_item(p.in[I_WBG], D, 64 * kb, 32 * nb, (bf16_t*)(c.ws + WS_WBG), D, 32 * nb, scr, c.lane); continue; } r -= I_SQ;
        if (r < I_SQ) { const int nb = r % 32, kb = r / 32; transpose_item(p.in[I_WBS], D, 64 * kb, 32 * nb, (bf16_t*)(c.ws + WS_WBS), D, 32 * nb, scr, c.lane); continue; } r -= I_SQ;
        if (r < I_SQ) { const int nb = r % 32, kb = r / 32; transpose_item(p.in[I_WOUT], D, 64 * kb, 32 * nb, (bf16_t*)(c.ws + WS_WOUT), D, 32 * nb, scr, c.lane); continue; } r -= I_SQ;
        if (r < I_1) { const int e = r / 1024, q = r % 1024, nb = q % 64, kb = q / 64, dr = 32 * nb; const int src = ((dr >> 7) & 1) * 1024 + (dr >> 8) * 128 + (dr & 127);
            transpose_item(p.in[I_W1] + (size_t)e * D * 2048, 2048, 64 * kb, src, (bf16_t*)(c.ws + WS_W1) + (size_t)e * 2048 * D, D, dr, scr, c.lane); continue; } r -= I_1;
        { const int e = r / 512, q = r % 512, nb = q % 32, kb = q / 32;
            transpose_item(p.in[I_W2] + (size_t)e * DFF * D, D, 64 * kb, 32 * nb, (bf16_t*)(c.ws + WS_W2) + (size_t)e * D * DFF, DFF, 32 * nb, scr, c.lane); }
    }
}

__device__ __forceinline__ void conv8(const float (&w)[8][4], const float (&r)[4][8], float (&y)[8]) {
#pragma unroll
    for (int j = 0; j < 8; ++j) { const float a = w[j][0] * r[0][j] + w[j][1] * r[1][j] + w[j][2] * r[2][j] + w[j][3] * r[3][j]; y[j] = siluf_(a); }
}
__device__ __forceinline__ void meta_state(const P& p, const Ctx& c, int h, LAS unsigned char* lb) {
    LAS float* kf = (LAS float*)lb; LAS float* vf = kf + 16 * 128; LAS float* red = vf + 16 * 128; LAS float* bet = red + 2 * 4 * 128; LAS float* gg = bet + 16;
    const float* PM = (const float*)(c.ws + WS_PM); const float* cw = p.in[I_CONVW];
    { const int tl = c.tid >> 5, cg = c.tid & 31; float kk[4], vv[4]; float ss = 0.f;
#pragma unroll
      for (int j = 0; j < 4; ++j) { const int ch = h * 128 + 4 * cg + j; float ak = 0.f, av = 0.f;
#pragma unroll
          for (int i = 0; i < 4; ++i) { const int tt = tl - 3 + i; if (tt >= 0) { ak += cw[(size_t)(1024 + ch) * 4 + i] * PM[(size_t)tt * CIN + C_KG + ch]; av += cw[(size_t)(2048 + ch) * 4 + i] * PM[(size_t)tt * CIN + C_VG + ch]; } }
          kk[j] = siluf_(ak); vv[j] = siluf_(av); ss += kk[j] * kk[j]; }
#pragma unroll
      for (int o = 1; o < 32; o <<= 1) ss += __shfl_xor(ss, o);
      const float rn = frsq(ss + RMS_EPS);
#pragma unroll
      for (int j = 0; j < 4; ++j) { kf[tl * 128 + 4 * cg + j] = kk[j] * rn; vf[tl * 128 + 4 * cg + j] = vv[j]; }
      if (cg == 0) { bet[tl] = sigmoidf_(PM[(size_t)tl * CIN + C_BG + h]); gg[tl] = fexp(-fexp(p.in[I_ALOG][h]) * softplusf_(PM[(size_t)tl * CIN + C_AG + h] + p.in[I_DTB][h])); } }
    __syncthreads();
    float S[32];
#pragma unroll
    for (int k = 0; k < 32; ++k) S[k] = 0.f;
    const int v = c.tid & 127, rg = c.tid >> 7;
#pragma unroll 1
    for (int t = 0; t < 16; ++t) { float pk = 0.f;
#pragma unroll
        for (int k = 0; k < 32; ++k) pk += S[k] * kf[t * 128 + rg * 32 + k];
        red[((t & 1) * 4 + rg) * 128 + v] = pk;
        __syncthreads();
        const float sk = (red[((t & 1) * 4 + 0) * 128 + v] + red[((t & 1) * 4 + 1) * 128 + v]) + (red[((t & 1) * 4 + 2) * 128 + v] + red[((t & 1) * 4 + 3) * 128 + v]);
        const float g = gg[t], u = bet[t] * (vf[t * 128 + v] - g * sk);
#pragma unroll
        for (int k = 0; k < 32; ++k) S[k] = g * S[k] + kf[t * 128 + rg * 32 + k] * u; }
    float* S1 = (float*)(c.ws + WS_S1) + (size_t)h * 128 * 128;
#pragma unroll
    for (int k = 0; k < 32; ++k) S1[(rg * 32 + k) * 128 + v] = S[k];
    __syncthreads();
}

__device__ __forceinline__ void phase_ln0(const P& p, Ctx c, int g) {
    LAS float* wba = (LAS float*)c.lds;
    const float* w_in = p.in[I_WIN];
    for (int idx = c.tid; idx < 16 * 1024; idx += NTHR) { const int k = idx >> 4, cc = idx & 15; wba[cc * 1024 + k] = w_in[(size_t)k * CIN + C_BG + cc]; }
    __syncthreads();
#ifndef NO_META
    if (g == 0 && blockIdx.x < NHG) meta_state(p, c, blockIdx.x, c.lds + 65536);
#endif
    asm volatile("" : "+v"(c.tid), "+v"(c.lane));
    bf16_t* H0 = (bf16_t*)(c.ws + WS_H0); float* BETA = (float*)(c.ws + WS_BETA); float* LOGG = (float*)(c.ws + WS_LOGG);
    for (int r = c.gw; r < TOK; r += c.NGW) {
        f32x4 y[4]; ln_row(p.in[I_X] + ((size_t)g * TOK + r) * D, p.in[I_ELG], p.in[I_ELB], c.lane, y);
        store_row_bf16(H0 + (size_t)r * D, c.lane, y);
        float mine = 0.f;
#pragma unroll
        for (int cc = 0; cc < 16; ++cc) { float s = 0.f;
#pragma unroll
            for (int j = 0; j < 4; ++j) { const f32x4 w = *(const LAS f32x4*)(wba + cc * 1024 + 4 * c.lane + 256 * j); s += (y[j].x * w.x + y[j].y * w.y) + (y[j].z * w.z + y[j].w * w.w); }
            s = wave_sum(s); if (c.lane == cc) mine = s; asm volatile("" ::: "memory"); }
        if (c.lane < 8) BETA[(size_t)r * 8 + c.lane] = sigmoidf_(mine);
        else if (c.lane < 16) { const int h = c.lane - 8; LOGG[(size_t)r * 8 + h] = -fexp(p.in[I_ALOG][h]) * softplusf_(mine + p.in[I_DTB][h]); }
    }
}

__device__ __forceinline__ void gdn_feat8(const float* cw, const bf16_t* QKVG, const float* PM, int bl, int tok, int h, int cg, int which, float (&y)[8]) {
    const int ch0 = which * 1024 + h * 128 + 8 * cg; float r[4][8];
#pragma unroll
    for (int i = 0; i < 4; ++i) { const int tt = tok - 3 + i; const int tc = tt < 0 ? 0 : tt;
        f32x4 a0, a1; unpack8(*(const u32x4*)(QKVG + ((size_t)bl * SEQ + tc) * 3072 + ch0), a0, a1);
#pragma unroll
        for (int j = 0; j < 4; ++j) { r[i][j] = a0[j]; r[i][4 + j] = a1[j]; }
        if (tt < 0) { const float* mp = PM + (size_t)(NMETA + tt) * CIN + ch0;
            const f32x4 m0 = *(const f32x4*)mp, m1 = *(const f32x4*)(mp + 4);
#pragma unroll
            for (int j = 0; j < 4; ++j) { r[i][j] = m0[j]; r[i][4 + j] = m1[j]; } } }
#pragma unroll
    for (int j = 0; j < 8; ++j) { const f32x4 w = *(const f32x4*)(cw + (size_t)(ch0 + j) * 4); y[j] = siluf_(w[0] * r[0][j] + w[1] * r[1][j] + w[2] * r[2][j] + w[3] * r[3][j]); }
}
__device__ __forceinline__ void gdn_seq_unit(const P& p, const Ctx& c, int bl, int h) {
    LAS float* qf = (LAS float*)c.lds; LAS float* kf = qf + 32 * 128; LAS float* vf = kf + 32 * 128; LAS float* ob = vf + 32 * 128;
    LAS float* red = ob + 32 * 128; LAS float* bet = red + 2 * 2 * 4 * 128; LAS float* gg = bet + 32; LAS float* kqs = gg + 32;
    const float* PM = (const float*)(c.ws + WS_PM); const float* cw = p.in[I_CONVW];
    const bf16_t* QKVG = (const bf16_t*)(c.ws + WS_QKVG); const bf16_t* ZS = (const bf16_t*)(c.ws + WS_ZS); bf16_t* OG = (bf16_t*)(c.ws + WS_OG);
    const float* BETA = (const float*)(c.ws + WS_BETA); const float* LOGG = (const float*)(c.ws + WS_LOGG);
    const int v = c.tid & 127, rg = c.tid >> 7, tl = c.tid >> 4, cg = c.tid & 15;
    float S[32];
    { const float* S1 = (const float*)(c.ws + WS_S1) + (size_t)h * 128 * 128;
#pragma unroll
      for (int k = 0; k < 32; ++k) S[k] = S1[(rg * 32 + k) * 128 + v]; }
#pragma unroll 1
    for (int t0 = 0; t0 < SEQ; t0 += 32) {
        { const int tok = t0 + tl; const size_t row = (size_t)bl * SEQ + tok; float yq[8], yk[8], yv[8];
          gdn_feat8(cw, QKVG, PM, bl, tok, h, cg, 0, yq); asm volatile("" ::: "memory");
          gdn_feat8(cw, QKVG, PM, bl, tok, h, cg, 1, yk); asm volatile("" ::: "memory");
          gdn_feat8(cw, QKVG, PM, bl, tok, h, cg, 2, yv); asm volatile("" ::: "memory");
          float sq = 0.f, sk = 0.f;
#pragma unroll
          for (int j = 0; j < 8; ++j) { sq += yq[j] * yq[j]; sk += yk[j] * yk[j]; }
#pragma unroll
          for (int o = 1; o < 16; o <<= 1) { sq += __shfl_xor(sq, o); sk += __shfl_xor(sk, o); }
          const float rq_ = 0.08838834764831845f * frsq(sq + RMS_EPS), rk_ = frsq(sk + RMS_EPS); float kq = 0.f;
#pragma unroll
          for (int j = 0; j < 8; ++j) { yq[j] *= rq_; yk[j] *= rk_; kq += yq[j] * yk[j]; qf[tl * 128 + 8 * cg + j] = yq[j]; kf[tl * 128 + 8 * cg + j] = yk[j]; vf[tl * 128 + 8 * cg + j] = yv[j]; }
#pragma unroll
          for (int o = 1; o < 16; o <<= 1) kq += __shfl_xor(kq, o);
          if (cg == 0) { bet[tl] = BETA[row * 8 + h]; gg[tl] = fexp(LOGG[row * 8 + h]); kqs[tl] = kq; } }
        __syncthreads();
#pragma unroll 1
        for (int t = 0; t < 32; ++t) { float pk = 0.f, pq = 0.f; const LAS float* kr = kf + t * 128 + rg * 32; const LAS float* qr = qf + t * 128 + rg * 32;
#pragma unroll
            for (int k = 0; k < 32; ++k) pk += S[k] * kr[k];
            asm volatile("" ::: "memory");
#pragma unroll
            for (int k = 0; k < 32; ++k) pq += S[k] * qr[k];
            asm volatile("" ::: "memory");
            LAS float* rb = red + (t & 1) * 1024; rb[rg * 128 + v] = pk; rb[512 + rg * 128 + v] = pq;
            __syncthreads();
            const float sk = (rb[v] + rb[128 + v]) + (rb[256 + v] + rb[384 + v]), sq = (rb[512 + v] + rb[640 + v]) + (rb[768 + v] + rb[896 + v]);
            const float g = gg[t], u = bet[t] * (vf[t * 128 + v] - g * sk);
            if (rg == 0) ob[t * 128 + v] = g * sq + kqs[t] * u;
            asm volatile("" ::: "memory");
#pragma unroll
            for (int k = 0; k < 32; ++k) S[k] = g * S[k] + kr[k] * u; }
        __syncthreads();
        { const size_t row = (size_t)bl * SEQ + t0 + tl; float o[8]; float ss = 0.f;
#pragma unroll
          for (int j = 0; j < 8; ++j) { o[j] = ob[tl * 128 + 8 * cg + j]; ss += o[j] * o[j]; }
#pragma unroll
          for (int o2 = 1; o2 < 16; o2 <<= 1) ss += __shfl_xor(ss, o2);
          const float rn = frsq(ss * (1.f / 128.f) + RMS_EPS); f32x4 z0, z1; unpack8(*(const u32x4*)(ZS + row * D + h * 128 + 8 * cg), z0, z1);
          const float* nw = p.in[I_GNW] + 8 * cg; f32x4 r0, r1;
#pragma unroll
          for (int j = 0; j < 4; ++j) { r0[j] = o[j] * rn * nw[j] * z0[j]; r1[j] = o[4 + j] * rn * nw[4 + j] * z1[j]; }
          *(u32x4*)(OG + row * D + h * 128 + 8 * cg) = pack8(r0, r1); }
        __syncthreads();
    }
}
__device__ __forceinline__ void swa_naive(const P& p, const Ctx& c, int first_block) {
    const float* PM = (const float*)(c.ws + WS_PM); const bf16_t* QS = (const bf16_t*)(c.ws + WS_QS); const bf16_t* KS = (const bf16_t*)(c.ws + WS_KS); const bf16_t* VS = (const bf16_t*)(c.ws + WS_VS);
    bf16_t* OS = (bf16_t*)(c.ws + WS_OSW);
    const int nthreads = (c.G - first_block) * NTHR;
    for (int idx = ((int)blockIdx.x - first_block) * NTHR + c.tid; idx < TOK * NHQ * 2; idx += nthreads) {
        const int half = idx & 1, hq = (idx >> 1) & 15, row = idx >> 5, hk = hq >> 2, bl = row / SEQ, i = row - bl * SEQ, dofs = hk * 64 + half * 32;
        float q[32], o[32];
#pragma unroll
        for (int d8 = 0; d8 < 4; ++d8) { f32x4 a0, a1; unpack8(*(const u32x4*)(QS + (size_t)row * D + hq * 64 + half * 32 + 8 * d8), a0, a1);
#pragma unroll
            for (int j = 0; j < 4; ++j) { q[8 * d8 + j] = a0[j]; q[8 * d8 + 4 + j] = a1[j]; } }
#pragma unroll
        for (int d = 0; d < 32; ++d) o[d] = 0.f;
        const float slope = __builtin_amdgcn_exp2f(-0.5f * (float)(hq + 1)); float m = p.in[I_SINK][hq], l = 1.0f;
        for (int mt = 0; mt < NMETA; ++mt) { const float* kp = PM + (size_t)mt * CIN + C_KS + dofs; const float* vp = PM + (size_t)mt * CIN + C_VS + dofs; float s = 0.f;
#pragma unroll
            for (int d = 0; d < 32; ++d) s += q[d] * kp[d];
            s += __shfl_xor(s, 1); s -= slope * (float)(NMETA + i - mt); asm volatile("" ::: "memory");
            if (s > m) { const float sc = fexp(m - s); l *= sc;
#pragma unroll
                for (int d = 0; d < 32; ++d) o[d] *= sc;
                m = s; }
            const float pe = fexp(s - m); l += pe;
#pragma unroll
            for (int d = 0; d < 32; ++d) o[d] += pe * vp[d]; }
        for (int j = (i > 127 ? i - 127 : 0); j <= i; ++j) { const bf16_t* kp = KS + ((size_t)bl * SEQ + j) * 256 + dofs; const bf16_t* vp = VS + ((size_t)bl * SEQ + j) * 256 + dofs; float s = 0.f;
#pragma unroll
            for (int d8 = 0; d8 < 4; ++d8) { f32x4 a0, a1; unpack8(*(const u32x4*)(kp + 8 * d8), a0, a1);
#pragma unroll
                for (int jj = 0; jj < 4; ++jj) s += q[8 * d8 + jj] * a0[jj] + q[8 * d8 + 4 + jj] * a1[jj]; }
            s += __shfl_xor(s, 1); s -= slope * (float)(i - j); asm volatile("" ::: "memory");
            if (s > m) { const float sc = fexp(m - s); l *= sc;
#pragma unroll
                for (int d = 0; d < 32; ++d) o[d] *= sc;
                m = s; }
            const float pe = fexp(s - m); l += pe;
#pragma unroll
            for (int d8 = 0; d8 < 4; ++d8) { f32x4 a0, a1; unpack8(*(const u32x4*)(vp + 8 * d8), a0, a1);
#pragma unroll
                for (int jj = 0; jj < 4; ++jj) { o[8 * d8 + jj] += pe * a0[jj]; o[8 * d8 + 4 + jj] += pe * a1[jj]; } } }
        const float il = frcp(l);
#pragma unroll
        for (int d8 = 0; d8 < 4; ++d8) { f32x4 r0, r1;
#pragma unroll
            for (int jj = 0; jj < 4; ++jj) { r0[jj] = o[8 * d8 + jj] * il; r1[jj] = o[8 * d8 + 4 + jj] * il; }
            *(u32x4*)(OS + (size_t)row * D + hq * 64 + half * 32 + 8 * d8) = pack8(r0, r1); }
    }
}

__device__ __forceinline__ void phase_ln1_router(const P& p, const Ctx& c, int g) {
    LAS float* wrT = (LAS float*)c.lds;
    const float* wr = p.in[I_WR];
    for (int idx = c.tid; idx < 32 * 1024; idx += NTHR) { const int k = idx >> 5, e = idx & 31; wrT[e * 1024 + k] = wr[idx]; }
    __syncthreads();
    const float* PRE1 = (const float*)(c.ws + WS_PRE1); bf16_t* H1 = (bf16_t*)(c.ws + WS_H1);
    int* TOPI = (int*)(c.ws + WS_TOPI); float* TOPW = (float*)(c.ws + WS_TOPW); int* RANK = (int*)(c.ws + WS_RANK); unsigned* cnt = (unsigned*)(c.ws + WS_CTL) + CW_CNT + g * 64;
    for (int r = c.gw; r < TOK; r += c.NGW) {
        f32x4 y[4]; ln_row(PRE1 + (size_t)r * D, p.in[I_L1G], p.in[I_L1B], c.lane, y);
        store_row_bf16(H1 + (size_t)r * D, c.lane, y);
        float lg[32];
#pragma unroll
        for (int e = 0; e < 32; ++e) { float s = 0.f;
#pragma unroll
            for (int j = 0; j < 4; ++j) { const f32x4 w = *(const LAS f32x4*)(wrT + e * 1024 + 4 * c.lane + 256 * j); s += (y[j].x * w.x + y[j].y * w.y) + (y[j].z * w.z + y[j].w * w.w); }
            lg[e] = wave_sum(s) + p.in[I_BR][e]; asm volatile("" ::: "memory"); }
        int sel[4]; float val[4];
#pragma unroll
        for (int k = 0; k < 4; ++k) { float best = -3.0e38f; int bi = 0;
#pragma unroll
            for (int e = 0; e < 32; ++e) if (lg[e] > best) { best = lg[e]; bi = e; }
            sel[k] = bi; val[k] = best;
#pragma unroll
            for (int e = 0; e < 32; ++e) lg[e] = (e == bi) ? -3.0e38f : lg[e]; }
        const float e1 = fexp(val[1] - val[0]), e2 = fexp(val[2] - val[0]), e3 = fexp(val[3] - val[0]); const float inv = frcp(1.0f + e1 + e2 + e3);
        if (c.lane < 4) { const int me = c.lane == 0 ? sel[0] : c.lane == 1 ? sel[1] : c.lane == 2 ? sel[2] : sel[3]; const float mw = (c.lane == 0 ? 1.0f : c.lane == 1 ? e1 : c.lane == 2 ? e2 : e3) * inv;
            const unsigned rk = atomicAdd(cnt + me, 1u); TOPI[(size_t)r * 4 + c.lane] = me; TOPW[(size_t)r * 4 + c.lane] = mw; RANK[(size_t)r * 4 + c.lane] = (int)rk; }
    }
}
__device__ __forceinline__ int moe_tables(const Ctx& c, int g) {
    const unsigned* cnt = (const unsigned*)(c.ws + WS_CTL) + CW_CNT + g * 64;
    if (c.tid == 0) { unsigned o = 0; for (int e = 0; e < NEXP; ++e) { c.MISC[MI_OFF + e] = o; o += (__hip_atomic_load(cnt + e, __ATOMIC_RELAXED, __HIP_MEMORY_SCOPE_AGENT) + 255u) & ~255u; } c.MISC[MI_OFF + NEXP] = o; }
    __syncthreads();
    const int ntiles = (int)(c.MISC[MI_OFF + NEXP] >> 8);
    for (int t = c.tid; t < ntiles; t += NTHR) { int e = 0; for (int k = 1; k < NEXP; ++k) if ((unsigned)(t * 256) >= c.MISC[MI_OFF + k]) e = k; c.MISC[MI_TE + t] = (unsigned)e; }
    __syncthreads();
    return ntiles;
}
__device__ __forceinline__ void phase_scatter(const P& p, const Ctx& c, int g) {
    (void)moe_tables(c, g);
    const unsigned* cnt = (const unsigned*)(c.ws + WS_CTL) + CW_CNT + g * 64;
    const bf16_t* H1 = (const bf16_t*)(c.ws + WS_H1); bf16_t* XS = (bf16_t*)(c.ws + WS_XS);
    const int* TOPI = (const int*)(c.ws + WS_TOPI); const float* TOPW = (const float*)(c.ws + WS_TOPW); const int* RANK = (const int*)(c.ws + WS_RANK); int* SLOT = (int*)(c.ws + WS_SLOT); float* ROWW = (float*)(c.ws + WS_ROWW);
    for (int r = c.gw; r < TOK; r += c.NGW) {
        const u32x4* src = (const u32x4*)(H1 + (size_t)r * D); const u32x4 a = src[c.lane], b = src[c.lane + 64];
#pragma unroll
        for (int k = 0; k < 4; ++k) { const int e = TOPI[(size_t)r * 4 + k], slot = (int)c.MISC[MI_OFF + e] + RANK[(size_t)r * 4 + k];
            u32x4* dst = (u32x4*)(XS + (size_t)slot * D); dst[c.lane] = a; dst[c.lane + 64] = b;
            if (c.lane == 0) { SLOT[(size_t)r * 4 + k] = slot; ROWW[slot] = TOPW[(size_t)r * 4 + k]; } }
    }
    for (int e = 0; e < NEXP; ++e) { const int lo = (int)c.MISC[MI_OFF + e] + (int)__hip_atomic_load(cnt + e, __ATOMIC_RELAXED, __HIP_MEMORY_SCOPE_AGENT), hi = (int)c.MISC[MI_OFF + e + 1];
        for (int pr = lo + c.gw; pr < hi; pr += c.NGW) { u32x4* dst = (u32x4*)(XS + (size_t)pr * D); const u32x4 z = {0u, 0u, 0u, 0u}; dst[c.lane] = z; dst[c.lane + 64] = z; if (c.lane == 0) ROWW[pr] = 0.f; } }
}
__device__ __forceinline__ void phase_combine(const P& p, const Ctx& c, int g) {
    const bf16_t* H1 = (const bf16_t*)(c.ws + WS_H1); const bf16_t* YS = (const bf16_t*)(c.ws + WS_YS); const int* SLOT = (const int*)(c.ws + WS_SLOT);
    for (int r = c.gw; r < TOK; r += c.NGW) {
        int sl[4];
#pragma unroll
        for (int k = 0; k < 4; ++k) sl[k] = SLOT[(size_t)r * 4 + k];
        f32x4 v[4]; float s = 0.f;
#pragma unroll
        for (int j = 0; j < 4; ++j) { const u32x2 hw = ((const u32x2*)(H1 + (size_t)r * D))[c.lane + 64 * j]; v[j] = (f32x4){bflo(hw.x), bfhi(hw.x), bflo(hw.y), bfhi(hw.y)} * DN_ALPHA;
#pragma unroll
            for (int k = 0; k < 4; ++k) { const u32x2 yw = ((const u32x2*)(YS + (size_t)sl[k] * D))[c.lane + 64 * j]; v[j] = v[j] + (f32x4){bflo(yw.x), bfhi(yw.x), bflo(yw.y), bfhi(yw.y)}; }
            s += (v[j].x + v[j].y) + (v[j].z + v[j].w); }
        const float mean = wave_sum(s) * (1.f / D); float s2 = 0.f;
#pragma unroll
        for (int j = 0; j < 4; ++j) { v[j] = v[j] - mean; s2 += (v[j].x * v[j].x + v[j].y * v[j].y) + (v[j].z * v[j].z + v[j].w * v[j].w); }
        const float rstd = frsq(wave_sum(s2) * (1.f / D) + LN_EPS);
        f32x4* orow = (f32x4*)(p.out + ((size_t)g * TOK + r) * D);
#pragma unroll
        for (int j = 0; j < 4; ++j) { const f32x4 gv = ((const f32x4*)p.in[I_L2G])[c.lane + 64 * j], bv = ((const f32x4*)p.in[I_L2B])[c.lane + 64 * j]; orow[c.lane + 64 * j] = v[j] * rstd * gv + bv; }
    }
}

constexpr int NPH_G = 10, NPHASES = 1 + NG * NPH_G;
__global__ void __launch_bounds__(NTHR, 2) fwd(P p) {
    extern __shared__ __attribute__((aligned(16))) unsigned char lds_raw[];
    Ctx c; c.lds = (LAS unsigned char*)lds_raw; c.MISC = (volatile LAS unsigned*)(c.lds + MISC_OFF);
    c.tid = threadIdx.x; c.lane = c.tid & 63; c.wave = __builtin_amdgcn_readfirstlane(c.tid >> 6); c.G = gridDim.x; c.ws = p.ws;
    { const int bx = blockIdx.x; const int vcu = (c.G % 8 == 0) ? (bx % 8) * (c.G / 8) + bx / 8 : bx; c.gw = vcu * NWAVES + c.wave; c.NGW = c.G * NWAVES; }
    unsigned* ctl = (unsigned*)(p.ws + WS_CTL);
    if (c.tid < 16) c.MISC[c.tid] = 0u;
    __syncthreads();
#if MK_SINGLE
    XcdBarrier bar = xcd_barrier_post(ctl + CW_BAR, c.MISC);
#define SEAM(k) do { if (IN(k) && IN((k) + 1)) xcd_barrier(bar); } while (0)
#else
#define SEAM(k) do { } while (0)
#endif
#ifndef PHASE_MASK
#define PHASE_MASK 0xFFFF
#endif
#define IN(k) (p.ph_lo <= (k) && (k) < p.ph_hi)
#define ON(j) (((PHASE_MASK) >> (j)) & 1)
    const int bx = blockIdx.x;
#define FRESH() do { asm volatile("" : "+v"(c.tid), "+v"(c.lane)); } while (0)
    if (ON(10) && IN(0)) { FRESH(); phase_prep(p, c); }
    SEAM(0);
    for (int g = 0; g < NG; ++g) {
        const int pb = 1 + g * NPH_G;
        if (ON(0) && IN(pb + 0)) { FRESH(); phase_ln0(p, c, g); }
        SEAM(pb + 0);
        if (ON(1) && IN(pb + 1)) { FRESH();
            SchedStd S; S.init(TOK, N1, D, c.G, bx, p.ws + WS_H0, p.ws + WS_WIN);
            EpiG1 E{(bf16_t*)(p.ws + WS_QKVG), (bf16_t*)(p.ws + WS_ZS), (bf16_t*)(p.ws + WS_QS), (bf16_t*)(p.ws + WS_KS), (bf16_t*)(p.ws + WS_VS), (bf16_t*)(p.ws + WS_SG), (bf16_t*)(p.ws + WS_SS)};
            pg8::gemm_phase<EpiG1, SchedStd, true, true>(c.lds, D, S, E);
        }
        SEAM(pb + 1);
        if (ON(2) && IN(pb + 2)) { FRESH();
#ifndef NO_GDN
            if (bx < NB * NHG) gdn_seq_unit(p, c, bx / NHG, bx % NHG);
#endif
#ifndef NO_SWA
            if (bx >= NB * NHG) swa_naive(p, c, NB * NHG);
#endif
        }
        SEAM(pb + 2);
        if (ON(3) && IN(pb + 3)) { FRESH();
            SchedPair S; S.init(TOK, D, D, c.G, bx, p.ws + WS_OG, p.ws + WS_WBG, p.ws + WS_OSW, p.ws + WS_WBS);
            EpiBr E{(const bf16_t*)(p.ws + WS_SG), (const bf16_t*)(p.ws + WS_SS), (bf16_t*)(p.ws + WS_Y)};
            pg8::gemm_phase<EpiBr, SchedPair, true, true>(c.lds, D, S, E);
        }
        SEAM(pb + 3);
        if (ON(4) && IN(pb + 4)) { FRESH();
            SchedStd S; S.init(TOK, D, D, c.G, bx, p.ws + WS_Y, p.ws + WS_WOUT);
            EpiOut E{(const bf16_t*)(p.ws + WS_H0), (float*)(p.ws + WS_PRE1)};
            pg8::gemm_phase<EpiOut, SchedStd, true, true>(c.lds, D, S, E);
        }
        SEAM(pb + 4);
        if (ON(5) && IN(pb + 5)) { FRESH(); phase_ln1_router(p, c, g); }
        SEAM(pb + 5);
        if (ON(6) && IN(pb + 6)) { FRESH(); phase_scatter(p, c, g); }
        SEAM(pb + 6);
        if (ON(7) && IN(pb + 7)) { FRESH();
            const int ntiles = moe_tables(c, g);
            SchedMoe S; S.init(ntiles, 2 * DFF, D, c.G, bx, p.ws + WS_XS, p.ws + WS_W1, c.MISC + MI_TE);
            EpiMoe1 E{p.in[I_B1], (bf16_t*)(p.ws + WS_HID)};
            pg8::gemm_phase<EpiMoe1, SchedMoe, true, true>(c.lds, D, S, E);
        }
        SEAM(pb + 7);
        if (ON(8) && IN(pb + 8)) { FRESH();
            const int ntiles = moe_tables(c, g);
            SchedMoe S; S.init(ntiles, D, DFF, c.G, bx, p.ws + WS_HID, p.ws + WS_W2, c.MISC + MI_TE);
            EpiMoe2 E{p.in[I_B2], (const float*)(p.ws + WS_ROWW), (bf16_t*)(p.ws + WS_YS)};
            pg8::gemm_phase<EpiMoe2, SchedMoe, true, true>(c.lds, DFF, S, E);
        }
        SEAM(pb + 8);
        if (ON(9) && IN(pb + 9)) { FRESH(); phase_combine(p, c, g); }
        SEAM(pb + 9);
    }
#undef IN
#undef FRESH
#undef SEAM
}

extern "C" void kernel_launch(void* const* d_in, const int* in_sizes, int n_in, void* d_out, int out_size, void* d_ws, size_t ws_size, hipStream_t stream) {
    static int grid = 0;
    if (grid == 0) {
        if (n_in != 23 || in_sizes[0] != BATCH * SEQ * D || out_size != BATCH * SEQ * D || ws_size < WS_END) {
            fprintf(stderr, "kernel_launch: unexpected shapes (n_in %d, in0 %d, out %d, ws %zu, need %zu); nothing launched\n", n_in, n_in > 0 ? in_sizes[0] : -1, out_size, ws_size, (size_t)WS_END); grid = -1; return; }
        int dev = 0, cus = 0;
        if (hipGetDevice(&dev) != hipSuccess || hipDeviceGetAttribute(&cus, hipDeviceAttributeMultiprocessorCount, dev) != hipSuccess) { grid = -1; return; }
        if (hipFuncSetAttribute((const void*)fwd, hipFuncAttributeMaxDynamicSharedMemorySize, LDS_BYTES) != hipSuccess) { fprintf(stderr, "kernel_launch: hipFuncSetAttribute failed\n"); grid = -1; return; }
        int per_cu = 0; (void)hipOccupancyMaxActiveBlocksPerMultiprocessor(&per_cu, (const void*)fwd, NTHR, LDS_BYTES); (void)hipGetLastError();
        grid = cus;
    }
    if (grid < 0) return;
    if (hipMemsetAsync((char*)d_ws + WS_CTL, 0, CTL_ZERO_BYTES, stream) != hipSuccess) return;
    P a{};
    for (int i = 0; i < 23; ++i) a.in[i] = (const float*)d_in[i];
    a.out = (float*)d_out; a.ws = (unsigned char*)d_ws;
#if MK_SINGLE
    a.ph_lo = 0; a.ph_hi = NPHASES;
    hipLaunchKernelGGL(fwd, dim3(grid), dim3(NTHR), LDS_BYTES, stream, a);
#else
    for (int ph = 0; ph < NPHASES; ++ph) { a.ph_lo = ph; a.ph_hi = ph + 1; hipLaunchKernelGGL(fwd, dim3(grid), dim3(NTHR), LDS_BYTES, stream, a); }
#endif
}
```

```cpp
#include <hip/hip_runtime.h>
#include <cstdio>
#include <cstdint>
#ifndef MK_SINGLE
#define MK_SINGLE 1
#endif
__device__ __forceinline__ int lane_fresh() { int l; asm volatile("v_mbcnt_lo_u32_b32 %0, -1, 0\n\tv_mbcnt_hi_u32_b32 %0, -1, %0" : "=v"(l)); return l; }
template <int M> __device__ __forceinline__ float sx(float v) {
    if constexpr (M < 32) return __builtin_bit_cast(float, __builtin_amdgcn_ds_swizzle(__builtin_bit_cast(int, v), 0x1F | (M << 10)));
    else return __builtin_bit_cast(float, __builtin_amdgcn_ds_bpermute((lane_fresh() ^ M) << 2, __builtin_bit_cast(int, v))); }
__device__ __forceinline__ float shfl_up_f(float v, int o, int lane) { return __builtin_bit_cast(float, __builtin_amdgcn_ds_bpermute((lane - o) << 2, __builtin_bit_cast(int, v))); }
__device__ __forceinline__ unsigned shfl_up_u(unsigned v, int o, int lane) { return (unsigned)__builtin_amdgcn_ds_bpermute((lane - o) << 2, (int)v); }
namespace pg8 {
#define PG8_LAS __attribute__((address_space(3)))
typedef unsigned short bf16_t;
typedef short bf16x8 __attribute__((ext_vector_type(8)));
typedef float f32x4 __attribute__((ext_vector_type(4)));
typedef unsigned u32x4 __attribute__((ext_vector_type(4)));
typedef unsigned u32x2 __attribute__((ext_vector_type(2)));
constexpr int BM = 256, BK = 64, HALF = 128, HTB = HALF * BK * 2  , STAGE_BYTES = 8 * HTB, NXCD = 8, WGM = 8;
__host__ __device__ __forceinline__ int lds_byte(int r, int c) { const int st = (r >> 4) * 2 + (c >> 5), rr = r & 15, cc = c & 31, ob = rr * 64 + cc * 2; return st * 1024 + (ob ^ (((ob >> 9) & 1) << 5)); }
__host__ __device__ __forceinline__ void stage_rc(int b, int& R, int& C) { const int st = b / 1024, sb = b % 1024, swz = sb ^ (((sb >> 9) & 1) << 5); R = (st >> 1) * 16 + swz / 64; C = (st & 1) * 32 + (swz % 64) / 2; }
__host__ __device__ __forceinline__ int perm32(int rho) { const int n = rho >> 4, i = rho & 15; return 8 * (i >> 2) + 4 * n + (i & 3); }
struct Unit { int pm, pn, e, kind; const char* A; const char* B; };
typedef __bf16 bf16x2n __attribute__((ext_vector_type(2))); typedef float f32x2n __attribute__((ext_vector_type(2)));
typedef int i32x8 __attribute__((ext_vector_type(8))); typedef int i32x4 __attribute__((ext_vector_type(4)));
__device__ __forceinline__ i32x8 cat8(bf16x8 a, bf16x8 b) { const i32x4 x = __builtin_bit_cast(i32x4, a), y = __builtin_bit_cast(i32x4, b); return (i32x8){x[0], x[1], x[2], x[3], y[0], y[1], y[2], y[3]}; }
__device__ __forceinline__ unsigned cvt_pk_bf16(float lo, float hi) { return __builtin_bit_cast(unsigned, __builtin_convertvector((f32x2n){lo, hi}, bf16x2n)); }
template <class Epi, class Sched, bool ALIGN_EPI = false, bool SP2 = false, bool FP8 = false, bool GATHER = false>
__device__ __forceinline__ void gemm_phase(PG8_LAS unsigned char* lds, const int KB  , const Sched& S, const Epi& E, const int wid_in) {
    int lane_ = lane_fresh();
    const int wid = wid_in, lane = lane_, tid = wid * 64 + lane, wr = wid >> 2, wc = wid & 3, fr = lane & 15, fq = lane >> 4;
    const int nt = KB / (BK * 2);
    unsigned voffA[2], voffB[2];
#pragma unroll
    for (int i = 0; i < 2; ++i) { int R, C; stage_rc(tid * 16 + i * 8192, R, C); const int Rb = Epi::PERM ? ((R & ~31) + perm32(R & 31)) : R;
        voffA[i] = (unsigned)(R * KB + C * 2); voffB[i] = (unsigned)(Rb * KB + C * 2); }
    const size_t kstep = (size_t)(BK * 2);
    const size_t hstep = (size_t)HALF * KB;
    const size_t tstep = 2 * hstep;
    const unsigned ldsw = (unsigned)wid * 1024u;
    const int aoff = lds_byte(wr * 64 + fr, fq * 8), boff = lds_byte(wc * 32 + fr, fq * 8);
#define PG8_SA(b, h) (((b) * 2 + (h)) * HTB)
#define PG8_SB(b, h) ((4 + (b) * 2 + (h)) * HTB)
#define PG8_STAGE(bufoff, gbase, voff) do { _Pragma("unroll") for (int _i = 0; _i < 2; ++_i) \
        __builtin_amdgcn_global_load_lds((const unsigned*)((const char*)(gbase) + (voff)[_i]), (PG8_LAS unsigned*)(lds + (bufoff) + ldsw + _i * 8192), 16, 0, 0); } while (0)
#define PG8_STAGEV(bufoff, gbase, pair) PG8_STAGEV2(bufoff, gbase, pair)
#define PG8_STAGEV2(bufoff, gbase, v0, v1) do { \
        __builtin_amdgcn_global_load_lds((const unsigned*)((const char*)(gbase) + (v0)), (PG8_LAS unsigned*)(lds + (bufoff) + ldsw), 16, 0, 0); \
        __builtin_amdgcn_global_load_lds((const unsigned*)((const char*)(gbase) + (v1)), (PG8_LAS unsigned*)(lds + (bufoff) + ldsw + 8192), 16, 0, 0); } while (0)
#define PG8_CV(h) cvo[h][0], cvo[h][1]
#define PG8_XV(h) (last ? nvo[h][0] : cvo[h][0]), (last ? nvo[h][1] : cvo[h][1])
#define PG8_LD2(p0) __builtin_shufflevector(*(const PG8_LAS i32x4*)(p0), *(const PG8_LAS i32x4*)((p0) + 1024), 0, 1, 2, 3, 4, 5, 6, 7)
#define PG8_LO(v) __builtin_bit_cast(bf16x8, __builtin_shufflevector(v, v, 0, 1, 2, 3))
#define PG8_HI(v) __builtin_bit_cast(bf16x8, __builtin_shufflevector(v, v, 4, 5, 6, 7))
#define PG8_LDA(dst, b, h) do { _Pragma("unroll") for (int m = 0; m < 4; ++m) dst[m] = PG8_LD2(lds + PG8_SA(b, h) + aoff + m * 2048); } while (0)
#define PG8_LDB(dst, b, h) do { _Pragma("unroll") for (int n = 0; n < 2; ++n) dst[n] = PG8_LD2(lds + PG8_SB(b, h) + boff + n * 2048); } while (0)
#if defined(FP8_NONSCALED)
#define PG8_FP8MMA(C, Bv, Av) do { typedef long l4 __attribute__((ext_vector_type(4))); const l4 bq = __builtin_bit_cast(l4, Bv), aq = __builtin_bit_cast(l4, Av); _Pragma("unroll") for (int qq = 0; qq < 4; ++qq) C = __builtin_amdgcn_mfma_f32_16x16x32_fp8_fp8(bq[qq], aq[qq], C, 0, 0, 0); } while (0)
#else
#define PG8_FP8MMA(C, Bv, Av) asm volatile("v_mfma_scale_f32_16x16x128_f8f6f4 %0, %1, %2, %0, %3, %3 op_sel_hi:[0,0,0]" : "+v"(C) : "v"(Bv), "v"(Av), "v"(sc127))
#endif
#define PG8_MMA(ai, bj, At, Bt) do { __builtin_amdgcn_s_setprio(1); \
        if constexpr (FP8) { _Pragma("unroll") for (int m = 0; m < 4; ++m) _Pragma("unroll") for (int n = 0; n < 2; ++n) \
            PG8_FP8MMA(acc[ai][bj][m][n], Bt[n], At[m]); } \
        else { _Pragma("unroll") for (int m = 0; m < 4; ++m) _Pragma("unroll") for (int n = 0; n < 2; ++n) { \
            acc[ai][bj][m][n] = __builtin_amdgcn_mfma_f32_16x16x32_bf16(PG8_LO(Bt[n]), PG8_LO(At[m]), acc[ai][bj][m][n], 0, 0, 0); \
            acc[ai][bj][m][n] = __builtin_amdgcn_mfma_f32_16x16x32_bf16(PG8_HI(Bt[n]), PG8_HI(At[m]), acc[ai][bj][m][n], 0, 0, 0); } } \
        __builtin_amdgcn_s_setprio(0); } while (0)
#define PG8_WAIT_V(n) asm volatile("s_waitcnt vmcnt(" #n ")" ::: "memory")
#define PG8_WAIT_L(n) asm volatile("s_waitcnt lgkmcnt(" #n ")" ::: "memory")
#define PG8_BAR __builtin_amdgcn_s_barrier()
#define PG8_SCHED __builtin_amdgcn_sched_barrier(0)
    Unit cur, nxt; int ui = 0;
    if (!S.next(0, cur)) return;
    unsigned cvo[2][2], nvo[2][2];
#pragma unroll
    for (int h2 = 0; h2 < 2; ++h2)
#pragma unroll
        for (int i = 0; i < 2; ++i) { if constexpr (GATHER) { int R, C; stage_rc(tid * 16 + i * 8192, R, C); cvo[h2][i] = S.rowoff(0, h2 * HALF + R) + (unsigned)(C * 2); } else cvo[h2][i] = voffA[i] + (unsigned)(h2 * HALF * KB); nvo[h2][i] = cvo[h2][i]; }
    f32x4 acc[2][2][4][2];
#pragma unroll
    for (int a = 0; a < 2; ++a)
#pragma unroll
        for (int b = 0; b < 2; ++b)
#pragma unroll
            for (int m = 0; m < 4; ++m)
#pragma unroll
                for (int n = 0; n < 2; ++n) acc[a][b][m][n] = (f32x4){0.f, 0.f, 0.f, 0.f};
    int sc127 = 127; asm volatile("" : "+v"(sc127));
    i32x8 At[4], B0[2], B1[2];
    const char* cA = cur.A; const char* cB = cur.B;
    S.a_ready(cur);
    if constexpr (SP2) {
        PG8_STAGE(PG8_SB(0, 0), cB, voffB); PG8_STAGE(PG8_SB(0, 1), cB + hstep, voffB); PG8_STAGEV(PG8_SA(0, 0), cA, PG8_CV(0)); PG8_STAGEV(PG8_SA(0, 1), cA, PG8_CV(1));
        if (wr == 1) PG8_BAR;
        PG8_WAIT_V(2); PG8_BAR;
        PG8_STAGE(PG8_SB(1, 0), cB + kstep, voffB); PG8_STAGEV(PG8_SA(1, 0), cA + kstep, PG8_CV(0)); PG8_STAGE(PG8_SB(1, 1), cB + hstep + kstep, voffB);
        PG8_WAIT_V(6); PG8_BAR;
    } else {
        PG8_STAGE(PG8_SB(0, 0), cB, voffB); PG8_STAGEV(PG8_SA(0, 0), cA, PG8_CV(0)); PG8_STAGE(PG8_SB(0, 1), cB + hstep, voffB); PG8_STAGEV(PG8_SA(0, 1), cA, PG8_CV(1));
        if (wr == 1) PG8_BAR;
        PG8_WAIT_V(4); PG8_BAR;
        PG8_STAGE(PG8_SB(1, 0), cB + kstep, voffB); PG8_STAGEV(PG8_SA(1, 0), cA + kstep, PG8_CV(0)); PG8_STAGE(PG8_SB(1, 1), cB + hstep + kstep, voffB);
        PG8_WAIT_V(6); PG8_BAR;
    }
    for (;;) {
        const bool has_next = S.next(ui + 1, nxt);
        if constexpr (GATHER) { if (has_next) {
#pragma unroll
            for (int h2 = 0; h2 < 2; ++h2)
#pragma unroll
                for (int i = 0; i < 2; ++i) { int R, C; stage_rc(tid * 16 + i * 8192, R, C); nvo[h2][i] = S.rowoff(ui + 1, h2 * HALF + R) + (unsigned)(C * 2); } } }
        const char* nA = has_next ? nxt.A : cA; const char* nB = has_next ? nxt.B : cB;
#pragma unroll 1
        for (int t = 0; t < nt; t += 2) {
            const bool last = (t == nt - 2);
            const char* a1 = cA + (size_t)(t + 1) * kstep;
            const char* a2 = last ? nA : cA + (size_t)(t + 2) * kstep; const char* b2 = last ? nB : cB + (size_t)(t + 2) * kstep;
            const char* a3 = a2 + kstep; const char* b3 = b2 + kstep;
            if (last && has_next) S.a_ready(nxt);
            if constexpr (SP2) {
            PG8_LDB(B0, 0, 0); PG8_LDB(B1, 0, 1); PG8_SCHED; PG8_LDA(At, 0, 0); PG8_STAGEV(PG8_SA(1, 1), a1, PG8_CV(1));
            PG8_WAIT_V(8); PG8_WAIT_L(0); PG8_BAR; PG8_MMA(0, 0, At, B0); PG8_MMA(0, 1, At, B1); PG8_BAR; PG8_SCHED;
            PG8_LDA(At, 0, 1); PG8_STAGE(PG8_SB(0, 0), b2, voffB); PG8_STAGE(PG8_SB(0, 1), b2 + hstep, voffB); PG8_STAGEV(PG8_SA(0, 0), a2, PG8_XV(0));
            PG8_WAIT_V(8); PG8_WAIT_L(0); PG8_BAR; PG8_MMA(1, 0, At, B0); PG8_MMA(1, 1, At, B1); PG8_BAR; PG8_SCHED;
            PG8_LDB(B0, 1, 0); PG8_LDB(B1, 1, 1); PG8_SCHED; PG8_LDA(At, 1, 0); PG8_STAGEV(PG8_SA(0, 1), a2, PG8_XV(1));
            PG8_WAIT_V(8); PG8_WAIT_L(0); PG8_BAR; PG8_MMA(0, 0, At, B0); PG8_MMA(0, 1, At, B1); PG8_BAR; PG8_SCHED;
            PG8_LDA(At, 1, 1); PG8_STAGE(PG8_SB(1, 0), b3, voffB); PG8_STAGE(PG8_SB(1, 1), b3 + hstep, voffB); PG8_STAGEV(PG8_SA(1, 0), a3, PG8_XV(0));
            PG8_WAIT_V(8); PG8_WAIT_L(0); PG8_BAR; PG8_MMA(1, 0, At, B0); PG8_MMA(1, 1, At, B1); PG8_BAR; PG8_SCHED;
            } else {
            PG8_LDB(B0, 0, 0); PG8_SCHED; PG8_LDA(At, 0, 0); PG8_STAGEV(PG8_SA(1, 1), a1, PG8_CV(1));
            PG8_WAIT_L(8); PG8_BAR; PG8_WAIT_L(0); PG8_MMA(0, 0, At, B0); PG8_BAR; PG8_SCHED;
            PG8_LDB(B1, 0, 1); PG8_STAGE(PG8_SB(0, 0), b2, voffB);
            PG8_BAR; PG8_WAIT_L(0); PG8_MMA(0, 1, At, B1); PG8_BAR;
            PG8_LDA(At, 0, 1); PG8_STAGEV(PG8_SA(0, 0), a2, PG8_XV(0));
            PG8_BAR; PG8_WAIT_L(0); PG8_MMA(1, 0, At, B0); PG8_BAR; PG8_SCHED;
            PG8_STAGE(PG8_SB(0, 1), b2 + hstep, voffB);
            PG8_WAIT_V(6); PG8_BAR; PG8_MMA(1, 1, At, B1); PG8_BAR;
            PG8_LDB(B0, 1, 0); PG8_SCHED; PG8_LDA(At, 1, 0); PG8_STAGEV(PG8_SA(0, 1), a2, PG8_XV(1));
            PG8_WAIT_L(8); PG8_BAR; PG8_WAIT_L(0); PG8_MMA(0, 0, At, B0); PG8_BAR; PG8_SCHED;
            PG8_LDB(B1, 1, 1); PG8_STAGE(PG8_SB(1, 0), b3, voffB);
            PG8_BAR; PG8_WAIT_L(0); PG8_MMA(0, 1, At, B1); PG8_BAR;
            PG8_LDA(At, 1, 1); PG8_STAGEV(PG8_SA(1, 0), a3, PG8_XV(0));
            PG8_BAR; PG8_WAIT_L(0); PG8_MMA(1, 0, At, B0); PG8_BAR; PG8_SCHED;
            PG8_STAGE(PG8_SB(1, 1), b3 + hstep, voffB);
            PG8_WAIT_V(6); PG8_BAR; PG8_MMA(1, 1, At, B1); PG8_BAR;
            }
        }
        if constexpr (ALIGN_EPI) { if (wr == 0) PG8_BAR; }
        if constexpr (FP8) asm volatile("s_nop 15\n\ts_nop 15" ::: "memory");
        if constexpr (!Epi::AFTER_DRAIN) { int le_ = lane_fresh();
            E(acc, cur, wr, wc, le_ & 15, le_ >> 4); S.done(cur); }
        if (!has_next) break;
#pragma unroll
        for (int a = 0; a < 2; ++a)
#pragma unroll
            for (int b = 0; b < 2; ++b)
#pragma unroll
                for (int m = 0; m < 4; ++m)
#pragma unroll
                    for (int n = 0; n < 2; ++n) acc[a][b][m][n] = (f32x4){0.f, 0.f, 0.f, 0.f};
        cur = nxt; cA = nA; cB = nB; ++ui;
#pragma unroll
        for (int h2 = 0; h2 < 2; ++h2)
#pragma unroll
            for (int i = 0; i < 2; ++i) cvo[h2][i] = nvo[h2][i];
        if constexpr (ALIGN_EPI) { if (wr == 1) PG8_BAR; }
    }
    PG8_WAIT_V(0);
    if constexpr (!ALIGN_EPI) { if (wr == 0) PG8_BAR; }
    PG8_BAR;
    if constexpr (Epi::AFTER_DRAIN) { E.fused(acc, cur, wr, wc, fr, fq, lds, wid, lane); S.done(cur); }
#undef PG8_SA
#undef PG8_SB
#undef PG8_STAGE
#undef PG8_LDA
#undef PG8_LDB
#undef PG8_MMA
#undef PG8_WAIT_V
#undef PG8_WAIT_L
#undef PG8_BAR
#undef PG8_SCHED
}
}


#ifndef SWA_FAST
#define SWA_FAST 1
#endif
#ifndef G1_FP8
#define G1_FP8 1
#endif
#ifndef GDN_FAST
#define GDN_FAST 1
#endif
constexpr int D = 1024, BATCH = 32, SEQ = 2048, NMETA = 16, CIN = 7696;
constexpr int NG = 4, TSL = SEQ / NG, TOK = BATCH * TSL;
constexpr int C_QG = 0, C_KG = 1024, C_VG = 2048, C_ZG = 3072, C_BG = 4096, C_AG = 4104, C_QS = 4112, C_KS = 5136, C_VS = 5392, C_GG = 5648, C_GS = 6672;
constexpr int N1 = 7936;
constexpr int NEXP = 32, TOPK = 4, DFF = 1024, NHG = 8, NHQ = 16, NHK = 4;
constexpr int NP = 2, TOKP = NP * TOK;
constexpr int NASG = TOKP * TOPK, MAXROWS = NASG + NEXP * 256, MAXTILES = MAXROWS / 256;
constexpr float LN_EPS = 1e-5f, RMS_EPS = 1e-6f;
constexpr float DN_ALPHA = 1.189207115002721f;
constexpr int NWAVES = 8, NTHR = 512;
constexpr size_t MiB = 1u << 20;
constexpr size_t WS_CTL = 0, CTL_ZERO_BYTES = 64 * 1024;
constexpr size_t WS_PM = 1 * MiB, WS_WRT = 1 * MiB + 512 * 1024  , WS_S1 = 2 * MiB, WS_WIN = 3 * MiB, WS_WBG = 19 * MiB, WS_WBS = 21 * MiB, WS_WOUT = 23 * MiB, WS_W1 = 26 * MiB, WS_W2 = 152 * MiB;
static_assert(WS_WIN + (size_t)N1 * D * 2 <= WS_WBG && WS_WOUT + 2 * MiB <= WS_W1 && WS_W1 + 64 * MiB <= WS_W2, "weight copies overlap");
constexpr size_t WS_H1Q = 216 * MiB;
constexpr size_t WS_ROWW = 249 * MiB, WS_BETA = 250 * MiB, WS_LOGG = WS_BETA + 512 * 1024;
constexpr size_t GR = 252 * MiB;
constexpr size_t WS_H0 = GR, WS_QKVG = GR + 32 * MiB, WS_ZS = GR + 128 * MiB, WS_QS = GR + 160 * MiB, WS_KS = GR + 192 * MiB, WS_VS = GR + 200 * MiB;
constexpr size_t WS_SG = GR + 208 * MiB, WS_SS = GR + 240 * MiB, WS_OG = GR + 272 * MiB, WS_OSW = GR + 304 * MiB, WS_Y = GR + 336 * MiB, WS_PRE1 = GR + 368 * MiB;
constexpr size_t WS_XS = GR, WS_HID = GR + 144 * MiB, WS_YS = GR + 288 * MiB;
constexpr size_t WS_KSF = GR + 576 * MiB, WS_VSF = GR + 608 * MiB, WS_SC = GR + 640 * MiB, WS_HALO = GR + 656 * MiB;
constexpr size_t WS_TOPI = GR + 658 * MiB, WS_TOPW = GR + 659 * MiB, WS_RANK = GR + 660 * MiB;
constexpr size_t WS_RTOK = GR + 662 * MiB, WS_RWW = GR + 666 * MiB;
constexpr size_t WS_H0Q = GR + 674 * MiB;
constexpr size_t WS_H1 = GR + 694 * MiB;
constexpr size_t WS_END = GR + 758 * MiB;
static_assert(WS_HID + (size_t)MAXROWS * DFF <= WS_YS && WS_YS + (size_t)MAXROWS * D <= GR + 432 * MiB, "moe row buffers (fp8) overlay the dead per-slice buffers below the GDN images");
constexpr int CW_TMO = 0, CW_BAR = 4096, CW_CNT = 8192;
constexpr int RING_BYTES = 131072, MISC_OFF = 143360, LDS_BYTES = 147456;
constexpr int MI_OFF = 16, MI_CNT = 64, MI_LCNT = 96, MI_LBASE = 128, MI_TE = 160, MI_TE_CAP = (LDS_BYTES - MISC_OFF) / 4 - MI_TE;
static_assert((size_t)NMETA * CIN * 4 <= 512 * 1024 && MAXTILES * 8 <= 17 * 256 && MI_TE_CAP >= MAXTILES, "proj_meta fits below the router weight copy; at most 17 MoE up-projection units per workgroup; tile table fits the LDS MISC words");

#define GAS __attribute__((address_space(1)))
#define LAS __attribute__((address_space(3)))
typedef unsigned short bf16_t;
typedef float f32x4 __attribute__((ext_vector_type(4)));
typedef float f32x2 __attribute__((ext_vector_type(2)));
typedef unsigned u32x4 __attribute__((ext_vector_type(4)));
typedef unsigned u32x2 __attribute__((ext_vector_type(2)));
#define LDS_WAIT() asm volatile("s_waitcnt lgkmcnt(0)" ::: "memory")
#define VM_WAIT() asm volatile("s_waitcnt vmcnt(0)" ::: "memory")
__device__ __forceinline__ unsigned f2bf(float f) { unsigned u = __builtin_bit_cast(unsigned, f); return (u + 0x7fffu + ((u >> 16) & 1u)) >> 16; }
__device__ __forceinline__ unsigned pk2(float lo, float hi) { return f2bf(lo) | (f2bf(hi) << 16); }
__device__ __forceinline__ float bflo(unsigned w) { return __builtin_bit_cast(float, w << 16); }
__device__ __forceinline__ float bfhi(unsigned w) { return __builtin_bit_cast(float, w & 0xffff0000u); }
__device__ __forceinline__ float bf1(bf16_t h) { return __builtin_bit_cast(float, (unsigned)h << 16); }
__device__ __forceinline__ float fexp(float x) { return __builtin_amdgcn_exp2f(x * 1.4426950408889634f); }
__device__ __forceinline__ float frcp(float x) { return __builtin_amdgcn_rcpf(x); }
__device__ __forceinline__ float frsq(float x) { return __builtin_amdgcn_rsqf(x); }
__device__ __forceinline__ float sigmoidf_(float x) { return frcp(1.0f + fexp(-x)); }
__device__ __forceinline__ float siluf_(float x) { return x * frcp(1.0f + fexp(-x)); }
__device__ __forceinline__ float softplusf_(float x) { const float e = fexp(-fabsf(x)); const float l = e < 1e-3f ? e * (1.0f - 0.5f * e) : __builtin_amdgcn_logf(1.0f + e) * 0.6931471805599453f; return fmaxf(x, 0.f) + l; }
__device__ __forceinline__ float wave_sum(float v) { v += sx<1>(v); v += sx<2>(v); v += sx<4>(v); v += sx<8>(v); v += sx<16>(v); v += sx<32>(v); return v; }

#define XB_TMO      128
#define XB_XCNT(j)  (256  + 64 * (j))
#define XB_XSUB(j)  (1280 + 64 * (j))
#define XB_XGEN(j)  (2304 + 64 * (j))
#define XB_TOP      3328
#define XB_TOPGEN   3392
#define XCD_BAR_WORDS 3456
#define XB_SPIN_CAP (1u << 18)
__device__ __forceinline__ unsigned xb_ld(unsigned* p)              { return __hip_atomic_load(p, __ATOMIC_RELAXED, __HIP_MEMORY_SCOPE_AGENT); }
__device__ __forceinline__ unsigned xb_add(unsigned* p, unsigned v) { return __hip_atomic_fetch_add(p, v, __ATOMIC_RELAXED, __HIP_MEMORY_SCOPE_AGENT); }
__device__ __forceinline__ unsigned xb_xcc_id() { return (unsigned)__builtin_amdgcn_s_getreg((3 << 11) | 20) & 0xFu; }
#define XB_SPIN(cond, bar) do { unsigned _sp = 0; while (cond) { __builtin_amdgcn_s_sleep(1); \
    if ((++_sp & 255u) == 0u) { if (xb_ld(&(bar)[XB_TMO])) break; if (_sp > XB_SPIN_CAP) { atomicAdd(&(bar)[XB_TMO], 1u); break; } } } } while (0)
struct XcdBarrier { unsigned* bar; unsigned x; volatile LAS unsigned* st; };
__device__ __forceinline__ XcdBarrier xcd_barrier_post(unsigned* bar, volatile LAS unsigned* st, bool leader) {
    XcdBarrier b; b.bar = bar; b.x = xb_xcc_id(); b.st = st;
    if (leader) (void)xb_add(&bar[XB_XCNT(b.x)], 1u);
    return b;
}
__device__ __forceinline__ void xcd_barrier_complete(unsigned* bar, unsigned x, unsigned& nloc, unsigned& nx) {
    const unsigned G = gridDim.x * gridDim.y * gridDim.z;
    unsigned sum, cnt, mine, sp = 0u;
    for (;;) {
        sum = 0u; cnt = 0u; mine = 0u;
#pragma unroll
        for (unsigned j = 0; j < 16; ++j) { const unsigned c = xb_ld(&bar[XB_XCNT(j)]); sum += c; cnt += (c > 0u) ? 1u : 0u; mine = (j == x) ? c : mine; }
        if (sum == G) break;
        __builtin_amdgcn_s_sleep(1);
        if ((++sp & 255u) == 0u) { if (xb_ld(&bar[XB_TMO])) break; if (sp > XB_SPIN_CAP) { atomicAdd(&bar[XB_TMO], 1u); break; } }
    }
    nloc = mine > 0u ? mine : 1u; nx = cnt > 0u ? cnt : 1u;
}
__device__ __forceinline__ void xcd_barrier(const XcdBarrier& b, bool leader) {
    asm volatile("s_waitcnt vmcnt(0)" ::: "memory");
    __syncthreads();
    if (leader) {
        unsigned* bar = b.bar;
        __builtin_amdgcn_s_waitcnt(0);
        unsigned nloc = b.st[0], nx = b.st[1];
        if (nloc == 0u) { xcd_barrier_complete(bar, b.x, nloc, nx); b.st[0] = nloc; b.st[1] = nx; }
        const unsigned old = xb_add(&bar[XB_XSUB(b.x)], 1u);
        const unsigned gen = old / nloc;
        if (old + 1u == (gen + 1u) * nloc) {
            __builtin_amdgcn_fence(__ATOMIC_RELEASE, "agent");
            asm volatile("s_waitcnt vmcnt(0)" ::: "memory");
            const unsigned og = xb_add(&bar[XB_TOP], 1u);
            const unsigned tg = og / nx;
            if (og + 1u == (tg + 1u) * nx) xb_add(&bar[XB_TOPGEN], 1u);
            else XB_SPIN(xb_ld(&bar[XB_TOPGEN]) == tg, bar);
            __builtin_amdgcn_fence(__ATOMIC_ACQUIRE, "agent");
            xb_add(&bar[XB_XGEN(b.x)], 1u);
            asm volatile("s_waitcnt vmcnt(0)" ::: "memory");
        } else {
            XB_SPIN(xb_ld(&bar[XB_XGEN(b.x)]) == gen, bar);
            __builtin_amdgcn_fence(__ATOMIC_ACQUIRE, "agent");
            asm volatile("s_waitcnt vmcnt(0)" ::: "memory");
        }
    }
    __syncthreads();
}

struct P { const float* in[23]; float* out; unsigned char* ws; int ph_lo, ph_hi; };
enum { I_X = 0, I_META, I_ELG, I_ELB, I_WIN, I_CONVW, I_ALOG, I_DTB, I_GNW, I_SINK, I_WBG, I_WBS, I_WOUT, I_L1G, I_L1B, I_WR, I_BR, I_W1, I_B1, I_W2, I_B2, I_L2G, I_L2B };
#ifndef AMP_MASK
#define AMP_MASK 0
#endif
#ifndef AMP_F
#define AMP_F 4
#endif
#define AMP_BEGIN(j) unsigned long long amp_t0 = 0; if ((AMP_MASK >> (j)) & 1) amp_t0 = __builtin_amdgcn_s_memrealtime();
#define AMP_END(j) if ((AMP_MASK >> (j)) & 1) { const unsigned long long amp_t1 = __builtin_amdgcn_s_memrealtime(); const unsigned long long amp_d = (amp_t1 - amp_t0) * AMP_F; while (__builtin_amdgcn_s_memrealtime() - amp_t1 < amp_d) __builtin_amdgcn_s_sleep(16); }

__device__ __forceinline__ void std_tile(int L, int nwg, int nM, int nN, int& pm, int& pn) {
    int wgid = L; { const int q = nwg / pg8::NXCD, r = nwg % pg8::NXCD, xcd = wgid % pg8::NXCD, off = wgid / pg8::NXCD; wgid = (xcd < r ? xcd * (q + 1) : r * (q + 1) + (xcd - r) * q) + off; }
    const int nig = pg8::WGM * nN, gid = wgid / nig, fm = gid * pg8::WGM, gsz = (nM - fm) < pg8::WGM ? (nM - fm) : pg8::WGM;
    pm = fm + ((wgid % nig) % gsz); pn = (wgid % nig) / gsz;
}
__device__ __forceinline__ int xcd_chunk(int L, int nwg) {
    const int q = nwg / pg8::NXCD, r = nwg % pg8::NXCD, xcd = L % pg8::NXCD, off = L / pg8::NXCD; return (xcd < r ? xcd * (q + 1) : r * (q + 1) + (xcd - r) * q) + off;
}
struct SchedStd {
    int nM, nN, nwg, G, c; const char* A; const char* B; size_t tstep;
    __device__ __forceinline__ void init(int M, int N, int KB, int G_, int c_, const void* A_, const void* B_) { nM = M / 256; nN = N / 256; nwg = nM * nN; G = G_; c = c_; A = (const char*)A_; B = (const char*)B_; tstep = (size_t)256 * KB; }
    __device__ __forceinline__ bool next(int i, pg8::Unit& u) const {
        const int L = i * G + c; if (L >= nwg) return false;
        int pm, pn; std_tile(L, nwg, nM, nN, pm, pn);
        u.pm = pm; u.pn = pn; u.e = 0; u.kind = 0; u.A = A + (size_t)pm * tstep; u.B = B + (size_t)pn * tstep; return true;
    }
    __device__ __forceinline__ void a_ready(const pg8::Unit&) const {}
    __device__ __forceinline__ void done(const pg8::Unit&) const {}
    __device__ __forceinline__ unsigned rowoff(int, int) const { return 0u; }
};
struct SchedPair {
    int nM, nN, nwg, G, c; const char *A0, *B0, *A1, *B1; size_t tstep;
    __device__ __forceinline__ void init(int M, int N, int KB, int G_, int c_, const void* A0_, const void* B0_, const void* A1_, const void* B1_) { nM = M / 256; nN = N / 256; nwg = nM * nN; G = G_; c = c_;
        A0 = (const char*)A0_; B0 = (const char*)B0_; A1 = (const char*)A1_; B1 = (const char*)B1_; tstep = (size_t)256 * KB; }
    __device__ __forceinline__ bool next(int i, pg8::Unit& u) const {
        const int L = (i >> 1) * G + c, kind = i & 1; if (L >= nwg) return false;
        int pm, pn; std_tile(L, nwg, nM, nN, pm, pn);
        u.pm = pm; u.pn = pn; u.e = 0; u.kind = kind; u.A = (kind ? A1 : A0) + (size_t)pm * tstep; u.B = (kind ? B1 : B0) + (size_t)pn * tstep; return true;
    }
    __device__ __forceinline__ void a_ready(const pg8::Unit&) const {}
    __device__ __forceinline__ void done(const pg8::Unit&) const {}
    __device__ __forceinline__ unsigned rowoff(int, int) const { return 0u; }
};
struct SchedMoe {
    int nN, nwg, G, c; const char* A; const char* W; size_t tstep, wexp; const volatile LAS unsigned* te;
    __device__ __forceinline__ void init(int ntiles, int N, int KB, int G_, int c_, const void* A_, const void* W_, const volatile LAS unsigned* te_) { nN = N / 256; nwg = ntiles * nN; G = G_; c = c_;
        A = (const char*)A_; W = (const char*)W_; tstep = (size_t)256 * KB; wexp = (size_t)N * KB; te = te_; }
    __device__ __forceinline__ bool next(int i, pg8::Unit& u) const {
        const int L = i * G + c; if (L >= nwg) return false;
        const int w = xcd_chunk(L, nwg), rt = w / nN, pn = w - rt * nN; const int e = __builtin_amdgcn_readfirstlane((int)te[rt]);
        u.pm = rt; u.pn = pn; u.e = e; u.kind = 0; u.A = A + (size_t)rt * tstep; u.B = W + (size_t)e * wexp + (size_t)pn * tstep; return true;
    }
    __device__ __forceinline__ void a_ready(const pg8::Unit&) const {}
    __device__ __forceinline__ void done(const pg8::Unit&) const {}
    __device__ __forceinline__ unsigned rowoff(int, int) const { return 0u; }
};

struct SchedMoeG : SchedMoe {
    const volatile LAS unsigned short* tokt;
    __device__ __forceinline__ bool next(int i, pg8::Unit& u) const { const bool ok = SchedMoe::next(i, u); if (ok) u.A = A; return ok; }
    __device__ __forceinline__ unsigned rowoff(int i, int Rg) const { return (unsigned)tokt[i * 256 + Rg] * (unsigned)D; }
};
using pg8::Unit;
typedef pg8::f32x4 (AccT)[2][2][4][2];
__device__ __forceinline__ u32x4 pack8(f32x4 v0, f32x4 v1) { u32x4 w; w.x = pg8::cvt_pk_bf16(v0[0], v0[1]); w.y = pg8::cvt_pk_bf16(v0[2], v0[3]); w.z = pg8::cvt_pk_bf16(v1[0], v1[1]); w.w = pg8::cvt_pk_bf16(v1[2], v1[3]); return w; }
__device__ __forceinline__ void unpack8(u32x4 w, f32x4& v0, f32x4& v1) { v0 = (f32x4){bflo(w.x), bfhi(w.x), bflo(w.y), bfhi(w.y)}; v1 = (f32x4){bflo(w.z), bfhi(w.z), bflo(w.w), bfhi(w.w)}; }
__device__ __forceinline__ unsigned pack4_fp8(float a, float b, float c2, float d) { int w = __builtin_amdgcn_cvt_pk_fp8_f32(a, b, 0, false); w = __builtin_amdgcn_cvt_pk_fp8_f32(c2, d, w, true); return (unsigned)w; }
constexpr float W8_SCALE = 64.0f, W8_INV = 1.0f / 64.0f, YS_SCALE = 64.0f, YS_INV = 1.0f / 64.0f;
struct EpiG1 {
    static constexpr bool PERM = true, AFTER_DRAIN = false;
    bf16_t *qkvg, *zs, *qs, *ks, *vs, *sg, *ss; int g;
    float asc;
    float *beta, *logg; const float *alog, *dtb;
    __device__ __forceinline__ void operator()(const AccT& acc, const Unit& u, int wr, int wc, int fr, int fq) const {
        if (u.pn == 30) {
            if (wc == 0 && fq < 2) {
                float ea[8], db[8];
#pragma unroll
                for (int h = 0; h < 8; ++h) { ea[h] = alog[h]; db[h] = dtb[h]; }
#pragma unroll
                for (int h = 0; h < 8; ++h) ea[h] = -fexp(ea[h]);
#pragma unroll
                for (int ai = 0; ai < 2; ++ai)
#pragma unroll
                    for (int m = 0; m < 4; ++m) { const size_t r = (size_t)(u.pm * 256 + ai * 128 + wr * 64 + m * 16 + fr);
#pragma unroll
                        for (int n = 0; n < 2; ++n) { f32x4 o;
#pragma unroll
                            for (int i = 0; i < 4; ++i) { const int h = 4 * n + i; const float x = acc[ai][0][m][n][i] * asc; o[i] = fq == 0 ? sigmoidf_(x) : ea[h] * softplusf_(x + db[h]); }
                            *(f32x4*)((fq == 0 ? beta : logg) + r * 8 + 4 * n) = o; } } }
            return; }
        const int pn = u.pn; bf16_t* base; int ldc, colt, act = 0; float sc = 1.f; const bool kv = (pn == 20 || pn == 21);
        if (pn < 12) { base = qkvg; ldc = 3072; colt = pn * 256; }
        else if (pn < 16) { base = zs; ldc = 1024; colt = (pn - 12) * 256; act = 1; }
        else if (pn < 20) { base = qs; ldc = 1024; colt = (pn - 16) * 256; sc = 0.125f * 1.4426950408889634f; }
        else if (pn == 20) { base = ks; ldc = 256; colt = 0; }
        else if (pn == 21) { base = vs; ldc = 256; colt = 0; }
        else if (pn < 26) { base = sg; ldc = 1024; colt = (pn - 22) * 256; act = 2; }
        else { base = ss; ldc = 1024; colt = (pn - 26) * 256; act = 2; }
        const int row0 = u.pm * 256 + wr * 64 + fr, col0 = colt + wc * 32 + 8 * fq; const float asc_sc = asc * sc, nl2e_asc = -1.4426950408889634f * asc;
#pragma unroll
        for (int ai = 0; ai < 2; ++ai)
#pragma unroll
            for (int m = 0; m < 4; ++m) { const int r = row0 + ai * 128 + m * 16, rr = kv ? ((r >> 9) * SEQ + g * TSL + (r & (TSL - 1))) : r; bf16_t* rowp = base + (size_t)rr * ldc + col0;
#pragma unroll
                for (int bj = 0; bj < 2; ++bj) { f32x4 v0, v1;
                    if (act == 0) { v0 = acc[ai][bj][m][0] * asc_sc; v1 = acc[ai][bj][m][1] * asc_sc; }
                    else {
#pragma unroll
                        for (int n = 0; n < 2; ++n)
#pragma unroll
                            for (int hh = 0; hh < 2; ++hh) { const f32x2 a = {acc[ai][bj][m][n][2 * hh], acc[ai][bj][m][n][2 * hh + 1]};
                                f32x2 t = a * nl2e_asc; t.x = __builtin_amdgcn_exp2f(t.x); t.y = __builtin_amdgcn_exp2f(t.y); t = t + 1.0f; t.x = __builtin_amdgcn_rcpf(t.x); t.y = __builtin_amdgcn_rcpf(t.y);
                                if (act == 1) t = t * (a * asc);
                                if (n == 0) { v0[2 * hh] = t.x; v0[2 * hh + 1] = t.y; } else { v1[2 * hh] = t.x; v1[2 * hh + 1] = t.y; } } }
                    *(u32x4*)(rowp + bj * 128) = pack8(v0, v1); } }
    }
};
struct EpiBr {
    static constexpr bool PERM = true, AFTER_DRAIN = false;
    const bf16_t *sg, *ss; bf16_t* y;
    template <bool K1>
    __device__ __forceinline__ void body(const AccT& acc, const bf16_t* __restrict__ gate, const bf16_t* yin, bf16_t* yout, const int row0, const int col0) const {
#pragma unroll
        for (int ai = 0; ai < 2; ++ai) { u32x4 gv[4][2], yv[4][2];
#pragma unroll
            for (int m = 0; m < 4; ++m) { const size_t off = (size_t)(row0 + ai * 128 + m * 16) * D + col0;
#pragma unroll
                for (int bj = 0; bj < 2; ++bj) { gv[m][bj] = *(const u32x4*)(gate + off + bj * 128); if constexpr (K1) yv[m][bj] = *(const u32x4*)(yin + off + bj * 128); } }
#pragma unroll
            for (int m = 0; m < 4; ++m) { const size_t off = (size_t)(row0 + ai * 128 + m * 16) * D + col0;
#pragma unroll
                for (int bj = 0; bj < 2; ++bj) { f32x4 g0, g1; unpack8(gv[m][bj], g0, g1);
                    f32x4 v0 = acc[ai][bj][m][0] * g0, v1 = acc[ai][bj][m][1] * g1;
                    if constexpr (K1) { f32x4 y0, y1; unpack8(yv[m][bj], y0, y1); v0 = v0 + y0; v1 = v1 + y1; }
                    *(u32x4*)(yout + off + bj * 128) = pack8(v0, v1); } } }
    }
    __device__ __forceinline__ void operator()(const AccT& acc, const Unit& u, int wr, int wc, int fr, int fq) const {
        const int row0 = u.pm * 256 + wr * 64 + fr, col0 = u.pn * 256 + wc * 32 + 8 * fq;
        if (u.kind) body<true>(acc, ss, y, y, row0, col0); else body<false>(acc, sg, y, y, row0, col0);
    }
};
struct EpiOut {
    static constexpr bool PERM = true, AFTER_DRAIN = false;
    const bf16_t* h0; bf16_t* pre1;
    __device__ __forceinline__ void operator()(const AccT& acc, const Unit& u, int wr, int wc, int fr, int fq) const {
        const int row0 = u.pm * 256 + wr * 64 + fr, col0 = u.pn * 256 + wc * 32 + 8 * fq;
#pragma unroll
        for (int ai = 0; ai < 2; ++ai) { u32x4 hv[4][2];
#pragma unroll
            for (int m = 0; m < 4; ++m) { const size_t off = (size_t)(row0 + ai * 128 + m * 16) * D + col0;
#pragma unroll
                for (int bj = 0; bj < 2; ++bj) hv[m][bj] = *(const u32x4*)(h0 + off + bj * 128); }
#pragma unroll
            for (int m = 0; m < 4; ++m) { const size_t off = (size_t)(row0 + ai * 128 + m * 16) * D + col0;
#pragma unroll
                for (int bj = 0; bj < 2; ++bj) { f32x4 h0a, h0b; unpack8(hv[m][bj], h0a, h0b);
                    *(u32x4*)(pre1 + off + bj * 128) = pack8(h0a * DN_ALPHA + acc[ai][bj][m][0], h0b * DN_ALPHA + acc[ai][bj][m][1]); } } }
    }
};
struct EpiMoe1 {
    static constexpr bool PERM = true, AFTER_DRAIN = false;
    const float* b1; unsigned char* hid;
    __device__ __forceinline__ void operator()(const AccT& acc, const Unit& u, int wr, int wc, int fr, int fq) const {
        const int row0 = u.pm * 256 + wr * 64 + fr, j0 = u.pn * 128 + wc * 32 + 8 * fq; const float* bb = b1 + (size_t)u.e * 2048 + j0;
        f32x2 bg[4], bu[4];
#pragma unroll
        for (int k = 0; k < 4; ++k) { bg[k] = *(const f32x2*)(bb + 2 * k); bu[k] = *(const f32x2*)(bb + 1024 + 2 * k) + 1.0f; }
#pragma unroll
        for (int ai = 0; ai < 2; ++ai)
#pragma unroll
            for (int m = 0; m < 4; ++m) { f32x2 o[4];
#pragma unroll
                for (int k = 0; k < 4; ++k) { const int n = k >> 1, j = (k & 1) * 2;
                    const f32x2 ga = {acc[ai][0][m][n][j], acc[ai][0][m][n][j + 1]}, ua = {acc[ai][1][m][n][j], acc[ai][1][m][n][j + 1]};
                    f32x2 g = ga * W8_INV + bg[k], up = ua * W8_INV + bu[k];
                    g.x = fminf(g.x, 7.0f); g.y = fminf(g.y, 7.0f);
                    up.x = __builtin_amdgcn_fmed3f(up.x, -6.0f, 8.0f); up.y = __builtin_amdgcn_fmed3f(up.y, -6.0f, 8.0f);
                    f32x2 t = g * (-1.702f * 1.4426950408889634f);
                    t.x = __builtin_amdgcn_exp2f(t.x); t.y = __builtin_amdgcn_exp2f(t.y);
                    t = t + 1.0f;
                    t.x = __builtin_amdgcn_rcpf(t.x); t.y = __builtin_amdgcn_rcpf(t.y);
                    o[k] = (g * t) * up; }
                u32x2 w8; w8.x = pack4_fp8(o[0].x, o[0].y, o[1].x, o[1].y); w8.y = pack4_fp8(o[2].x, o[2].y, o[3].x, o[3].y);
                *(u32x2*)(hid + (size_t)(row0 + ai * 128 + m * 16) * DFF + j0) = w8; }
    }
};
struct EpiMoe2 {
    static constexpr bool PERM = true, AFTER_DRAIN = false;
    const float* b2; const float* rww; unsigned char* ys; const volatile LAS unsigned* misc;
    __device__ __forceinline__ void operator()(const AccT& acc, const Unit& u, int wr, int wc, int fr, int fq) const {
        const int row0 = u.pm * 256 + wr * 64 + fr, col0 = u.pn * 256 + wc * 32 + 8 * fq; const float* bb = b2 + (size_t)u.e * D + col0;
        f32x4 bv[2][2];
#pragma unroll
        for (int bj = 0; bj < 2; ++bj)
#pragma unroll
            for (int n = 0; n < 2; ++n) bv[bj][n] = *(const f32x4*)(bb + bj * 128 + 4 * n);
        const unsigned eoff = misc[MI_OFF + u.e], ecnt = misc[MI_CNT + u.e]; const float* rwe = rww + (size_t)u.e * TOKP;
        float wv[2][4];
#pragma unroll
        for (int ai = 0; ai < 2; ++ai)
#pragma unroll
            for (int m = 0; m < 4; ++m) { const unsigned pos = (unsigned)(row0 + ai * 128 + m * 16) - eoff; wv[ai][m] = rwe[pos < ecnt ? pos : 0u]; }
#pragma unroll
        for (int ai = 0; ai < 2; ++ai)
#pragma unroll
            for (int m = 0; m < 4; ++m) { const int row = row0 + ai * 128 + m * 16; const unsigned pos = (unsigned)row - eoff;
                const float w64 = pos < ecnt ? wv[ai][m] * YS_SCALE : 0.f;
#pragma unroll
                for (int bj = 0; bj < 2; ++bj) { const f32x4 v0 = (acc[ai][bj][m][0] * W8_INV + bv[bj][0]) * w64, v1 = (acc[ai][bj][m][1] * W8_INV + bv[bj][1]) * w64;
                    u32x2 o8; o8.x = pack4_fp8(v0[0], v0[1], v0[2], v0[3]); o8.y = pack4_fp8(v1[0], v1[1], v1[2], v1[3]); *(u32x2*)(ys + (size_t)row * D + col0 + bj * 128) = o8; } }
    }
};

struct Ctx { LAS unsigned char* lds; volatile LAS unsigned* MISC; int tid, lane, wave, G, gw, NGW; unsigned char* ws; };

__device__ __forceinline__ void transpose_item(const float* W, int ldw, int k0, int srccol, bf16_t* WT, int ldt, int dstrow, LAS float* scr, int lane) {
    float wv_[32];
#pragma unroll
    for (int i = 0; i < 32; ++i) { const int kk = 2 * i + (lane >> 5); wv_[i] = W[(size_t)(k0 + kk) * ldw + srccol + (lane & 31)]; }
#pragma unroll
    for (int i = 0; i < 32; ++i) { const int kk = 2 * i + (lane >> 5); scr[kk * 33 + (lane & 31)] = wv_[i]; }
    LDS_WAIT(); asm volatile("" ::: "memory");
    const int c = lane & 7;
#pragma unroll
    for (int j = 0; j < 4; ++j) { const int n = (lane >> 3) + 8 * j; const LAS float* s = scr + (8 * c) * 33 + n;
        u32x4 o; o.x = pk2(s[0 * 33], s[1 * 33]); o.y = pk2(s[2 * 33], s[3 * 33]); o.z = pk2(s[4 * 33], s[5 * 33]); o.w = pk2(s[6 * 33], s[7 * 33]);
        *(u32x4*)(WT + (size_t)(dstrow + n) * ldt + k0 + 8 * c) = o; }
    LDS_WAIT(); asm volatile("" ::: "memory");
}
__device__ __forceinline__ void transpose_item8(const float* W, int ldw, int k0, int srccol, unsigned char* WT, int ldt, int dstrow, LAS float* scr, int lane) {
    float wv_[32];
#pragma unroll
    for (int i = 0; i < 32; ++i) { const int kk = 2 * i + (lane >> 5); wv_[i] = W[(size_t)(k0 + kk) * ldw + srccol + (lane & 31)]; }
#pragma unroll
    for (int i = 0; i < 32; ++i) { const int kk = 2 * i + (lane >> 5); scr[kk * 33 + (lane & 31)] = wv_[i]; }
    LDS_WAIT(); asm volatile("" ::: "memory");
    const int c = lane & 7;
#pragma unroll
    for (int j = 0; j < 4; ++j) { const int n = (lane >> 3) + 8 * j; const LAS float* s = scr + (8 * c) * 33 + n;
        u32x2 o; o.x = pack4_fp8(s[0 * 33] * W8_SCALE, s[1 * 33] * W8_SCALE, s[2 * 33] * W8_SCALE, s[3 * 33] * W8_SCALE); o.y = pack4_fp8(s[4 * 33] * W8_SCALE, s[5 * 33] * W8_SCALE, s[6 * 33] * W8_SCALE, s[7 * 33] * W8_SCALE);
        *(u32x2*)(WT + (size_t)(dstrow + n) * ldt + k0 + 8 * c) = o; }
    LDS_WAIT(); asm volatile("" ::: "memory");
}
__device__ __forceinline__ void ln_row(const float* xrow, const float* gam, const float* bet, int lane, f32x4 (&y)[4]) {
    const f32x4* xr = (const f32x4*)xrow + lane; float s = 0.f;
#pragma unroll
    for (int j = 0; j < 4; ++j) { y[j] = xr[64 * j]; s += (y[j].x + y[j].y) + (y[j].z + y[j].w); }
    const float mean = wave_sum(s) * (1.f / D); float s2 = 0.f;
#pragma unroll
    for (int j = 0; j < 4; ++j) { y[j] = y[j] - mean; s2 += (y[j].x * y[j].x + y[j].y * y[j].y) + (y[j].z * y[j].z + y[j].w * y[j].w); }
    const float rstd = frsq(wave_sum(s2) * (1.f / D) + LN_EPS);
#pragma unroll
    for (int j = 0; j < 4; ++j) { const f32x4 gv = ((const f32x4*)gam)[lane + 64 * j], bv = ((const f32x4*)bet)[lane + 64 * j]; y[j] = y[j] * rstd * gv + bv; }
}
__device__ __forceinline__ void store_row_bf16(bf16_t* orow, int lane, const f32x4 (&y)[4]) {
    u32x2* o8 = (u32x2*)orow + lane;
#pragma unroll
    for (int j = 0; j < 4; ++j) { u32x2 w; w.x = pk2(y[j].x, y[j].y); w.y = pk2(y[j].z, y[j].w); o8[64 * j] = w; }
}
__device__ __forceinline__ void phase_prep(const P& p, const Ctx& c) {
    const float* w_in = p.in[I_WIN];
    if ((int)blockIdx.x * 32 < CIN) {
        LAS float* h0m = (LAS float*)c.lds; LAS float* red = (LAS float*)(c.lds + 65536);
#pragma unroll
        for (int rr = 0; rr < 2; ++rr) { const int m = 2 * c.wave + rr; f32x4 y[4]; ln_row(p.in[I_META] + (size_t)m * D, p.in[I_ELG], p.in[I_ELB], c.lane, y);
#pragma unroll
            for (int j = 0; j < 4; ++j) *(LAS f32x4*)(h0m + m * D + 4 * c.lane + 256 * j) = y[j]; }
        __syncthreads();
        const int cc = c.tid & 31, ks = c.tid >> 5, col = blockIdx.x * 32 + cc; float acc[16];
#pragma unroll
        for (int m = 0; m < 16; ++m) acc[m] = 0.f;
        if (col < CIN) {
#pragma unroll 1
            for (int k0 = ks * 64; k0 < ks * 64 + 64; k0 += 32) { float wv[32];
#pragma unroll
                for (int i = 0; i < 32; ++i) wv[i] = w_in[(size_t)(k0 + i) * CIN + col];
                __builtin_amdgcn_sched_barrier(0);
#pragma unroll
                for (int i = 0; i < 32; ++i) {
#pragma unroll
                    for (int m = 0; m < 16; ++m) acc[m] += h0m[m * D + k0 + i] * wv[i];
                    if (i & 1) __builtin_amdgcn_sched_barrier(0); } } }
#pragma unroll
        for (int m = 0; m < 16; ++m) red[(ks * 16 + m) * 32 + cc] = acc[m];
        __syncthreads();
        { const int m = c.tid >> 5; float s = 0.f;
#pragma unroll
          for (int k2 = 0; k2 < 16; ++k2) s += red[(k2 * 16 + m) * 32 + cc];
          if (col < CIN) ((float*)(c.ws + WS_PM))[(size_t)m * CIN + col] = s; }
        __syncthreads();
    }
    { const int gid = (int)blockIdx.x * NTHR + c.tid; if (gid < NEXP * D) { const int k = gid >> 5, e = gid & 31; ((bf16_t*)(c.ws + WS_WRT))[e * D + k] = (bf16_t)f2bf(p.in[I_WR][gid]); } }
    for (int i = c.gw * 64 + c.lane; i < 224 * 128; i += c.NGW * 64) { const u32x4 z = {0u, 0u, 0u, 0u}; ((u32x4*)(c.ws + WS_WIN + (size_t)7712 * D * (G1_FP8 ? 1 : 2)))[i] = z; }
    LAS float* scr = (LAS float*)(c.lds + c.wave * 17408);
    constexpr int I_IN = 241 * 16, I_SQ = 512, I_1 = 32 * 1024, I_2 = 32 * 512, NITEMS = I_IN + 3 * I_SQ + I_1 + I_2;
    bf16_t* WIN = (bf16_t*)(c.ws + WS_WIN);
    for (int it = c.gw; it < I_IN + 3 * I_SQ; it += c.NGW) {
        int r = it;
#if G1_FP8
        if (r < I_IN) { const int nb = r % 241, kb = r / 241, dr = 32 * nb; transpose_item8(w_in, CIN, 64 * kb, nb == 240 ? C_BG : (dr < 4096 ? dr : dr + 16), c.ws + WS_WIN, D, dr, scr, c.lane); continue; } r -= I_IN;
#else
        if (r < I_IN) { const int nb = r % 241, kb = r / 241, dr = 32 * nb; transpose_item(w_in, CIN, 64 * kb, nb == 240 ? C_BG : (dr < 4096 ? dr : dr + 16), WIN, D, dr, scr, c.lane); continue; } r -= I_IN;
#endif
        if (r < I_SQ) { const int nb = r % 32, kb = r / 32; transpose_item(p.in[I_WBG], D, 64 * kb, 32 * nb, (bf16_t*)(c.ws + WS_WBG), D, 32 * nb, scr, c.lane); continue; } r -= I_SQ;
        if (r < I_SQ) { const int nb = r % 32, kb = r / 32; transpose_item(p.in[I_WBS], D, 64 * kb, 32 * nb, (bf16_t*)(c.ws + WS_WBS), D, 32 * nb, scr, c.lane); continue; } r -= I_SQ;
        if (r < I_SQ) { const int nb = r % 32, kb = r / 32; transpose_item(p.in[I_WOUT], D, 64 * kb, 32 * nb, (bf16_t*)(c.ws + WS_WOUT), D, 32 * nb, scr, c.lane); continue; } r -= I_SQ;
        (void)r; }
    { const int kr = c.lane >> 3, n4 = (c.lane & 7) * 4; (void)NITEMS;
      auto decode = [&](int r, const float*& src, int& ldw, unsigned char*& dst) {
          if (r < I_1) { const int e = r / 1024, q = r % 1024, nb = q % 64, kb = q / 64, dr = 32 * nb; const int sc = ((dr >> 7) & 1) * 1024 + (dr >> 8) * 128 + (dr & 127);
              ldw = 2048; src = p.in[I_W1] + (size_t)e * D * 2048 + (size_t)(64 * kb) * 2048 + sc; dst = c.ws + WS_W1 + (size_t)e * 2048 * D + (size_t)dr * D + 64 * kb; }
          else { r -= I_1; const int e = r / 512, q = r % 512, nb = q % 32, kb = q / 32;
              ldw = D; src = p.in[I_W2] + (size_t)e * DFF * D + (size_t)(64 * kb) * D + 32 * nb; dst = c.ws + WS_W2 + (size_t)e * D * DFF + (size_t)(32 * nb) * DFF + 64 * kb; } };
      static_assert((I_1 + I_2) % 2 == 0, "item pairs");
      f32x4 va[8], vb[8]; const float* src; unsigned char *dsta, *dstb; int ldw;
      LAS float* scrb = scr + 64 * 33;
      int it = c.gw; const int NI = I_1 + I_2;
      auto loadp = [&](int i0) {
          decode(i0, src, ldw, dsta);
#pragma unroll
          for (int j = 0; j < 8; ++j) va[j] = *(const f32x4*)(src + (size_t)(8 * j + kr) * ldw + n4);
          if (i0 + c.NGW < NI) { decode(i0 + c.NGW, src, ldw, dstb);
#pragma unroll
              for (int j = 0; j < 8; ++j) vb[j] = *(const f32x4*)(src + (size_t)(8 * j + kr) * ldw + n4); } };
      if (it < NI) loadp(it);
#pragma unroll 1
      for (; it < NI; it += 2 * c.NGW) { const bool hasb = it + c.NGW < NI;
#pragma unroll
          for (int j = 0; j < 8; ++j) { LAS float* sp = scr + (8 * j + kr) * 33 + n4; sp[0] = va[j].x; sp[1] = va[j].y; sp[2] = va[j].z; sp[3] = va[j].w;
              LAS float* sq2 = scrb + (8 * j + kr) * 33 + n4; sq2[0] = vb[j].x; sq2[1] = vb[j].y; sq2[2] = vb[j].z; sq2[3] = vb[j].w; }
          unsigned char* da = dsta; unsigned char* db = dstb;
          if (it + 2 * c.NGW < NI) loadp(it + 2 * c.NGW);
          LDS_WAIT(); asm volatile("" ::: "memory");
          const int cc = c.lane & 7;
#pragma unroll
          for (int j = 0; j < 4; ++j) { const int n = (c.lane >> 3) + 8 * j; const LAS float* sq = scr + (8 * cc) * 33 + n;
              u32x2 o; o.x = pack4_fp8(sq[0 * 33] * W8_SCALE, sq[1 * 33] * W8_SCALE, sq[2 * 33] * W8_SCALE, sq[3 * 33] * W8_SCALE); o.y = pack4_fp8(sq[4 * 33] * W8_SCALE, sq[5 * 33] * W8_SCALE, sq[6 * 33] * W8_SCALE, sq[7 * 33] * W8_SCALE);
              *(u32x2*)(da + (size_t)n * D + 8 * cc) = o;
              if (hasb) { const LAS float* sr = scrb + (8 * cc) * 33 + n;
                  u32x2 o2; o2.x = pack4_fp8(sr[0 * 33] * W8_SCALE, sr[1 * 33] * W8_SCALE, sr[2 * 33] * W8_SCALE, sr[3 * 33] * W8_SCALE); o2.y = pack4_fp8(sr[4 * 33] * W8_SCALE, sr[5 * 33] * W8_SCALE, sr[6 * 33] * W8_SCALE, sr[7 * 33] * W8_SCALE);
                  *(u32x2*)(db + (size_t)n * D + 8 * cc) = o2; } }
          LDS_WAIT(); asm volatile("" ::: "memory");
      } }
}

__device__ __forceinline__ void meta_state(const P& p, const Ctx& c, int h, LAS unsigned char* lb) {
    LAS float* kf = (LAS float*)lb; LAS float* vf = kf + 16 * 128; LAS float* red = vf + 16 * 128; LAS float* bet = red + 2 * 4 * 128; LAS float* gg = bet + 16;
    const float* PM = (const float*)(c.ws + WS_PM); const float* cw = p.in[I_CONVW];
    { const int tl = c.tid >> 5, cg = c.tid & 31; float kk[4], vv[4]; float ss = 0.f;
#pragma unroll
      for (int j = 0; j < 4; ++j) { const int ch = h * 128 + 4 * cg + j; float ak = 0.f, av = 0.f;
#pragma unroll
          for (int i = 0; i < 4; ++i) { const int tt = tl - 3 + i; if (tt >= 0) { ak += cw[(size_t)(1024 + ch) * 4 + i] * PM[(size_t)tt * CIN + C_KG + ch]; av += cw[(size_t)(2048 + ch) * 4 + i] * PM[(size_t)tt * CIN + C_VG + ch]; } }
          kk[j] = siluf_(ak); vv[j] = siluf_(av); ss += kk[j] * kk[j]; }
      ss += sx<1>(ss); ss += sx<2>(ss); ss += sx<4>(ss); ss += sx<8>(ss); ss += sx<16>(ss);
      const float rn = frsq(ss + RMS_EPS);
#pragma unroll
      for (int j = 0; j < 4; ++j) { kf[tl * 128 + 4 * cg + j] = kk[j] * rn; vf[tl * 128 + 4 * cg + j] = vv[j]; }
      if (cg == 0) { bet[tl] = sigmoidf_(PM[(size_t)tl * CIN + C_BG + h]); gg[tl] = fexp(-fexp(p.in[I_ALOG][h]) * softplusf_(PM[(size_t)tl * CIN + C_AG + h] + p.in[I_DTB][h])); } }
    __syncthreads();
    float S[32];
#pragma unroll
    for (int k = 0; k < 32; ++k) S[k] = 0.f;
    const int v = c.tid & 127, rg = c.tid >> 7;
#pragma unroll 1
    for (int t = 0; t < 16; ++t) { float pk = 0.f;
#pragma unroll
        for (int k = 0; k < 32; ++k) pk += S[k] * kf[t * 128 + rg * 32 + k];
        red[((t & 1) * 4 + rg) * 128 + v] = pk;
        __syncthreads();
        const float sk = (red[((t & 1) * 4 + 0) * 128 + v] + red[((t & 1) * 4 + 1) * 128 + v]) + (red[((t & 1) * 4 + 2) * 128 + v] + red[((t & 1) * 4 + 3) * 128 + v]);
        const float g = gg[t], u = bet[t] * (vf[t * 128 + v] - g * sk);
#pragma unroll
        for (int k = 0; k < 32; ++k) S[k] = g * S[k] + kf[t * 128 + rg * 32 + k] * u; }
    float* S1 = (float*)(c.ws + WS_S1) + (size_t)h * 128 * 128;
#pragma unroll
    for (int k = 0; k < 32; ++k) S1[(rg * 32 + k) * 128 + v] = S[k];
    bf16_t* HALO = (bf16_t*)(c.ws + WS_HALO);
    for (int it = c.tid; it < BATCH * 3 * 3 * 16; it += NTHR) { const int cg2 = it & 15, which = (it >> 4) % 3, i = (it / 48) % 3, b = it / 144; const int ch0 = which * 1024 + h * 128 + 8 * cg2;
        const float* mp = PM + (size_t)(NMETA - 3 + i) * CIN + ch0; const f32x4 m0 = *(const f32x4*)mp, m1 = *(const f32x4*)(mp + 4);
        *(u32x4*)(HALO + ((size_t)(BATCH + b) * 3 + i) * 3072 + ch0) = pack8(m0, m1); }
    __syncthreads();
}


__device__ __forceinline__ float red16(float v) { v += sx<1>(v); v += sx<2>(v); v += sx<4>(v); v += sx<8>(v); return v; }
__device__ __forceinline__ void quad_load(const float* row, int sub, f32x4 (&y)[16]) { const f32x4* xr = (const f32x4*)row + sub;
#pragma unroll
    for (int j = 0; j < 16; ++j) y[j] = xr[16 * j]; }
__device__ __forceinline__ void quad_load_bf16(const bf16_t* row, int sub, f32x4 (&y)[16]) { const u32x2* xr = (const u32x2*)row + sub;
#pragma unroll
    for (int j = 0; j < 16; ++j) { const u32x2 w = xr[16 * j]; y[j] = (f32x4){bflo(w.x), bfhi(w.x), bflo(w.y), bfhi(w.y)}; } }
__device__ __forceinline__ void stage_gb(const Ctx& c, const float* g, const float* b, LAS float* dst) {
    if (c.tid < 256) *(LAS f32x4*)(dst + 4 * c.tid) = *(const f32x4*)(g + 4 * c.tid); else *(LAS f32x4*)(dst + 1024 + 4 * (c.tid - 256)) = *(const f32x4*)(b + 4 * (c.tid - 256));
}
__device__ __forceinline__ void quad_norm(f32x4 (&y)[16], const LAS float* gam, const LAS float* bet, int sub) {
    float s = 0.f;
#pragma unroll
    for (int j = 0; j < 16; ++j) s += (y[j].x + y[j].y) + (y[j].z + y[j].w);
    const float mean = red16(s) * (1.f / D); float s2 = 0.f;
#pragma unroll
    for (int j = 0; j < 16; ++j) { y[j] = y[j] - mean; s2 += (y[j].x * y[j].x + y[j].y * y[j].y) + (y[j].z * y[j].z + y[j].w * y[j].w); }
    const float rstd = frsq(red16(s2) * (1.f / D) + LN_EPS);
#pragma unroll
    for (int j = 0; j < 16; ++j) { const f32x4 gv = ((const LAS f32x4*)gam)[16 * j + sub], bv = ((const LAS f32x4*)bet)[16 * j + sub]; y[j] = y[j] * rstd * gv + bv;
        if ((j & 3) == 3) __builtin_amdgcn_sched_barrier(0); }
}
__device__ __forceinline__ void quad_store_bf16(bf16_t* orow, int sub, const f32x4 (&y)[16]) { u32x2* o8 = (u32x2*)orow + sub;
#pragma unroll
    for (int j = 0; j < 16; ++j) { u32x2 w; w.x = pg8::cvt_pk_bf16(y[j].x, y[j].y); w.y = pg8::cvt_pk_bf16(y[j].z, y[j].w); o8[16 * j] = w; } }

__device__ __forceinline__ void quad_store_fp8(unsigned char* orow, int sub, const f32x4 (&y)[16]) { unsigned* o4 = (unsigned*)orow + sub;
#pragma unroll
    for (int j = 0; j < 16; ++j) o4[16 * j] = pack4_fp8(y[j].x, y[j].y, y[j].z, y[j].w); }
constexpr int GB_LN2 = 0, GB_EMB = 8192, GB_LN1 = 98304;
constexpr int GB_EMB2 = 106496;
__device__ __forceinline__ void phase_ln0(const P& p, const Ctx& c, int g, int wid, int nw, int gboff) {
    bf16_t* H0 = (bf16_t*)(c.ws + WS_H0); const int sub = c.lane & 15, rs = c.lane >> 4; const LAS float* gL = (const LAS float*)(c.lds + gboff); const LAS float* bL = gL + 1024;
    for (int q0 = wid; q0 < TOK / 4; q0 += 2 * nw) { const int q1 = q0 + nw; const bool has1 = q1 < TOK / 4;
        const int r0 = 4 * q0 + rs, r1 = 4 * (has1 ? q1 : q0) + rs;
        f32x4 y0[16], y1[16];
        quad_load(p.in[I_X] + ((size_t)(r0 >> 9) * SEQ + g * TSL + (r0 & (TSL - 1))) * D, sub, y0);
        quad_load(p.in[I_X] + ((size_t)(r1 >> 9) * SEQ + g * TSL + (r1 & (TSL - 1))) * D, sub, y1);
        quad_norm(y0, gL, bL, sub); quad_store_bf16(H0 + (size_t)r0 * D, sub, y0); quad_store_fp8(c.ws + WS_H0Q + (size_t)r0 * D, sub, y0);
        if (has1) { quad_norm(y1, gL, bL, sub); quad_store_bf16(H0 + (size_t)r1 * D, sub, y1); quad_store_fp8(c.ws + WS_H0Q + (size_t)r1 * D, sub, y1); }
    }
}

__device__ __forceinline__ void ln1_norm(const P& p, const Ctx& c, int r, int sub, f32x4 (&y)[16]) {
    bf16_t* H1 = (bf16_t*)(c.ws + WS_H1);
    quad_norm(y, (const LAS float*)(c.lds + GB_LN1), (const LAS float*)(c.lds + GB_LN1) + 1024, sub);
    quad_store_bf16(H1 + (size_t)r * D, sub, y);
    int r2 = r, sub2 = sub; asm volatile("" : "+v"(r2), "+v"(sub2));
    unsigned* h8 = (unsigned*)(c.ws + WS_H1Q + (size_t)r2 * D) + sub2;
#pragma unroll
    for (int j = 0; j < 16; ++j) h8[16 * j] = pack4_fp8(y[j].x, y[j].y, y[j].z, y[j].w);
}
constexpr int RT_WS = 1032;
__device__ __forceinline__ void phase_ln1_router(const P& p, const Ctx& c, int g, int ln0_next) {
    LAS bf16_t* wrb = (LAS bf16_t*)c.lds;
    LAS float* lgs = (LAS float*)(c.lds + 32 * RT_WS * 2);
    { const u32x4* wrt = (const u32x4*)(c.ws + WS_WRT); u32x4 wv[8];
#pragma unroll
      for (int i = 0; i < 8; ++i) wv[i] = wrt[c.tid + NTHR * i];
#pragma unroll
      for (int i = 0; i < 8; ++i) { const int ch = c.tid + NTHR * i, e = ch >> 7, k8 = ch & 127; *(LAS u32x4*)(wrb + e * RT_WS + 8 * k8) = wv[i]; } }
    stage_gb(c, p.in[I_L1G], p.in[I_L1B], (LAS float*)(c.lds + GB_LN1));
    if (ln0_next >= 0) stage_gb(c, p.in[I_ELG], p.in[I_ELB], (LAS float*)(c.lds + GB_EMB2));
    if (c.tid < NEXP) c.MISC[MI_LCNT + c.tid] = 0u;
    __syncthreads();
    const bf16_t* PRE1 = (const bf16_t*)(c.ws + WS_PRE1); const int sub = c.lane & 15, rs = c.lane >> 4;
    const int rloc = 64 * blockIdx.x, rbase = (g & 1) * TOK + rloc;
    { const int r0 = rbase + 8 * c.wave + rs, r1 = r0 + 4, l0 = rloc + 8 * c.wave + rs, l1 = l0 + 4; f32x4 y0[16], y1[16]; u32x2 w0[16], w1[16];
      { const u32x2* x0 = (const u32x2*)(PRE1 + (size_t)l0 * D) + sub; const u32x2* x1 = (const u32x2*)(PRE1 + (size_t)l1 * D) + sub;
#pragma unroll
        for (int j = 0; j < 16; ++j) { w0[j] = x0[16 * j]; w1[j] = x1[16 * j]; } }
      __builtin_amdgcn_sched_barrier(0);
#pragma unroll
      for (int j = 0; j < 16; ++j) { y0[j] = (f32x4){bflo(w0[j].x), bfhi(w0[j].x), bflo(w0[j].y), bfhi(w0[j].y)}; y1[j] = (f32x4){bflo(w1[j].x), bfhi(w1[j].x), bflo(w1[j].y), bfhi(w1[j].y)}; }
      ln1_norm(p, c, r0, sub, y0); ln1_norm(p, c, r1, sub, y1); }
    asm volatile("s_waitcnt vmcnt(0)" ::: "memory");
    __syncthreads();
    int* TOPI = (int*)(c.ws + WS_TOPI); float* TOPW = (float*)(c.ws + WS_TOPW); int* RANK = (int*)(c.ws + WS_RANK);
    if (c.wave < 4) {
        const int i15 = c.lane & 15, kq = c.lane >> 4, R0 = rbase + 16 * c.wave; const bf16_t* H1 = (const bf16_t*)(c.ws + WS_H1);
        const bf16_t* hrow = H1 + (size_t)(R0 + i15) * D + 8 * kq;
        f32x4 a0 = *(const f32x4*)(p.in[I_BR] + 4 * kq), a1 = *(const f32x4*)(p.in[I_BR] + 16 + 4 * kq);
        pg8::bf16x8 bf[32];
#pragma unroll
        for (int j = 0; j < 32; ++j) bf[j] = *(const pg8::bf16x8*)(hrow + 32 * j);
        __builtin_amdgcn_sched_barrier(0);
#pragma unroll
        for (int j = 0; j < 32; ++j) { const int ko = 32 * j + 8 * kq;
            const pg8::bf16x8 w0 = *(const LAS pg8::bf16x8*)(wrb + i15 * RT_WS + ko), w1 = *(const LAS pg8::bf16x8*)(wrb + (16 + i15) * RT_WS + ko);
            a0 = __builtin_amdgcn_mfma_f32_16x16x32_bf16(w0, bf[j], a0, 0, 0, 0); a1 = __builtin_amdgcn_mfma_f32_16x16x32_bf16(w1, bf[j], a1, 0, 0, 0); }
        LAS float* lg = lgs + c.wave * 16 * 33;
#pragma unroll
        for (int r = 0; r < 4; ++r) { lg[i15 * 33 + 4 * kq + r] = a0[r]; lg[i15 * 33 + 16 + 4 * kq + r] = a1[r]; }
        asm volatile("s_waitcnt lgkmcnt(0)" ::: "memory");
        if (c.lane < 16) { const int r = R0 + c.lane; float v[32];
#pragma unroll
            for (int e = 0; e < 32; ++e) v[e] = lg[c.lane * 33 + e];
            int sel[4]; float val[4];
#pragma unroll
            for (int k = 0; k < 4; ++k) { float best = -3.0e38f; int bi = 0;
#pragma unroll
                for (int e = 0; e < 32; ++e) if (v[e] > best) { best = v[e]; bi = e; }
                sel[k] = bi; val[k] = best;
#pragma unroll
                for (int e = 0; e < 32; ++e) v[e] = (e == bi) ? -3.0e38f : v[e]; }
            const float e1 = fexp(val[1] - val[0]), e2 = fexp(val[2] - val[0]), e3 = fexp(val[3] - val[0]); const float inv = frcp(1.0f + e1 + e2 + e3);
            const float ww[4] = {inv, e1 * inv, e2 * inv, e3 * inv};
#pragma unroll
            for (int k = 0; k < 4; ++k) { const unsigned rk = __hip_atomic_fetch_add((LAS unsigned*)(c.MISC + MI_LCNT + sel[k]), 1u, __ATOMIC_RELAXED, __HIP_MEMORY_SCOPE_WORKGROUP);
                TOPI[(size_t)r * 4 + k] = sel[k]; TOPW[(size_t)r * 4 + k] = ww[k]; RANK[(size_t)r * 4 + k] = (int)rk; } }
    } else if (ln0_next >= 0) {
        phase_ln0(p, c, ln0_next, (int)blockIdx.x * 4 + (c.wave - 4), (int)gridDim.x * 4, GB_EMB2);
    }
    asm volatile("s_waitcnt vmcnt(0)" ::: "memory");
    __syncthreads();
    int lane2 = lane_fresh(); const int tid2 = c.wave * 64 + lane2;
    if (tid2 < NEXP) { unsigned* gc = (unsigned*)(c.ws + WS_CTL) + CW_CNT + ((g >> 1) * NEXP + tid2) * 32; c.MISC[MI_LBASE + tid2] = atomicAdd(gc, (unsigned)c.MISC[MI_LCNT + tid2]); }
    __syncthreads();
    if (tid2 < 256) { const size_t i = (size_t)rbase * 4 + tid2; const int e = __hip_atomic_load(TOPI + i, __ATOMIC_RELAXED, __HIP_MEMORY_SCOPE_AGENT); const int pos = RANK[i] + (int)c.MISC[MI_LBASE + e]; RANK[i] = pos;
        ((int*)(c.ws + WS_RTOK))[(size_t)e * TOKP + pos] = (int)(i >> 2); ((float*)(c.ws + WS_RWW))[(size_t)e * TOKP + pos] = TOPW[i]; }
}
__device__ __forceinline__ int moe_tables(const Ctx& c, int pr) {
    const unsigned* cnt = (const unsigned*)(c.ws + WS_CTL) + CW_CNT + pr * NEXP * 32;
    if (c.wave == 0) { const int e = c.lane & 31; const unsigned cv = __hip_atomic_load(cnt + e * 32, __ATOMIC_RELAXED, __HIP_MEMORY_SCOPE_AGENT), pd = (cv + 255u) & ~255u; unsigned inc = pd;
#pragma unroll
        for (int o = 1; o < 32; o <<= 1) { const unsigned t = shfl_up_u(inc, o, c.lane); if (e >= o) inc += t; }
        if (c.lane < 32) { c.MISC[MI_OFF + e] = inc - pd; c.MISC[MI_CNT + e] = cv; if (e == 31) c.MISC[MI_OFF + NEXP] = inc; } }
    __syncthreads();
    const int ntiles = (int)(c.MISC[MI_OFF + NEXP] >> 8);
    for (int t = c.tid; t < ntiles; t += NTHR) { int e = 0; for (int k = 1; k < NEXP; ++k) if ((unsigned)(t * 256) >= c.MISC[MI_OFF + k]) e = k; c.MISC[MI_TE + t] = (unsigned)e; }
    __syncthreads();
    return ntiles;
}
__device__ __forceinline__ void phase_combine(const P& p, const Ctx& c, int pr) {
    const bf16_t* H1 = (const bf16_t*)(c.ws + WS_H1); const unsigned char* YS = c.ws + WS_YS; const int* TOPI = (const int*)(c.ws + WS_TOPI); const int* RANK = (const int*)(c.ws + WS_RANK);
    const int sub = c.lane & 15, rs = c.lane >> 4;
    for (int q = c.gw; q < TOKP / 4; q += c.NGW) { const int r = 4 * q + rs;
        int sl[4];
#pragma unroll
        for (int k = 0; k < 4; ++k) sl[k] = (int)c.MISC[MI_OFF + TOPI[(size_t)r * 4 + k]] + RANK[(size_t)r * 4 + k];
        f32x4 v[16];
        u32x4 hw[8]; u32x2 yw[4][8];
#pragma unroll
        for (int j = 0; j < 8; ++j) { hw[j] = ((const u32x4*)(H1 + (size_t)r * D))[16 * j + sub];
#pragma unroll
            for (int k = 0; k < 4; ++k) yw[k][j] = ((const u32x2*)(YS + (size_t)sl[k] * D))[16 * j + sub]; }
#pragma unroll
        for (int j = 0; j < 8; ++j) { f32x4 a0, a1; unpack8(hw[j], a0, a1); a0 = a0 * DN_ALPHA; a1 = a1 * DN_ALPHA; f32x4 y0 = {0.f, 0.f, 0.f, 0.f}, y1 = {0.f, 0.f, 0.f, 0.f};
#pragma unroll
            for (int k = 0; k < 4; ++k) { const f32x2 p0 = __builtin_amdgcn_cvt_pk_f32_fp8((int)yw[k][j].x, false), p1 = __builtin_amdgcn_cvt_pk_f32_fp8((int)yw[k][j].x, true), p2 = __builtin_amdgcn_cvt_pk_f32_fp8((int)yw[k][j].y, false), p3 = __builtin_amdgcn_cvt_pk_f32_fp8((int)yw[k][j].y, true);
                y0 = y0 + (f32x4){p0.x, p0.y, p1.x, p1.y}; y1 = y1 + (f32x4){p2.x, p2.y, p3.x, p3.y}; }
            v[2 * j] = a0 + y0 * YS_INV; v[2 * j + 1] = a1 + y1 * YS_INV; }
        float s = 0.f;
#pragma unroll
        for (int j = 0; j < 16; ++j) s += (v[j].x + v[j].y) + (v[j].z + v[j].w);
        const float mean = red16(s) * (1.f / D); float s2 = 0.f;
#pragma unroll
        for (int j = 0; j < 16; ++j) { v[j] = v[j] - mean; s2 += (v[j].x * v[j].x + v[j].y * v[j].y) + (v[j].z * v[j].z + v[j].w * v[j].w); }
        const float rstd = frsq(red16(s2) * (1.f / D) + LN_EPS);
        const int rl = r & (TOK - 1), gs = NP * pr + (r >= TOK ? 1 : 0);
        float* orow = p.out + ((size_t)(rl >> 9) * SEQ + gs * TSL + (rl & (TSL - 1))) * D;
#pragma unroll
        for (int j = 0; j < 8; ++j) { const int k0 = 128 * j + 8 * sub;
            const LAS float* gL = (const LAS float*)(c.lds + GB_LN2); const f32x4 g0 = *(const LAS f32x4*)(gL + k0), g1 = *(const LAS f32x4*)(gL + k0 + 4), b0 = *(const LAS f32x4*)(gL + 1024 + k0), b1 = *(const LAS f32x4*)(gL + 1024 + k0 + 4);
            *(f32x4*)(orow + k0) = v[2 * j] * rstd * g0 + b0; *(f32x4*)(orow + k0 + 4) = v[2 * j + 1] * rstd * g1 + b1;
            if (j & 1) __builtin_amdgcn_sched_barrier(0); }
    }
}

typedef short bf16x8 __attribute__((ext_vector_type(8)));
typedef float f32x16 __attribute__((ext_vector_type(16)));
typedef short bf16x4 __attribute__((ext_vector_type(4)));
constexpr int SW_K = 0, SW_KT = 9216, SW_VT = 36864, SW_VTT = 8704, SW_KM = 71680, SW_VTM = 76288;
constexpr float L2E = 1.4426950408889634f;
__device__ __forceinline__ bf16x8 mk8(bf16x4 a, bf16x4 b) { return (bf16x8){a[0], a[1], a[2], a[3], b[0], b[1], b[2], b[3]}; }
template <int MODE>
__device__ __forceinline__ void swa_tile(LAS unsigned char* lds, int kt, int jt, int iq, int lane, float slope2, const bf16x8 (&qf)[4], float& m, float& l, f32x16& ot0, f32x16& ot1) {
    const int r31 = lane & 31, h = lane >> 5;
    const int dq = iq - jt - 4 * h;
    const float cl = -slope2 * (float)dq; const int dmax = iq < 127 ? iq : 127;
    f32x16 s0, s1;
#pragma unroll
    for (int r = 0; r < 16; ++r) { const int ko = 8 * (r >> 2) + (r & 3);
        float t0 = fmaf(slope2, (float)ko, cl), t1 = fmaf(slope2, (float)(ko + 32), cl);
        if (MODE == 1) { const int d0 = dq - ko, d1 = dq - ko - 32; t0 = ((unsigned)d0 <= (unsigned)dmax) ? t0 : -3.0e38f; t1 = ((unsigned)d1 <= (unsigned)dmax) ? t1 : -3.0e38f; }
        s0[r] = t0; s1[r] = t1; }
    const LAS unsigned char* kb0 = lds + SW_K + kt * SW_KT + r31 * 144 + h * 16;
#pragma unroll
    for (int ks = 0; ks < 4; ++ks) { const bf16x8 a0 = *(const LAS bf16x8*)(kb0 + ks * 32), a1 = *(const LAS bf16x8*)(kb0 + 32 * 144 + ks * 32);
        s0 = __builtin_amdgcn_mfma_f32_32x32x16_bf16(a0, qf[ks], s0, 0, 0, 0); s1 = __builtin_amdgcn_mfma_f32_32x32x16_bf16(a1, qf[ks], s1, 0, 0, 0); }
    __builtin_amdgcn_sched_barrier(0);
    float mx = -3.0e38f;
#pragma unroll
    for (int r = 0; r < 16; ++r) mx = fmaxf(mx, fmaxf(s0[r], s1[r]));
    mx = fmaxf(mx, sx<32>(mx));
    const float mn = fmaxf(m, mx), sc = __builtin_amdgcn_exp2f(m - mn); m = mn;
    float ls = 0.f;
#pragma unroll
    for (int r = 0; r < 16; ++r) { s0[r] = __builtin_amdgcn_exp2f(s0[r] - mn); s1[r] = __builtin_amdgcn_exp2f(s1[r] - mn); ls += s0[r] + s1[r]; }
    l = l * sc + ls;
#pragma unroll
    for (int r = 0; r < 16; ++r) { ot0[r] *= sc; ot1[r] *= sc; }
    bf16x8 pf[2][2];
#pragma unroll
    for (int s = 0; s < 2; ++s) {
        u32x4 w0, w1;
        w0.x = pg8::cvt_pk_bf16(s0[8 * s + 0], s0[8 * s + 1]); w0.y = pg8::cvt_pk_bf16(s0[8 * s + 2], s0[8 * s + 3]); w0.z = pg8::cvt_pk_bf16(s0[8 * s + 4], s0[8 * s + 5]); w0.w = pg8::cvt_pk_bf16(s0[8 * s + 6], s0[8 * s + 7]);
        w1.x = pg8::cvt_pk_bf16(s1[8 * s + 0], s1[8 * s + 1]); w1.y = pg8::cvt_pk_bf16(s1[8 * s + 2], s1[8 * s + 3]); w1.z = pg8::cvt_pk_bf16(s1[8 * s + 4], s1[8 * s + 5]); w1.w = pg8::cvt_pk_bf16(s1[8 * s + 6], s1[8 * s + 7]);
        pf[0][s] = __builtin_bit_cast(bf16x8, w0); pf[1][s] = __builtin_bit_cast(bf16x8, w1); }
    __builtin_amdgcn_sched_barrier(0);
    const LAS unsigned char* vb0 = lds + SW_VT + kt * SW_VTT + r31 * 136 + h * 8; const int swz = (r31 >> 3) & 3;
#pragma unroll
    for (int kb = 0; kb < 2; ++kb)
#pragma unroll
        for (int s = 0; s < 2; ++s) { const int g0 = 4 * kb + 2 * s;
            const bf16x8 a0 = mk8(*(const LAS bf16x4*)(vb0 + ((g0 ^ swz) << 4)), *(const LAS bf16x4*)(vb0 + (((g0 + 1) ^ swz) << 4))),
                         a1 = mk8(*(const LAS bf16x4*)(vb0 + 32 * 136 + ((g0 ^ (swz + 4)) << 4)), *(const LAS bf16x4*)(vb0 + 32 * 136 + (((g0 + 1) ^ (swz + 4)) << 4)));
            ot0 = __builtin_amdgcn_mfma_f32_32x32x16_bf16(a0, pf[kb][s], ot0, 0, 0, 0); ot1 = __builtin_amdgcn_mfma_f32_32x32x16_bf16(a1, pf[kb][s], ot1, 0, 0, 0); }
    __builtin_amdgcn_sched_barrier(0);
}
__device__ __forceinline__ void swa_meta(LAS unsigned char* lds, int iq, int lane, float slope2, const bf16x8 (&qf)[4], float& m, float& l, f32x16& ot0, f32x16& ot1) {
    const int r31 = lane & 31, h = lane >> 5;
    const float cl = -slope2 * (float)(NMETA + iq - 4 * h);
    f32x16 s0;
#pragma unroll
    for (int r = 0; r < 16; ++r) { const int ko = 8 * (r >> 2) + (r & 3); s0[r] = r < 8 ? fmaf(slope2, (float)ko, cl) : 0.f; }
    const LAS unsigned char* kb0 = lds + SW_KM + r31 * 144 + h * 16;
#pragma unroll
    for (int ks = 0; ks < 4; ++ks) { const bf16x8 a0 = *(const LAS bf16x8*)(kb0 + ks * 32); s0 = __builtin_amdgcn_mfma_f32_32x32x16_bf16(a0, qf[ks], s0, 0, 0, 0); }
    float mx = -3.0e38f;
#pragma unroll
    for (int r = 0; r < 8; ++r) mx = fmaxf(mx, s0[r]);
    mx = fmaxf(mx, sx<32>(mx));
    const float mn = fmaxf(m, mx), sc = __builtin_amdgcn_exp2f(m - mn); m = mn;
    float ls = 0.f;
#pragma unroll
    for (int r = 0; r < 8; ++r) { s0[r] = __builtin_amdgcn_exp2f(s0[r] - mn); ls += s0[r]; }
    l = l * sc + ls;
#pragma unroll
    for (int r = 0; r < 16; ++r) { ot0[r] *= sc; ot1[r] *= sc; }
    u32x4 w0; w0.x = pg8::cvt_pk_bf16(s0[0], s0[1]); w0.y = pg8::cvt_pk_bf16(s0[2], s0[3]); w0.z = pg8::cvt_pk_bf16(s0[4], s0[5]); w0.w = pg8::cvt_pk_bf16(s0[6], s0[7]);
    const bf16x8 pf = __builtin_bit_cast(bf16x8, w0);
    const LAS unsigned char* vb0 = lds + SW_VTM + r31 * 72 + h * 8;
    const bf16x8 a0 = mk8(*(const LAS bf16x4*)(vb0), *(const LAS bf16x4*)(vb0 + 16)), a1 = mk8(*(const LAS bf16x4*)(vb0 + 32 * 72), *(const LAS bf16x4*)(vb0 + 32 * 72 + 16));
    ot0 = __builtin_amdgcn_mfma_f32_32x32x16_bf16(a0, pf, ot0, 0, 0, 0); ot1 = __builtin_amdgcn_mfma_f32_32x32x16_bf16(a1, pf, ot1, 0, 0, 0);
    __builtin_amdgcn_sched_barrier(0);
}
__device__ __forceinline__ void swa_unit(const P& p, const Ctx& c, int g, int u) {
    const int b = u >> 4, hk = (u >> 2) & 3, qt = u & 3, i0 = g * TSL + qt * 128;
    const bf16_t* KSF = (const bf16_t*)(c.ws + WS_KSF); const bf16_t* VSF = (const bf16_t*)(c.ws + WS_VSF); const float* PM = (const float*)(c.ws + WS_PM);
    const bf16_t* QS = (const bf16_t*)(c.ws + WS_QS); bf16_t* OS = (bf16_t*)(c.ws + WS_OSW);
    LAS unsigned char* lds = c.lds;
    { const int kk = c.tid >> 3, ch = c.tid & 7;
      u32x4 kv[4], vv[4]; f32x4 mk0 = {0.f, 0.f, 0.f, 0.f}, mk1 = {0.f, 0.f, 0.f, 0.f}; float mv[4] = {0.f, 0.f, 0.f, 0.f};
#pragma unroll
      for (int kt = 0; kt < 4; ++kt) { const int j = i0 - 128 + 64 * kt + kk, jc = j < 0 ? 0 : j; const size_t off = ((size_t)b * SEQ + jc) * 256 + hk * 64 + ch * 8;
          kv[kt] = *(const u32x4*)(KSF + off); vv[kt] = *(const u32x4*)(VSF + off); }
      const int mrow = c.tid >> 3, md = c.tid >> 3, m4 = (c.tid & 7) * 4;
      if (c.tid < 256 && mrow < NMETA) { const float* kp = PM + (size_t)mrow * CIN + C_KS + hk * 64 + ch * 8; mk0 = *(const f32x4*)kp; mk1 = *(const f32x4*)(kp + 4); }
      if (m4 < NMETA) { const float* vp = PM + (size_t)m4 * CIN + C_VS + hk * 64 + md; mv[0] = vp[0]; mv[1] = vp[CIN]; mv[2] = vp[2 * CIN]; mv[3] = vp[3 * CIN]; }
#pragma unroll
      for (int kt = 0; kt < 4; ++kt) {
          *(LAS u32x4*)(lds + SW_K + kt * SW_KT + kk * 144 + ch * 16) = kv[kt];
          LAS unsigned char* vt = lds + SW_VT + kt * SW_VTT + (ch * 8) * 136 + ((((kk >> 3) ^ ch) << 3) + (kk & 7)) * 2;
          *(LAS bf16_t*)(vt + 0 * 136) = (bf16_t)(vv[kt].x & 0xffffu); *(LAS bf16_t*)(vt + 1 * 136) = (bf16_t)(vv[kt].x >> 16); *(LAS bf16_t*)(vt + 2 * 136) = (bf16_t)(vv[kt].y & 0xffffu); *(LAS bf16_t*)(vt + 3 * 136) = (bf16_t)(vv[kt].y >> 16);
          *(LAS bf16_t*)(vt + 4 * 136) = (bf16_t)(vv[kt].z & 0xffffu); *(LAS bf16_t*)(vt + 5 * 136) = (bf16_t)(vv[kt].z >> 16); *(LAS bf16_t*)(vt + 6 * 136) = (bf16_t)(vv[kt].w & 0xffffu); *(LAS bf16_t*)(vt + 7 * 136) = (bf16_t)(vv[kt].w >> 16); }
      if (c.tid < 256) *(LAS u32x4*)(lds + SW_KM + mrow * 144 + ch * 16) = pack8(mk0, mk1);
      { u32x2 w; w.x = pg8::cvt_pk_bf16(mv[0], mv[1]); w.y = pg8::cvt_pk_bf16(mv[2], mv[3]); *(LAS u32x2*)(lds + SW_VTM + md * 72 + m4 * 2) = w; } }
    bf16x8 qf[4];
    { const int hq_ = 4 * hk + (c.wave & 3), r31_ = c.lane & 31, h_ = c.lane >> 5; const size_t row_ = (size_t)b * TSL + qt * 128 + (c.wave >> 2) * 64 + r31_;
#pragma unroll
      for (int ks = 0; ks < 4; ++ks) qf[ks] = *(const bf16x8*)(QS + row_ * D + hq_ * 64 + 16 * ks + 8 * h_); }
    __syncthreads();
    { const int gh = c.wave & 3, half = c.wave >> 2, hq = 4 * hk + gh, lane = c.lane, r31 = lane & 31, h = lane >> 5;
      const float slope2 = __builtin_amdgcn_exp2f(-0.5f * (float)(hq + 1)) * L2E, sink2 = p.in[I_SINK][hq] * L2E;
#pragma unroll 1
      for (int qb = 0; qb < 2; ++qb) {
          const int tl = qt * 128 + half * 64 + qb * 32 + r31, iq = g * TSL + tl; const size_t row = (size_t)b * TSL + tl;
          if (qb) {
#pragma unroll
              for (int ks = 0; ks < 4; ++ks) qf[ks] = *(const bf16x8*)(QS + row * D + hq * 64 + 16 * ks + 8 * h); }
          float m = sink2, l = h == 0 ? 1.0f : 0.0f; f32x16 ot0, ot1;
#pragma unroll
          for (int r = 0; r < 16; ++r) { ot0[r] = 0.f; ot1[r] = 0.f; }
          swa_meta(lds, iq, lane, slope2, qf, m, l, ot0, ot1);
          const int jt0 = i0 - 128 + 64 * half;
          swa_tile<1>(lds, half, jt0, iq, lane, slope2, qf, m, l, ot0, ot1);
          if (jt0 + 64 < 0) swa_tile<1>(lds, half + 1, jt0 + 64, iq, lane, slope2, qf, m, l, ot0, ot1); else swa_tile<0>(lds, half + 1, jt0 + 64, iq, lane, slope2, qf, m, l, ot0, ot1);
          swa_tile<1>(lds, half + 2, jt0 + 128, iq, lane, slope2, qf, m, l, ot0, ot1);
          const float inv = frcp(l + sx<32>(l));
          bf16_t* op = OS + row * D + hq * 64 + 4 * h;
#pragma unroll
          for (int gq = 0; gq < 4; ++gq) { u32x2 w0, w1;
              w0.x = pg8::cvt_pk_bf16(ot0[4 * gq] * inv, ot0[4 * gq + 1] * inv); w0.y = pg8::cvt_pk_bf16(ot0[4 * gq + 2] * inv, ot0[4 * gq + 3] * inv);
              w1.x = pg8::cvt_pk_bf16(ot1[4 * gq] * inv, ot1[4 * gq + 1] * inv); w1.y = pg8::cvt_pk_bf16(ot1[4 * gq + 2] * inv, ot1[4 * gq + 3] * inv);
              *(u32x2*)(op + 8 * gq) = w0; *(u32x2*)(op + 32 + 8 * gq) = w1; }
      } }
    __syncthreads();
}

constexpr int IM_W = 0, IM_QD = 16384, IM_QK = 32768, IM_KDT = 40960, IM_UV = 57344, UNIT_BYTES = 73728;
constexpr size_t WS_IMG = GR + 432 * MiB, WS_GT = 251 * MiB;
constexpr int GA_A = 0, GA_T = 16896, GA_GAM = 26112, GA_K = 27136, GA_Q = 44544, GA_KBT = 61952, GA_VBT = 80384;
__device__ __forceinline__ u32x4 pack8r(const f32x16& v, int s, float sc) {
    u32x4 w; w.x = pg8::cvt_pk_bf16(v[8 * s + 0] * sc, v[8 * s + 1] * sc); w.y = pg8::cvt_pk_bf16(v[8 * s + 2] * sc, v[8 * s + 3] * sc); w.z = pg8::cvt_pk_bf16(v[8 * s + 4] * sc, v[8 * s + 5] * sc); w.w = pg8::cvt_pk_bf16(v[8 * s + 6] * sc, v[8 * s + 7] * sc); return w; }
struct GdnRaw { u32x4 r[3][5]; float lg, be; };
__device__ __forceinline__ void gdn_a_prefetch(const Ctx& c, int g, int u, GdnRaw& R) {
    const int n = u & 7, h = (u >> 3) & 7, b = u >> 6, cg = c.tid & 15;
    const bf16_t* QKVG = (const bf16_t*)(c.ws + WS_QKVG); const bf16_t* HALO = (const bf16_t*)(c.ws + WS_HALO);
    const int tok0 = n * 64 + 2 * (c.tid >> 4);
#pragma unroll
    for (int i = 0; i < 5; ++i) { const int tt = tok0 - 3 + i;
        const bf16_t* mid = (tt >= 0 ? QKVG + ((size_t)b * TSL + tt) * 3072 : HALO + ((size_t)(((g + 1) & 1) * BATCH + b) * 3 + (3 + tt)) * 3072) + 1024 + h * 128 + 8 * cg;
        R.r[0][i] = *(const u32x4*)(mid - 1024); R.r[1][i] = *(const u32x4*)(mid); R.r[2][i] = *(const u32x4*)(mid + 1024); }
    const size_t row = (size_t)b * TSL + n * 64 + (c.lane);
    R.lg = ((const float*)(c.ws + WS_LOGG))[row * 8 + h]; R.be = ((const float*)(c.ws + WS_BETA))[row * 8 + h];
}
template <int R0>
__device__ __forceinline__ void gdn_conv8(const LAS float* cw, const u32x4 (&rawr)[5], f32x2 (&y)[4]) {
    f32x2 acc[4];
#pragma unroll
    for (int i = 0; i < 4; ++i) { const f32x4 w0 = *(const LAS f32x4*)(cw + i * 128), w1 = *(const LAS f32x4*)(cw + i * 128 + 4); const u32x4 rw = rawr[R0 + i];
        const f32x2 x0 = {bflo(rw.x), bfhi(rw.x)}, x1 = {bflo(rw.y), bfhi(rw.y)}, x2 = {bflo(rw.z), bfhi(rw.z)}, x3 = {bflo(rw.w), bfhi(rw.w)};
        const f32x2 wa = {w0.x, w0.y}, wb = {w0.z, w0.w}, wc = {w1.x, w1.y}, wd = {w1.z, w1.w};
        if (i == 0) { acc[0] = wa * x0; acc[1] = wb * x1; acc[2] = wc * x2; acc[3] = wd * x3; }
        else { acc[0] = acc[0] + wa * x0; acc[1] = acc[1] + wb * x1; acc[2] = acc[2] + wc * x2; acc[3] = acc[3] + wd * x3; } }
#pragma unroll
    for (int p = 0; p < 4; ++p) { f32x2 t = acc[p] * (-1.4426950408889634f);
        t.x = __builtin_amdgcn_exp2f(t.x); t.y = __builtin_amdgcn_exp2f(t.y); t = t + 1.0f; t.x = __builtin_amdgcn_rcpf(t.x); t.y = __builtin_amdgcn_rcpf(t.y);
        y[p] = acc[p] * t; }
}
constexpr int GA_CW = 98816, GA_TF = 104960, GA_XS = 121856;
constexpr int GA_LD = 66;
#define LDS_BAR() do { asm volatile("s_waitcnt lgkmcnt(0)" ::: "memory"); __builtin_amdgcn_s_barrier(); asm volatile("" ::: "memory"); } while (0)
__device__ __forceinline__ void gdn_a_unit(const P& p, const Ctx& c, int g, int u, GdnRaw& R, int unext) {
    const int n = u & 7, h = (u >> 3) & 7, b = u >> 6;
    LAS unsigned char* lds = c.lds;
    LAS float* gam = (LAS float*)(lds + GA_GAM); LAS float* bet = gam + 64; LAS float* egam = gam + 128; LAS float* ekd = gam + 192;
    LAS float* Amat = (LAS float*)(lds + GA_A); LAS float* TF = (LAS float*)(lds + GA_TF);
    const bf16_t* QKVG = (const bf16_t*)(c.ws + WS_QKVG); bf16_t* HALO = (bf16_t*)(c.ws + WS_HALO);
    unsigned char* img = c.ws + WS_IMG + (size_t)u * UNIT_BYTES;
    const int lane = c.lane, l31 = lane & 31, hh = lane >> 5;
    { AMP_BEGIN(16)
    if (c.wave == 0) { float ps = R.lg;
#pragma unroll
        for (int o = 1; o < 64; o <<= 1) { const float t = shfl_up_f(ps, o, lane); if (lane >= o) ps += t; }
        const float last = __builtin_bit_cast(float, __builtin_amdgcn_readlane(__builtin_bit_cast(int, ps), 63));
        gam[lane] = ps; bet[lane] = R.be; egam[lane] = fexp(ps); ekd[lane] = fexp(last - ps);
        if (lane == 63) ((float*)(c.ws + WS_GT))[u] = fexp(ps); }
    if (n == 7 && c.tid >= 64 && c.tid < 64 + 144) { const int t2 = c.tid - 64, i = t2 / 48, which = (t2 / 16) % 3, cg2 = t2 & 15;
        *(u32x4*)(HALO + ((size_t)((g & 1) * BATCH + b) * 3 + i) * 3072 + which * 1024 + h * 128 + 8 * cg2) = *(const u32x4*)(QKVG + ((size_t)b * TSL + (TSL - 3 + i)) * 3072 + which * 1024 + h * 128 + 8 * cg2); }
    LDS_BAR(); AMP_END(16) }
    { AMP_BEGIN(17)
    const LAS float* cwb = (const LAS float*)(lds + GA_CW) + 8 * (c.tid & 15);
    { const int cg = c.tid & 15, cl0 = 2 * (c.tid >> 4); f32x2 kbp[2][4], vbp[2][4];
#pragma unroll
      for (int pass = 0; pass < 2; ++pass) { const int cl = cl0 + pass; f32x2 yq[4], yk[4], yv[4];
        if (pass == 0) { gdn_conv8<0>(cwb, R.r[0], yq); gdn_conv8<0>(cwb + 512, R.r[1], yk); gdn_conv8<0>(cwb + 1024, R.r[2], yv); }
        else           { gdn_conv8<1>(cwb, R.r[0], yq); gdn_conv8<1>(cwb + 512, R.r[1], yk); gdn_conv8<1>(cwb + 1024, R.r[2], yv); }
        f32x2 sq2 = yq[0] * yq[0], sk2 = yk[0] * yk[0];
#pragma unroll
        for (int p = 1; p < 4; ++p) { sq2 = sq2 + yq[p] * yq[p]; sk2 = sk2 + yk[p] * yk[p]; }
        float sq = sq2.x + sq2.y, sk = sk2.x + sk2.y;
        sq += sx<1>(sq); sk += sx<1>(sk); sq += sx<2>(sq); sk += sx<2>(sk); sq += sx<4>(sq); sk += sx<4>(sk); sq += sx<8>(sq); sk += sx<8>(sk);
        const float rq_ = 0.08838834764831845f * frsq(sq + RMS_EPS), rk_ = frsq(sk + RMS_EPS), be = bet[cl] * egam[cl], bv = bet[cl];
        u32x4 qw, kw;
#pragma unroll
        for (int p = 0; p < 4; ++p) { const f32x2 qs = yq[p] * rq_, ks = yk[p] * rk_; qw[p] = pg8::cvt_pk_bf16(qs.x, qs.y); kw[p] = pg8::cvt_pk_bf16(ks.x, ks.y); kbp[pass][p] = ks * be; vbp[pass][p] = yv[p] * bv; }
        *(LAS u32x4*)(lds + GA_Q + cl * 272 + cg * 16) = qw; *(LAS u32x4*)(lds + GA_K + cl * 272 + cg * 16) = kw; }
#pragma unroll
      for (int j = 0; j < 8; ++j) { const float k0v = (j & 1) ? kbp[0][j >> 1].y : kbp[0][j >> 1].x, k1v = (j & 1) ? kbp[1][j >> 1].y : kbp[1][j >> 1].x, v0v = (j & 1) ? vbp[0][j >> 1].y : vbp[0][j >> 1].x, v1v = (j & 1) ? vbp[1][j >> 1].y : vbp[1][j >> 1].x;
          const int so = (8 * cg + j) * 144 + ((((cl0 >> 3) ^ (cg & 7)) << 3) + (cl0 & 7)) * 2;
          *(LAS unsigned*)(lds + GA_KBT + so) = pg8::cvt_pk_bf16(k0v, k1v); *(LAS unsigned*)(lds + GA_VBT + so) = pg8::cvt_pk_bf16(v0v, v1v); } }
    if (unext >= 0) gdn_a_prefetch(c, g, unext, R);
    LDS_BAR(); AMP_END(17) }
    { AMP_BEGIN(18)
    { const int w = c.wave & 3, rb = w >> 1, cb = w & 1; const bool isqk = c.wave >= 4;
      f32x16 acc;
#pragma unroll
      for (int r = 0; r < 16; ++r) acc[r] = 0.f;
      const bool zero = isqk ? (rb == 1 && cb == 0) : (rb == 0 && cb == 1);
      if (!zero) { const LAS unsigned char* ap = lds + GA_K + (32 * rb + l31) * 272 + hh * 16; const LAS unsigned char* bp = lds + (isqk ? GA_Q : GA_K) + (32 * cb + l31) * 272 + hh * 16;
#pragma unroll
          for (int ks = 0; ks < 8; ++ks) acc = __builtin_amdgcn_mfma_f32_32x32x16_bf16(*(const LAS bf16x8*)(ap + ks * 32), *(const LAS bf16x8*)(bp + ks * 32), acc, 0, 0, 0); }
      const int colx = 32 * cb + l31; const float gcol = gam[colx];
      if (!isqk) {
#pragma unroll
          for (int r = 0; r < 16; ++r) { const int cc = 32 * rb + 8 * (r >> 2) + 4 * hh + (r & 3); Amat[cc * GA_LD + colx] = (cc > colx) ? bet[cc] * acc[r] * fexp(gam[cc] - gcol) : 0.f; } }
      else {
#pragma unroll
          for (int r = 0; r < 16; ++r) { const int sp = 32 * rb + 8 * (r >> 2) + 4 * hh + (r & 3); acc[r] = (sp <= colx) ? acc[r] * fexp(gcol - gam[sp]) : 0.f; }
#pragma unroll
          for (int s = 0; s < 2; ++s) *(u32x4*)(img + IM_QK + ((((cb * 2 + rb) * 2 + s) * 64 + lane) * 16)) = pack8r(acc, s, 1.0f); } }
    LDS_BAR(); AMP_END(18) }
    { AMP_BEGIN(19)
    if (c.wave == 0) {
        const int blk = lane >> 4, cc = lane & 15; const LAS float* Ab = Amat + (16 * blk) * GA_LD + 16 * blk; float t[16]; const float lf = (float)cc;
#pragma unroll
        for (int i = 0; i < 16; ++i) { float s = fmaxf(1.0f - fabsf(lf - (float)i), 0.0f);
#pragma unroll
            for (int j = 0; j < i; ++j) s -= Ab[i * GA_LD + j] * t[j];
            t[i] = s; }
#pragma unroll
        for (int i = 0; i < 16; ++i) TF[(16 * blk + i) * GA_LD + 16 * blk + cc] = t[i];
    } else {
        for (int pid = c.tid - 64; pid < 2048; pid += NTHR - 64) { const int which = pid >> 10, f = (pid >> 6) & 15, ln = pid & 63, pl = ln & 31, ph = ln >> 5;
            if (which == 0) { const int ct = f >> 3, kt = (f >> 1) & 3, s = f & 1, cc = 32 * ct + pl; const float e = egam[cc];
                const LAS unsigned char* qp = lds + GA_Q + cc * 272 + (32 * kt + 16 * s + 4 * ph) * 2; const u32x2 a = *(const LAS u32x2*)qp, d = *(const LAS u32x2*)(qp + 16);
                u32x4 w; w.x = pg8::cvt_pk_bf16(bflo(a.x) * e, bfhi(a.x) * e); w.y = pg8::cvt_pk_bf16(bflo(a.y) * e, bfhi(a.y) * e); w.z = pg8::cvt_pk_bf16(bflo(d.x) * e, bfhi(d.x) * e); w.w = pg8::cvt_pk_bf16(bflo(d.y) * e, bfhi(d.y) * e);
                *(u32x4*)(img + IM_QD + (f * 64 + ln) * 16) = w; }
            else { const int kt = f >> 2, ctp = (f >> 1) & 1, s = f & 1, dk = 32 * kt + pl, c0 = 32 * ctp + 16 * s + 4 * ph; float v[8];
#pragma unroll
                for (int j = 0; j < 8; ++j) { const int cc = c0 + 8 * (j >> 2) + (j & 3); v[j] = bf1(*(const LAS bf16_t*)(lds + GA_K + cc * 272 + dk * 2)) * ekd[cc]; }
                u32x4 w; w.x = pg8::cvt_pk_bf16(v[0], v[1]); w.y = pg8::cvt_pk_bf16(v[2], v[3]); w.z = pg8::cvt_pk_bf16(v[4], v[5]); w.w = pg8::cvt_pk_bf16(v[6], v[7]);
                *(u32x4*)(img + IM_KDT + (f * 64 + ln) * 16) = w; } }
    }
    LDS_BAR(); AMP_END(19) }
    { AMP_BEGIN(20)
    { const int i15 = lane & 15, kq = lane >> 4; LAS float* XS = (LAS float*)(lds + GA_XS) + (c.wave < 3 ? c.wave : 0) * 16 * 17;
#pragma unroll 1
      for (int bi = 1; bi < 4; ++bi) {
          if (c.wave < bi) { const int cb = c.wave; f32x4 x = {0.f, 0.f, 0.f, 0.f};
#pragma unroll 1
              for (int bj = cb; bj < bi; ++bj)
#pragma unroll
                  for (int kk = 0; kk < 4; ++kk) x = __builtin_amdgcn_mfma_f32_16x16x4f32(Amat[(16 * bi + i15) * GA_LD + 16 * bj + 4 * kk + kq], TF[(16 * bj + 4 * kk + kq) * GA_LD + 16 * cb + i15], x, 0, 0, 0);
#pragma unroll
              for (int r = 0; r < 4; ++r) XS[(4 * kq + r) * 17 + i15] = x[r];
              asm volatile("s_waitcnt lgkmcnt(0)" ::: "memory");
              f32x4 t = {0.f, 0.f, 0.f, 0.f};
#pragma unroll
              for (int kk = 0; kk < 4; ++kk) t = __builtin_amdgcn_mfma_f32_16x16x4f32(TF[(16 * bi + i15) * GA_LD + 16 * bi + 4 * kk + kq], XS[(4 * kk + kq) * 17 + i15], t, 0, 0, 0);
#pragma unroll
              for (int r = 0; r < 4; ++r) TF[(16 * bi + 4 * kq + r) * GA_LD + 16 * cb + i15] = -t[r]; }
          LDS_BAR(); } }
    AMP_END(20) }
    { AMP_BEGIN(21)
    { const int row = c.tid >> 3, c8 = (c.tid & 7) * 8; f32x4 a, d;
#pragma unroll
      for (int j = 0; j < 4; ++j) { a[j] = (c8 <= (row | 15)) ? TF[row * GA_LD + c8 + j] : 0.f; d[j] = (c8 <= (row | 15)) ? TF[row * GA_LD + c8 + 4 + j] : 0.f; }
      *(LAS u32x4*)(lds + GA_T + row * 144 + c8 * 2) = pack8(a, d); }
    LDS_BAR();
    { const int kt = c.wave >> 1, ct = c.wave & 1; f32x16 acc;
#pragma unroll
      for (int r = 0; r < 16; ++r) acc[r] = 0.f;
      const LAS unsigned char* ap = lds + GA_KBT + (32 * kt + l31) * 144; const LAS unsigned char* bp = lds + GA_T + (32 * ct + l31) * 144 + hh * 16; const int swz = (4 * kt + (l31 >> 3)) & 7;
#pragma unroll
      for (int ks = 0; ks < 4; ++ks) acc = __builtin_amdgcn_mfma_f32_32x32x16_bf16(*(const LAS bf16x8*)(ap + (((hh + 2 * ks) ^ swz) << 4)), *(const LAS bf16x8*)(bp + ks * 32), acc, 0, 0, 0);
#pragma unroll
      for (int s = 0; s < 2; ++s) *(u32x4*)(img + IM_W + ((((ct * 4 + kt) * 2 + s) * 64 + lane) * 16)) = pack8r(acc, s, -1.0f); }
    { const int ct = c.wave >> 2, vt = c.wave & 3; f32x16 acc;
#pragma unroll
      for (int r = 0; r < 16; ++r) acc[r] = 0.f;
      const LAS unsigned char* ap = lds + GA_T + (32 * ct + l31) * 144 + hh * 16; const LAS unsigned char* bp = lds + GA_VBT + (32 * vt + l31) * 144; const int swz = (4 * vt + (l31 >> 3)) & 7;
#pragma unroll
      for (int ks = 0; ks < 4; ++ks) acc = __builtin_amdgcn_mfma_f32_32x32x16_bf16(*(const LAS bf16x8*)(ap + ks * 32), *(const LAS bf16x8*)(bp + (((hh + 2 * ks) ^ swz) << 4)), acc, 0, 0, 0);
#pragma unroll
      for (int s = 0; s < 2; ++s) *(u32x4*)(img + IM_UV + (((ct * 4 + vt) * 64 + lane) * 32 + s * 16)) = pack8r(acc, s, 1.0f); }
    LDS_BAR(); AMP_END(21) }
}
__device__ __forceinline__ void gdn_a_units(const P& p, Ctx& c, int g, int bh) {
    { const int h = bh & 7; const float* cw = p.in[I_CONVW]; LAS float* cwl = (LAS float*)(c.lds + GA_CW);
      for (int i = c.tid; i < 3 * 128; i += NTHR) { const int which = i >> 7, ch = i & 127; const f32x4 w4 = *(const f32x4*)(cw + (size_t)(which * 1024 + h * 128 + ch) * 4); LAS float* o = cwl + which * 512 + ch; o[0] = w4.x; o[128] = w4.y; o[256] = w4.z; o[384] = w4.w; } }
    GdnRaw R; gdn_a_prefetch(c, g, bh * 8, R);
    LDS_BAR();
    c.lane = lane_fresh(); c.tid = c.wave * 64 + c.lane;
    gdn_a_unit(p, c, g, bh * 8, R, bh * 8 + 1);
#pragma unroll 1
    for (int n = 1; n < 8; ++n) { const int u = bh * 8 + n, un = n < 7 ? u + 1 : -1;
        c.lane = lane_fresh(); c.tid = c.wave * 64 + c.lane;
        gdn_a_unit(p, c, g, u, R, un); }
}

constexpr int GS_S = 0, GS_U = 32768, GS_O = 49152, GS_WQ = 66560, GS_KK = 99328;
__device__ __forceinline__ void gdn_scan_unit(const P& p, const Ctx& c, int g, int bh) {
    const int b = bh >> 3, h = bh & 7, ct = c.wave >> 2, vt = c.wave & 3, lane = c.lane, l31 = lane & 31, hh = lane >> 5;
    LAS unsigned char* lds = c.lds;
    const bf16_t* ZS = (const bf16_t*)(c.ws + WS_ZS); bf16_t* OG = (bf16_t*)(c.ws + WS_OG); const float* GT = (const float*)(c.ws + WS_GT);
    float* SC = (float*)(c.ws + WS_SC) + (size_t)bh * 128 * 128; const float* Sin = g == 0 ? (const float*)(c.ws + WS_S1) + (size_t)h * 128 * 128 : SC;
    f32x16 S0, S1;
#pragma unroll
    for (int r = 0; r < 16; ++r) { const int dk = 8 * (r >> 2) + 4 * hh + (r & 3); S0[r] = Sin[(size_t)(64 * ct + dk) * 128 + 32 * vt + l31]; S1[r] = Sin[(size_t)(64 * ct + 32 + dk) * 128 + 32 * vt + l31]; }
#pragma unroll
    for (int s = 0; s < 2; ++s) { *(LAS u32x4*)(lds + GS_S + ((((2 * ct) * 4 + vt) * 2 + s) * 64 + lane) * 16) = pack8r(S0, s, 1.0f); *(LAS u32x4*)(lds + GS_S + ((((2 * ct + 1) * 4 + vt) * 2 + s) * 64 + lane) * 16) = pack8r(S1, s, 1.0f); }
    const unsigned char* img0 = c.ws + WS_IMG + (size_t)(bh * 8) * UNIT_BYTES;
    u32x4 t0[4], t1[3], uv0, uv1; float gtn;
    { const unsigned char* img = img0;
#pragma unroll
      for (int i = 0; i < 4; ++i) t0[i] = *(const u32x4*)(img + IM_W + (size_t)(i * NTHR + c.tid) * 16);
#pragma unroll
      for (int i = 0; i < 3; ++i) t1[i] = *(const u32x4*)(img + IM_QK + (size_t)(i * NTHR + c.tid) * 16);
      uv0 = *(const u32x4*)(img + IM_UV + ((ct * 4 + vt) * 64 + lane) * 32); uv1 = *(const u32x4*)(img + IM_UV + ((ct * 4 + vt) * 64 + lane) * 32 + 16);
      gtn = __hip_atomic_load(GT + bh * 8, __ATOMIC_RELAXED, __HIP_MEMORY_SCOPE_AGENT); }
    auto chunk = [&](const int n) __attribute__((always_inline)) {
#pragma unroll
        for (int i = 0; i < 4; ++i) *(LAS u32x4*)(lds + GS_WQ + (i * NTHR + c.tid) * 16) = t0[i];
#pragma unroll
        for (int i = 0; i < 3; ++i) *(LAS u32x4*)(lds + GS_KK + (i * NTHR + c.tid) * 16) = t1[i];
        f32x16 U, O;
        U[0] = bflo(uv0.x); U[1] = bfhi(uv0.x); U[2] = bflo(uv0.y); U[3] = bfhi(uv0.y); U[4] = bflo(uv0.z); U[5] = bfhi(uv0.z); U[6] = bflo(uv0.w); U[7] = bfhi(uv0.w);
        U[8] = bflo(uv1.x); U[9] = bfhi(uv1.x); U[10] = bflo(uv1.y); U[11] = bfhi(uv1.y); U[12] = bflo(uv1.z); U[13] = bfhi(uv1.z); U[14] = bflo(uv1.w); U[15] = bfhi(uv1.w);
        const float gt = gtn;
#pragma unroll
        for (int r = 0; r < 16; ++r) O[r] = 0.f;
        LDS_BAR();
        { const unsigned char* img = img0 + (size_t)(n < 7 ? n + 1 : 7) * UNIT_BYTES;
#pragma unroll
          for (int i = 0; i < 4; ++i) t0[i] = *(const u32x4*)(img + IM_W + (size_t)(i * NTHR + c.tid) * 16);
#pragma unroll
          for (int i = 0; i < 3; ++i) t1[i] = *(const u32x4*)(img + IM_QK + (size_t)(i * NTHR + c.tid) * 16);
          uv0 = *(const u32x4*)(img + IM_UV + ((ct * 4 + vt) * 64 + lane) * 32); uv1 = *(const u32x4*)(img + IM_UV + ((ct * 4 + vt) * 64 + lane) * 32 + 16);
          gtn = __hip_atomic_load(GT + bh * 8 + (n < 7 ? n + 1 : 7), __ATOMIC_RELAXED, __HIP_MEMORY_SCOPE_AGENT); }
        const int zc = c.tid >> 3, zseg = c.tid & 7; const size_t zrow = (size_t)b * TSL + n * 64 + zc;
        const u32x4 z0 = *(const u32x4*)(ZS + zrow * D + h * 128 + zseg * 16), z1 = *(const u32x4*)(ZS + zrow * D + h * 128 + zseg * 16 + 8);
        f32x4 nwv[4];
#pragma unroll
        for (int j = 0; j < 4; ++j) nwv[j] = *(const f32x4*)(p.in[I_GNW] + zseg * 16 + 4 * j);
#pragma unroll
        for (int kt = 0; kt < 4; ++kt)
#pragma unroll
            for (int s = 0; s < 2; ++s) { const bf16x8 sb = *(const LAS bf16x8*)(lds + GS_S + (((kt * 4 + vt) * 2 + s) * 64 + lane) * 16);
                const bf16x8 aw = *(const LAS bf16x8*)(lds + GS_WQ + (((ct * 4 + kt) * 2 + s) * 64 + lane) * 16), aq = *(const LAS bf16x8*)(lds + GS_WQ + 16384 + (((ct * 4 + kt) * 2 + s) * 64 + lane) * 16);
                U = __builtin_amdgcn_mfma_f32_32x32x16_bf16(aw, sb, U, 0, 0, 0); O = __builtin_amdgcn_mfma_f32_32x32x16_bf16(aq, sb, O, 0, 0, 0); }
#pragma unroll
        for (int s = 0; s < 2; ++s) *(LAS u32x4*)(lds + GS_U + (((ct * 4 + vt) * 2 + s) * 64 + lane) * 16) = pack8r(U, s, 1.0f);
        LDS_BAR();
#pragma unroll
        for (int r = 0; r < 16; ++r) { S0[r] *= gt; S1[r] *= gt; }
#pragma unroll
        for (int cp = 0; cp < 2; ++cp)
#pragma unroll
            for (int s = 0; s < 2; ++s) { const bf16x8 ub = *(const LAS bf16x8*)(lds + GS_U + (((cp * 4 + vt) * 2 + s) * 64 + lane) * 16);
                const bf16x8 aqk = *(const LAS bf16x8*)(lds + GS_KK + (((ct * 2 + cp) * 2 + s) * 64 + lane) * 16);
                const bf16x8 ak0 = *(const LAS bf16x8*)(lds + GS_KK + 8192 + ((((2 * ct) * 2 + cp) * 2 + s) * 64 + lane) * 16), ak1 = *(const LAS bf16x8*)(lds + GS_KK + 8192 + ((((2 * ct + 1) * 2 + cp) * 2 + s) * 64 + lane) * 16);
                O = __builtin_amdgcn_mfma_f32_32x32x16_bf16(aqk, ub, O, 0, 0, 0); S0 = __builtin_amdgcn_mfma_f32_32x32x16_bf16(ak0, ub, S0, 0, 0, 0); S1 = __builtin_amdgcn_mfma_f32_32x32x16_bf16(ak1, ub, S1, 0, 0, 0); }
#pragma unroll
        for (int r = 0; r < 16; ++r) { const int cc = 32 * ct + 8 * (r >> 2) + 4 * hh + (r & 3); *(LAS bf16_t*)(lds + GS_O + cc * 272 + (32 * vt + l31) * 2) = (bf16_t)f2bf(O[r]); }
#pragma unroll
        for (int s = 0; s < 2; ++s) { *(LAS u32x4*)(lds + GS_S + ((((2 * ct) * 4 + vt) * 2 + s) * 64 + lane) * 16) = pack8r(S0, s, 1.0f); *(LAS u32x4*)(lds + GS_S + ((((2 * ct + 1) * 4 + vt) * 2 + s) * 64 + lane) * 16) = pack8r(S1, s, 1.0f); }
        LDS_BAR();
        { f32x4 o[4]; float ss = 0.f;
          const u32x4 w0 = *(const LAS u32x4*)(lds + GS_O + zc * 272 + zseg * 32), w1 = *(const LAS u32x4*)(lds + GS_O + zc * 272 + zseg * 32 + 16);
          unpack8(w0, o[0], o[1]); unpack8(w1, o[2], o[3]);
#pragma unroll
          for (int j = 0; j < 4; ++j) ss += (o[j].x * o[j].x + o[j].y * o[j].y) + (o[j].z * o[j].z + o[j].w * o[j].w);
          ss += sx<1>(ss); ss += sx<2>(ss); ss += sx<4>(ss);
          const float rn = frsq(ss * (1.f / 128.f) + RMS_EPS);
          f32x4 z[4]; unpack8(z0, z[0], z[1]); unpack8(z1, z[2], z[3]);
#pragma unroll
          for (int j = 0; j < 4; ++j) o[j] = o[j] * rn * nwv[j] * z[j];
          *(u32x4*)(OG + zrow * D + h * 128 + zseg * 16) = pack8(o[0], o[1]); *(u32x4*)(OG + zrow * D + h * 128 + zseg * 16 + 8) = pack8(o[2], o[3]); }
    };
    chunk(0);
#pragma unroll 1
    for (int n = 1; n < 8; ++n) chunk(n);
    { int l2 = l31, h2 = hh; asm volatile("" : "+v"(l2), "+v"(h2));
#pragma unroll
      for (int r = 0; r < 16; ++r) { const int dk = 8 * (r >> 2) + 4 * h2 + (r & 3); SC[(size_t)(64 * ct + dk) * 128 + 32 * vt + l2] = S0[r]; SC[(size_t)(64 * ct + 32 + dk) * 128 + 32 * vt + l2] = S1[r]; } }
    __syncthreads();
}


constexpr int NPH_G = 11, NPHASES = 1 + NG * NPH_G;
__global__ void __launch_bounds__(NTHR, 2) fwd(P p) {
    extern __shared__ __attribute__((aligned(16))) unsigned char lds_raw[];
    Ctx c; c.lds = (LAS unsigned char*)lds_raw; c.MISC = (volatile LAS unsigned*)(c.lds + MISC_OFF);
    c.tid = threadIdx.x; c.lane = c.tid & 63; c.wave = __builtin_amdgcn_readfirstlane(c.tid >> 6); c.G = gridDim.x; c.ws = p.ws;
    { const int bx = blockIdx.x; const int vcu = (c.G % 8 == 0) ? (bx % 8) * (c.G / 8) + bx / 8 : bx; c.gw = vcu * NWAVES + c.wave; c.NGW = c.G * NWAVES; }
    unsigned* ctl = (unsigned*)(p.ws + WS_CTL);
    if (c.tid < 16) c.MISC[c.tid] = 0u;
    __syncthreads();
#if MK_SINGLE
    XcdBarrier bar = xcd_barrier_post(ctl + CW_BAR, c.MISC, c.tid == 0);
#define SEAM(k) do { if (IN(k) && IN((k) + 1)) { FRESH(); xcd_barrier(bar, c.tid == 0); } } while (0)
#else
#define SEAM(k) do { } while (0)
#endif
#ifndef PHASE_MASK
#define PHASE_MASK 0xFFFF
#endif
#define IN(k) (p.ph_lo <= (k) && (k) < p.ph_hi)
#define ON(j) (((PHASE_MASK) >> (j)) & 1)
    const int bx = blockIdx.x;
#if defined(__HIP_DEVICE_COMPILE__)
    typedef const P __attribute__((address_space(4)))* KP;
    KP kp0 = (KP)__builtin_amdgcn_kernarg_segment_ptr();
#define PLOAD() KP kp_ = kp0; asm volatile("" : "+s"(kp_)); const P q = *kp_;
#else
#define PLOAD() const P q = p;
#endif
#define FRESH() do { c.lane = lane_fresh(); c.tid = c.wave * 64 + c.lane; } while (0)
    { AMP_BEGIN(11) if (ON(11) && IN(0)) { FRESH(); PLOAD(); phase_prep(q, c); __syncthreads(); FRESH(); stage_gb(c, q.in[I_ELG], q.in[I_ELB], (LAS float*)(c.lds + GB_EMB)); __syncthreads(); phase_ln0(q, c, 0, c.gw, c.NGW, GB_EMB); }
    SEAM(0); AMP_END(11) }
    for (int g = 0; g < NG; ++g) {
        const int pb = 1 + g * NPH_G;
        { AMP_BEGIN(1)
        if (ON(1) && IN(pb + 1)) { FRESH(); PLOAD();
#if G1_FP8
            SchedStd S; S.init(TOK, N1, D, c.G, bx, q.ws + WS_H0Q, q.ws + WS_WIN);
#else
            SchedStd S; S.init(TOK, N1, 2 * D, c.G, bx, q.ws + WS_H0, q.ws + WS_WIN);
#endif
            if (g == 0 && bx >= 256 - NHG) { meta_state(q, c, bx - (256 - NHG), c.lds); FRESH(); }
            EpiG1 E{(bf16_t*)(q.ws + WS_QKVG), (bf16_t*)(q.ws + WS_ZS), (bf16_t*)(q.ws + WS_QS), (bf16_t*)(q.ws + WS_KSF), (bf16_t*)(q.ws + WS_VSF), (bf16_t*)(q.ws + WS_SG), (bf16_t*)(q.ws + WS_SS), g, G1_FP8 ? W8_INV : 1.0f,
                    (float*)(q.ws + WS_BETA), (float*)(q.ws + WS_LOGG), q.in[I_ALOG], q.in[I_DTB]};
#if G1_FP8
            pg8::gemm_phase<EpiG1, SchedStd, true, true, true>(c.lds, D, S, E, c.wave);
#else
            pg8::gemm_phase<EpiG1, SchedStd, true, true>(c.lds, 2 * D, S, E, c.wave);
#endif
        }
        SEAM(pb + 1); AMP_END(1) }
        { AMP_BEGIN(2)
        if (ON(2) && IN(pb + 2)) { FRESH(); PLOAD();
            { AMP_BEGIN(12) for (int bh = bx; bh < BATCH * NHG; bh += c.G) { { AMP_BEGIN(14) gdn_a_units(q, c, g, bh); AMP_END(14) }
                asm volatile("s_waitcnt vmcnt(0)" ::: "memory"); __syncthreads();
                FRESH(); gdn_scan_unit(q, c, g, bh); } AMP_END(12) }
            { AMP_BEGIN(13) for (int u = bx; u < BATCH * NHK * 4; u += c.G) { FRESH(); swa_unit(q, c, g, u); } AMP_END(13) }
        }
        SEAM(pb + 2); AMP_END(2) }
        { AMP_BEGIN(4)
        if (ON(4) && IN(pb + 4)) { FRESH(); PLOAD();
            SchedPair S; S.init(TOK, D, 2 * D, c.G, bx, q.ws + WS_OG, q.ws + WS_WBG, q.ws + WS_OSW, q.ws + WS_WBS);
            EpiBr E{(const bf16_t*)(q.ws + WS_SG), (const bf16_t*)(q.ws + WS_SS), (bf16_t*)(q.ws + WS_Y)};
            pg8::gemm_phase<EpiBr, SchedPair, true, true>(c.lds, 2 * D, S, E, c.wave);
        }
        SEAM(pb + 4); AMP_END(4) }
        { AMP_BEGIN(5)
        if (ON(5) && IN(pb + 5)) { FRESH(); PLOAD();
            SchedStd S; S.init(TOK, D, 2 * D, c.G, bx, q.ws + WS_Y, q.ws + WS_WOUT);
            EpiOut E{(const bf16_t*)(q.ws + WS_H0), (bf16_t*)(q.ws + WS_PRE1)};
            pg8::gemm_phase<EpiOut, SchedStd, true, true>(c.lds, 2 * D, S, E, c.wave);
        }
        SEAM(pb + 5); AMP_END(5) }
        { AMP_BEGIN(6)
        if (ON(6) && IN(pb + 6)) { FRESH(); PLOAD(); phase_ln1_router(q, c, g, g + 1 < NG ? g + 1 : -1); }
        SEAM(pb + 6); AMP_END(6) }
        if (g & 1) {
        const int pr = g >> 1;
        { AMP_BEGIN(8)
        if (ON(8) && IN(pb + 8)) { FRESH(); PLOAD();
            const int ntiles = moe_tables(c, pr);
            LAS unsigned short* tokt = (LAS unsigned short*)(c.lds + RING_BYTES);
            { const int* RTOK = (const int*)(q.ws + WS_RTOK); const int nwg_ = ntiles * 8;
              int tv[9];
#pragma unroll
              for (int k = 0; k < 9; ++k) { const int it = c.tid + NTHR * k, i = it >> 8, R = it & 255, L = i * c.G + bx; tv[k] = 0;
                  if (L < nwg_) { const int rt = xcd_chunk(L, nwg_) >> 3, e = (int)c.MISC[MI_TE + rt]; const unsigned pos = (unsigned)(rt * 256 + R) - c.MISC[MI_OFF + e];
                      if (pos < c.MISC[MI_CNT + e]) tv[k] = RTOK[(size_t)e * TOKP + pos]; } }
#pragma unroll
              for (int k = 0; k < 9; ++k) { const int it = c.tid + NTHR * k, L = (it >> 8) * c.G + bx; if (L < nwg_) tokt[it] = (unsigned short)tv[k]; } }
            __syncthreads();
            SchedMoeG S; S.init(ntiles, 2 * DFF, D, c.G, bx, q.ws + WS_H1Q, q.ws + WS_W1, c.MISC + MI_TE); S.tokt = tokt;
            EpiMoe1 E{q.in[I_B1], q.ws + WS_HID};
            pg8::gemm_phase<EpiMoe1, SchedMoeG, true, true, true, true>(c.lds, D, S, E, c.wave);
        }
        SEAM(pb + 8); AMP_END(8) }
        { AMP_BEGIN(9)
        if (ON(9) && IN(pb + 9)) { FRESH(); PLOAD();
            const int ntiles = (int)(c.MISC[MI_OFF + NEXP] >> 8);
            SchedMoe S; S.init(ntiles, D, DFF, c.G, bx, q.ws + WS_HID, q.ws + WS_W2, c.MISC + MI_TE);
            EpiMoe2 E{q.in[I_B2], (const float*)(q.ws + WS_RWW), q.ws + WS_YS, c.MISC};
            pg8::gemm_phase<EpiMoe2, SchedMoe, true, true, true>(c.lds, DFF, S, E, c.wave);
        }
        SEAM(pb + 9); AMP_END(9) }
        { AMP_BEGIN(10)
        if (ON(10) && IN(pb + 10)) { FRESH(); PLOAD(); stage_gb(c, q.in[I_L2G], q.in[I_L2B], (LAS float*)(c.lds + GB_LN2)); __syncthreads();
            phase_combine(q, c, pr); }
        SEAM(pb + 10); AMP_END(10) }
        }
    }
#if defined(EXTRA_BARRIERS) && MK_SINGLE
    for (int xb = 0; xb < EXTRA_BARRIERS; ++xb) { FRESH(); xcd_barrier(bar, c.tid == 0); }
#endif
#undef IN
#undef PLOAD
#undef FRESH
#undef SEAM
}

extern "C" void kernel_launch(void* const* d_in, const int* in_sizes, int n_in, void* d_out, int out_size, void* d_ws, size_t ws_size, hipStream_t stream) {
    static int grid = 0;
    if (grid == 0) {
        if (n_in != 23 || in_sizes[0] != BATCH * SEQ * D || out_size != BATCH * SEQ * D || ws_size < WS_END) {
            fprintf(stderr, "kernel_launch: unexpected shapes (n_in %d, in0 %d, out %d, ws %zu, need %zu); nothing launched\n", n_in, n_in > 0 ? in_sizes[0] : -1, out_size, ws_size, (size_t)WS_END); grid = -1; return; }
        int dev = 0, cus = 0;
        if (hipGetDevice(&dev) != hipSuccess || hipDeviceGetAttribute(&cus, hipDeviceAttributeMultiprocessorCount, dev) != hipSuccess) { grid = -1; return; }
        if (hipFuncSetAttribute((const void*)fwd, hipFuncAttributeMaxDynamicSharedMemorySize, LDS_BYTES) != hipSuccess) { fprintf(stderr, "kernel_launch: hipFuncSetAttribute failed\n"); grid = -1; return; }
        int per_cu = 0; (void)hipOccupancyMaxActiveBlocksPerMultiprocessor(&per_cu, (const void*)fwd, NTHR, LDS_BYTES); (void)hipGetLastError();
        if (cus != 256) { fprintf(stderr, "kernel_launch: built for a 256-CU device (one workgroup per CU, 64 token rows of a slice per workgroup in the router phase); found %d CUs; nothing launched\n", cus); grid = -1; return; }
        grid = cus;
    }
    if (grid < 0) return;
    if (hipMemsetAsync((char*)d_ws + WS_CTL, 0, CTL_ZERO_BYTES, stream) != hipSuccess) return;
    P a{};
    for (int i = 0; i < 23; ++i) a.in[i] = (const float*)d_in[i];
    a.out = (float*)d_out; a.ws = (unsigned char*)d_ws;
#if MK_SINGLE
    a.ph_lo = 0; a.ph_hi = NPHASES;
    hipLaunchKernelGGL(fwd, dim3(grid), dim3(NTHR), LDS_BYTES, stream, a);
#else
    for (int ph = 0; ph < NPHASES; ++ph) { a.ph_lo = ph; a.ph_hi = ph + 1; hipLaunchKernelGGL(fwd, dim3(grid), dim3(NTHR), LDS_BYTES, stream, a); }
#endif
}
```

```cpp
#include <hip/hip_runtime.h>
#include <cstdio>
#include <cstdint>
#ifndef MK_SINGLE
#define MK_SINGLE 1
#endif
__device__ __forceinline__ int lane_fresh() { int l; asm volatile("v_mbcnt_lo_u32_b32 %0, -1, 0\n\tv_mbcnt_hi_u32_b32 %0, -1, %0" : "=v"(l)); return l; }
template <int M> __device__ __forceinline__ float sx(float v) {
    if constexpr (M < 32) return __builtin_bit_cast(float, __builtin_amdgcn_ds_swizzle(__builtin_bit_cast(int, v), 0x1F | (M << 10)));
    else return __builtin_bit_cast(float, __builtin_amdgcn_ds_bpermute((lane_fresh() ^ M) << 2, __builtin_bit_cast(int, v))); }
__device__ __forceinline__ float shfl_up_f(float v, int o, int lane) { return __builtin_bit_cast(float, __builtin_amdgcn_ds_bpermute((lane - o) << 2, __builtin_bit_cast(int, v))); }
__device__ __forceinline__ unsigned shfl_up_u(unsigned v, int o, int lane) { return (unsigned)__builtin_amdgcn_ds_bpermute((lane - o) << 2, (int)v); }
namespace pg8 {
#define PG8_LAS __attribute__((address_space(3)))
typedef unsigned short bf16_t;
typedef short bf16x8 __attribute__((ext_vector_type(8)));
typedef float f32x4 __attribute__((ext_vector_type(4)));
typedef unsigned u32x4 __attribute__((ext_vector_type(4)));
typedef unsigned u32x2 __attribute__((ext_vector_type(2)));
constexpr int BM = 256, BK = 64, HALF = 128, HTB = HALF * BK * 2  , STAGE_BYTES = 8 * HTB, NXCD = 8, WGM = 8;
__host__ __device__ __forceinline__ int lds_byte(int r, int c) { const int st = (r >> 4) * 2 + (c >> 5), rr = r & 15, cc = c & 31, ob = rr * 64 + cc * 2; return st * 1024 + (ob ^ (((ob >> 9) & 1) << 5)); }
__host__ __device__ __forceinline__ void stage_rc(int b, int& R, int& C) { const int st = b / 1024, sb = b % 1024, swz = sb ^ (((sb >> 9) & 1) << 5); R = (st >> 1) * 16 + swz / 64; C = (st & 1) * 32 + (swz % 64) / 2; }
__host__ __device__ __forceinline__ int perm32(int rho) { const int n = rho >> 4, i = rho & 15; return 8 * (i >> 2) + 4 * n + (i & 3); }
struct Unit { int pm, pn, e, kind; const char* A; const char* B; };
typedef __bf16 bf16x2n __attribute__((ext_vector_type(2))); typedef float f32x2n __attribute__((ext_vector_type(2)));
typedef int i32x8 __attribute__((ext_vector_type(8))); typedef int i32x4 __attribute__((ext_vector_type(4)));
__device__ __forceinline__ i32x8 cat8(bf16x8 a, bf16x8 b) { const i32x4 x = __builtin_bit_cast(i32x4, a), y = __builtin_bit_cast(i32x4, b); return (i32x8){x[0], x[1], x[2], x[3], y[0], y[1], y[2], y[3]}; }
__device__ __forceinline__ unsigned cvt_pk_bf16(float lo, float hi) { return __builtin_bit_cast(unsigned, __builtin_convertvector((f32x2n){lo, hi}, bf16x2n)); }
template <class Epi, class Sched, bool ALIGN_EPI = false, bool SP2 = false, bool FP8 = false, bool GATHER = false>
__device__ __forceinline__ void gemm_phase(PG8_LAS unsigned char* lds, const int KB  , const Sched& S, const Epi& E, const int wid_in) {
    int lane_ = lane_fresh();
    const int wid = wid_in, lane = lane_, tid = wid * 64 + lane, wr = wid >> 2, wc = wid & 3, fr = lane & 15, fq = lane >> 4;
    const int nt = KB / (BK * 2);
    unsigned voffA[2], voffB[2];
#pragma unroll
    for (int i = 0; i < 2; ++i) { int R, C; stage_rc(tid * 16 + i * 8192, R, C); const int Rb = Epi::PERM ? ((R & ~31) + perm32(R & 31)) : R;
        voffA[i] = (unsigned)(R * KB + C * 2); voffB[i] = (unsigned)(Rb * KB + C * 2); }
    const size_t kstep = (size_t)(BK * 2);
    const size_t hstep = (size_t)HALF * KB;
    const size_t tstep = 2 * hstep;
    const unsigned ldsw = (unsigned)wid * 1024u;
    const int aoff = lds_byte(wr * 64 + fr, fq * 8), boff = lds_byte(wc * 32 + fr, fq * 8);
#define PG8_SA(b, h) (((b) * 2 + (h)) * HTB)
#define PG8_SB(b, h) ((4 + (b) * 2 + (h)) * HTB)
#define PG8_STAGE(bufoff, gbase, voff) do { _Pragma("unroll") for (int _i = 0; _i < 2; ++_i) \
        __builtin_amdgcn_global_load_lds((const unsigned*)((const char*)(gbase) + (voff)[_i]), (PG8_LAS unsigned*)(lds + (bufoff) + ldsw + _i * 8192), 16, 0, 0); } while (0)
#define PG8_STAGEV(bufoff, gbase, pair) PG8_STAGEV2(bufoff, gbase, pair)
#define PG8_STAGEV2(bufoff, gbase, v0, v1) do { \
        __builtin_amdgcn_global_load_lds((const unsigned*)((const char*)(gbase) + (v0)), (PG8_LAS unsigned*)(lds + (bufoff) + ldsw), 16, 0, 0); \
        __builtin_amdgcn_global_load_lds((const unsigned*)((const char*)(gbase) + (v1)), (PG8_LAS unsigned*)(lds + (bufoff) + ldsw + 8192), 16, 0, 0); } while (0)
#define PG8_CV(h) cvo[h][0], cvo[h][1]
#define PG8_XV(h) (last ? nvo[h][0] : cvo[h][0]), (last ? nvo[h][1] : cvo[h][1])
#define PG8_LD2(p0) __builtin_shufflevector(*(const PG8_LAS i32x4*)(p0), *(const PG8_LAS i32x4*)((p0) + 1024), 0, 1, 2, 3, 4, 5, 6, 7)
#define PG8_LO(v) __builtin_bit_cast(bf16x8, __builtin_shufflevector(v, v, 0, 1, 2, 3))
#define PG8_HI(v) __builtin_bit_cast(bf16x8, __builtin_shufflevector(v, v, 4, 5, 6, 7))
#define PG8_LDA(dst, b, h) do { _Pragma("unroll") for (int m = 0; m < 4; ++m) dst[m] = PG8_LD2(lds + PG8_SA(b, h) + aoff + m * 2048); } while (0)
#define PG8_LDB(dst, b, h) do { _Pragma("unroll") for (int n = 0; n < 2; ++n) dst[n] = PG8_LD2(lds + PG8_SB(b, h) + boff + n * 2048); } while (0)
#if defined(FP8_NONSCALED)
#define PG8_FP8MMA(C, Bv, Av) do { typedef long l4 __attribute__((ext_vector_type(4))); const l4 bq = __builtin_bit_cast(l4, Bv), aq = __builtin_bit_cast(l4, Av); _Pragma("unroll") for (int qq = 0; qq < 4; ++qq) C = __builtin_amdgcn_mfma_f32_16x16x32_fp8_fp8(bq[qq], aq[qq], C, 0, 0, 0); } while (0)
#else
#define PG8_FP8MMA(C, Bv, Av) asm volatile("v_mfma_scale_f32_16x16x128_f8f6f4 %0, %1, %2, %0, %3, %3 op_sel_hi:[0,0,0]" : "+v"(C) : "v"(Bv), "v"(Av), "v"(sc127))
#endif
#define PG8_MMA(ai, bj, At, Bt) do { __builtin_amdgcn_s_setprio(1); \
        if constexpr (FP8) { _Pragma("unroll") for (int m = 0; m < 4; ++m) _Pragma("unroll") for (int n = 0; n < 2; ++n) \
            PG8_FP8MMA(acc[ai][bj][m][n], Bt[n], At[m]); } \
        else { _Pragma("unroll") for (int m = 0; m < 4; ++m) _Pragma("unroll") for (int n = 0; n < 2; ++n) { \
            acc[ai][bj][m][n] = __builtin_amdgcn_mfma_f32_16x16x32_bf16(PG8_LO(Bt[n]), PG8_LO(At[m]), acc[ai][bj][m][n], 0, 0, 0); \
            acc[ai][bj][m][n] = __builtin_amdgcn_mfma_f32_16x16x32_bf16(PG8_HI(Bt[n]), PG8_HI(At[m]), acc[ai][bj][m][n], 0, 0, 0); } } \
        __builtin_amdgcn_s_setprio(0); } while (0)
#define PG8_WAIT_V(n) asm volatile("s_waitcnt vmcnt(" #n ")" ::: "memory")
#define PG8_WAIT_L(n) asm volatile("s_waitcnt lgkmcnt(" #n ")" ::: "memory")
#define PG8_BAR __builtin_amdgcn_s_barrier()
#define PG8_SCHED __builtin_amdgcn_sched_barrier(0)
    Unit cur, nxt; int ui = 0;
    if (!S.next(0, cur)) return;
    unsigned cvo[2][2], nvo[2][2];
#pragma unroll
    for (int h2 = 0; h2 < 2; ++h2)
#pragma unroll
        for (int i = 0; i < 2; ++i) { if constexpr (GATHER) { int R, C; stage_rc(tid * 16 + i * 8192, R, C); cvo[h2][i] = S.rowoff(0, h2 * HALF + R) + (unsigned)(C * 2); } else cvo[h2][i] = voffA[i] + (unsigned)(h2 * HALF * KB); nvo[h2][i] = cvo[h2][i]; }
    f32x4 acc[2][2][4][2];
#pragma unroll
    for (int a = 0; a < 2; ++a)
#pragma unroll
        for (int b = 0; b < 2; ++b)
#pragma unroll
            for (int m = 0; m < 4; ++m)
#pragma unroll
                for (int n = 0; n < 2; ++n) acc[a][b][m][n] = (f32x4){0.f, 0.f, 0.f, 0.f};
    int sc127 = 127; asm volatile("" : "+v"(sc127));
    i32x8 At[4], B0[2], B1[2];
    const char* cA = cur.A; const char* cB = cur.B;
    S.a_ready(cur);
    if constexpr (SP2) {
        PG8_STAGE(PG8_SB(0, 0), cB, voffB); PG8_STAGE(PG8_SB(0, 1), cB + hstep, voffB); PG8_STAGEV(PG8_SA(0, 0), cA, PG8_CV(0)); PG8_STAGEV(PG8_SA(0, 1), cA, PG8_CV(1));
        if (wr == 1) PG8_BAR;
        PG8_WAIT_V(2); PG8_BAR;
        PG8_STAGE(PG8_SB(1, 0), cB + kstep, voffB); PG8_STAGEV(PG8_SA(1, 0), cA + kstep, PG8_CV(0)); PG8_STAGE(PG8_SB(1, 1), cB + hstep + kstep, voffB);
        PG8_WAIT_V(6); PG8_BAR;
    } else {
        PG8_STAGE(PG8_SB(0, 0), cB, voffB); PG8_STAGEV(PG8_SA(0, 0), cA, PG8_CV(0)); PG8_STAGE(PG8_SB(0, 1), cB + hstep, voffB); PG8_STAGEV(PG8_SA(0, 1), cA, PG8_CV(1));
        if (wr == 1) PG8_BAR;
        PG8_WAIT_V(4); PG8_BAR;
        PG8_STAGE(PG8_SB(1, 0), cB + kstep, voffB); PG8_STAGEV(PG8_SA(1, 0), cA + kstep, PG8_CV(0)); PG8_STAGE(PG8_SB(1, 1), cB + hstep + kstep, voffB);
        PG8_WAIT_V(6); PG8_BAR;
    }
    for (;;) {
        const bool has_next = S.next(ui + 1, nxt);
        if constexpr (GATHER) { if (has_next) {
#pragma unroll
            for (int h2 = 0; h2 < 2; ++h2)
#pragma unroll
                for (int i = 0; i < 2; ++i) { int R, C; stage_rc(tid * 16 + i * 8192, R, C); nvo[h2][i] = S.rowoff(ui + 1, h2 * HALF + R) + (unsigned)(C * 2); } } }
        const char* nA = has_next ? nxt.A : cA; const char* nB = has_next ? nxt.B : cB;
#pragma unroll 1
        for (int t = 0; t < nt; t += 2) {
            const bool last = (t == nt - 2);
            const char* a1 = cA + (size_t)(t + 1) * kstep;
            const char* a2 = last ? nA : cA + (size_t)(t + 2) * kstep; const char* b2 = last ? nB : cB + (size_t)(t + 2) * kstep;
            const char* a3 = a2 + kstep; const char* b3 = b2 + kstep;
            if (last && has_next) S.a_ready(nxt);
            if constexpr (SP2) {
            PG8_LDB(B0, 0, 0); PG8_LDB(B1, 0, 1); PG8_SCHED; PG8_LDA(At, 0, 0); PG8_STAGEV(PG8_SA(1, 1), a1, PG8_CV(1));
            PG8_WAIT_V(8); PG8_WAIT_L(0); PG8_BAR; PG8_MMA(0, 0, At, B0); PG8_MMA(0, 1, At, B1); PG8_BAR; PG8_SCHED;
            PG8_LDA(At, 0, 1); PG8_STAGE(PG8_SB(0, 0), b2, voffB); PG8_STAGE(PG8_SB(0, 1), b2 + hstep, voffB); PG8_STAGEV(PG8_SA(0, 0), a2, PG8_XV(0));
            PG8_WAIT_V(8); PG8_WAIT_L(0); PG8_BAR; PG8_MMA(1, 0, At, B0); PG8_MMA(1, 1, At, B1); PG8_BAR; PG8_SCHED;
            PG8_LDB(B0, 1, 0); PG8_LDB(B1, 1, 1); PG8_SCHED; PG8_LDA(At, 1, 0); PG8_STAGEV(PG8_SA(0, 1), a2, PG8_XV(1));
            PG8_WAIT_V(8); PG8_WAIT_L(0); PG8_BAR; PG8_MMA(0, 0, At, B0); PG8_MMA(0, 1, At, B1); PG8_BAR; PG8_SCHED;
            PG8_LDA(At, 1, 1); PG8_STAGE(PG8_SB(1, 0), b3, voffB); PG8_STAGE(PG8_SB(1, 1), b3 + hstep, voffB); PG8_STAGEV(PG8_SA(1, 0), a3, PG8_XV(0));
            PG8_WAIT_V(8); PG8_WAIT_L(0); PG8_BAR; PG8_MMA(1, 0, At, B0); PG8_MMA(1, 1, At, B1); PG8_BAR; PG8_SCHED;
            } else {
            PG8_LDB(B0, 0, 0); PG8_SCHED; PG8_LDA(At, 0, 0); PG8_STAGEV(PG8_SA(1, 1), a1, PG8_CV(1));
            PG8_WAIT_L(8); PG8_BAR; PG8_WAIT_L(0); PG8_MMA(0, 0, At, B0); PG8_BAR; PG8_SCHED;
            PG8_LDB(B1, 0, 1); PG8_STAGE(PG8_SB(0, 0), b2, voffB);
            PG8_BAR; PG8_WAIT_L(0); PG8_MMA(0, 1, At, B1); PG8_BAR;
            PG8_LDA(At, 0, 1); PG8_STAGEV(PG8_SA(0, 0), a2, PG8_XV(0));
            PG8_BAR; PG8_WAIT_L(0); PG8_MMA(1, 0, At, B0); PG8_BAR; PG8_SCHED;
            PG8_STAGE(PG8_SB(0, 1), b2 + hstep, voffB);
            PG8_WAIT_V(6); PG8_BAR; PG8_MMA(1, 1, At, B1); PG8_BAR;
            PG8_LDB(B0, 1, 0); PG8_SCHED; PG8_LDA(At, 1, 0); PG8_STAGEV(PG8_SA(0, 1), a2, PG8_XV(1));
            PG8_WAIT_L(8); PG8_BAR; PG8_WAIT_L(0); PG8_MMA(0, 0, At, B0); PG8_BAR; PG8_SCHED;
            PG8_LDB(B1, 1, 1); PG8_STAGE(PG8_SB(1, 0), b3, voffB);
            PG8_BAR; PG8_WAIT_L(0); PG8_MMA(0, 1, At, B1); PG8_BAR;
            PG8_LDA(At, 1, 1); PG8_STAGEV(PG8_SA(1, 0), a3, PG8_XV(0));
            PG8_BAR; PG8_WAIT_L(0); PG8_MMA(1, 0, At, B0); PG8_BAR; PG8_SCHED;
            PG8_STAGE(PG8_SB(1, 1), b3 + hstep, voffB);
            PG8_WAIT_V(6); PG8_BAR; PG8_MMA(1, 1, At, B1); PG8_BAR;
            }
        }
        if constexpr (ALIGN_EPI) { if (wr == 0) PG8_BAR; }
        if constexpr (FP8) asm volatile("s_nop 15\n\ts_nop 15" ::: "memory");
        if constexpr (!Epi::AFTER_DRAIN) { int le_ = lane_fresh();
            E(acc, cur, wr, wc, le_ & 15, le_ >> 4); S.done(cur); }
        if (!has_next) break;
#pragma unroll
        for (int a = 0; a < 2; ++a)
#pragma unroll
            for (int b = 0; b < 2; ++b)
#pragma unroll
                for (int m = 0; m < 4; ++m)
#pragma unroll
                    for (int n = 0; n < 2; ++n) acc[a][b][m][n] = (f32x4){0.f, 0.f, 0.f, 0.f};
        cur = nxt; cA = nA; cB = nB; ++ui;
#pragma unroll
        for (int h2 = 0; h2 < 2; ++h2)
#pragma unroll
            for (int i = 0; i < 2; ++i) cvo[h2][i] = nvo[h2][i];
        if constexpr (ALIGN_EPI) { if (wr == 1) PG8_BAR; }
    }
    PG8_WAIT_V(0);
    if constexpr (!ALIGN_EPI) { if (wr == 0) PG8_BAR; }
    PG8_BAR;
    if constexpr (Epi::AFTER_DRAIN) { E.fused(acc, cur, wr, wc, fr, fq, lds, wid, lane); S.done(cur); }
#undef PG8_SA
#undef PG8_SB
#undef PG8_STAGE
#undef PG8_LDA
#undef PG8_LDB
#undef PG8_MMA
#undef PG8_WAIT_V
#undef PG8_WAIT_L
#undef PG8_BAR
#undef PG8_SCHED
}
}


#ifndef SWA_FAST
#define SWA_FAST 1
#endif
#ifndef G1_FP8
#define G1_FP8 1
#endif
#ifndef GDN_FAST
#define GDN_FAST 1
#endif
constexpr int D = 1024, BATCH = 32, SEQ = 2048, NMETA = 16, CIN = 7696;
constexpr int NG = 4, TSL = SEQ / NG, TOK = BATCH * TSL;
constexpr int C_QG = 0, C_KG = 1024, C_VG = 2048, C_ZG = 3072, C_BG = 4096, C_AG = 4104, C_QS = 4112, C_KS = 5136, C_VS = 5392, C_GG = 5648, C_GS = 6672;
constexpr int N1 = 7936;
constexpr int NEXP = 32, TOPK = 4, DFF = 1024, NHG = 8, NHQ = 16, NHK = 4;
constexpr int NP = 4, TOKP = NP * TOK;
constexpr int NASG = TOKP * TOPK, MAXROWS = NASG + NEXP * 256, MAXTILES = MAXROWS / 256;
constexpr float LN_EPS = 1e-5f, RMS_EPS = 1e-6f;
constexpr float DN_ALPHA = 1.189207115002721f;
constexpr int NWAVES = 8, NTHR = 512;
constexpr size_t MiB = 1u << 20;
constexpr size_t WS_CTL = 0, CTL_ZERO_BYTES = 64 * 1024;
constexpr size_t WS_PM = 1 * MiB, WS_WRT = 1 * MiB + 512 * 1024  , WS_S1 = 2 * MiB, WS_WIN = 3 * MiB, WS_WBG = 19 * MiB, WS_WBS = 21 * MiB, WS_WOUT = 23 * MiB, WS_W1 = 26 * MiB, WS_W2 = 152 * MiB;
static_assert(WS_WIN + (size_t)N1 * D * 2 <= WS_WBG && WS_WOUT + 2 * MiB <= WS_W1 && WS_W1 + 64 * MiB <= WS_W2, "weight copies overlap");
constexpr size_t WS_H0Q = 216 * MiB;
constexpr size_t WS_TOPI = 232 * MiB, WS_TOPW = 233 * MiB, WS_RANK = 234 * MiB;
constexpr size_t WS_ROWW = 249 * MiB, WS_BETA = 250 * MiB, WS_LOGG = WS_BETA + 512 * 1024;
constexpr size_t GR = 252 * MiB;
constexpr size_t WS_H0 = GR, WS_QKVG = GR + 32 * MiB, WS_ZS = GR + 128 * MiB, WS_QS = GR + 160 * MiB;
constexpr size_t WS_SG = GR + 192 * MiB, WS_SS = GR + 224 * MiB, WS_OG = GR + 256 * MiB, WS_OSW = GR + 288 * MiB, WS_Y = WS_ZS, WS_PRE1 = WS_QKVG;
constexpr size_t WS_IMG_BASE = GR + 320 * MiB;
constexpr size_t WS_KSF = GR + 464 * MiB, WS_VSF = GR + 496 * MiB, WS_SC = GR + 528 * MiB, WS_HALO = GR + 544 * MiB;
constexpr size_t WS_H1 = GR + 546 * MiB;
constexpr size_t WS_H1Q = GR + 674 * MiB;
constexpr size_t WS_RTOK = GR + 738 * MiB, WS_RWW = GR + 746 * MiB;
constexpr size_t WS_END = GR + 754 * MiB;
constexpr size_t WS_XS = GR, WS_HID = GR, WS_YS = GR + 264 * MiB;
static_assert(WS_HID + (size_t)MAXROWS * DFF <= WS_YS && WS_YS + (size_t)MAXROWS * D <= WS_H1 && WS_HALO + 2 * MiB <= WS_H1, "moe row buffers overlay only dead buffers");
static_assert((size_t)TOKP * TOPK * 4 <= MiB && (size_t)NEXP * TOKP * 4 <= 8 * MiB && (size_t)TOKP * D * 2 <= 128 * MiB, "routing tables");
constexpr int CW_TMO = 0, CW_BAR = 4096, CW_CNT = 8192;
constexpr int RING_BYTES = 131072, MISC_OFF = 143360, LDS_BYTES = 147456;
constexpr int MI_OFF = 16, MI_CNT = 64, MI_LCNT = 96, MI_LBASE = 128, MI_TE = 160, MI_TE_CAP = (LDS_BYTES - MISC_OFF) / 4 - MI_TE;
static_assert((size_t)NMETA * CIN * 4 <= 512 * 1024 && MAXTILES * 8 <= 2 * 17 * 256 && MI_TE_CAP * 4 >= MAXTILES && TOKP <= 65536, "proj_meta fits below the router weight copy; at most 2 x 17 MoE up-projection units per workgroup; byte tile table fits the LDS MISC words; token rows fit 16 bits");

#define GAS __attribute__((address_space(1)))
#define LAS __attribute__((address_space(3)))
typedef unsigned short bf16_t;
typedef float f32x4 __attribute__((ext_vector_type(4)));
typedef float f32x2 __attribute__((ext_vector_type(2)));
typedef unsigned u32x4 __attribute__((ext_vector_type(4)));
typedef unsigned u32x2 __attribute__((ext_vector_type(2)));
#define LDS_WAIT() asm volatile("s_waitcnt lgkmcnt(0)" ::: "memory")
#define VM_WAIT() asm volatile("s_waitcnt vmcnt(0)" ::: "memory")
__device__ __forceinline__ unsigned f2bf(float f) { unsigned u = __builtin_bit_cast(unsigned, f); return (u + 0x7fffu + ((u >> 16) & 1u)) >> 16; }
__device__ __forceinline__ unsigned pk2(float lo, float hi) { return f2bf(lo) | (f2bf(hi) << 16); }
__device__ __forceinline__ float bflo(unsigned w) { return __builtin_bit_cast(float, w << 16); }
__device__ __forceinline__ float bfhi(unsigned w) { return __builtin_bit_cast(float, w & 0xffff0000u); }
__device__ __forceinline__ float bf1(bf16_t h) { return __builtin_bit_cast(float, (unsigned)h << 16); }
__device__ __forceinline__ float fexp(float x) { return __builtin_amdgcn_exp2f(x * 1.4426950408889634f); }
__device__ __forceinline__ float frcp(float x) { return __builtin_amdgcn_rcpf(x); }
__device__ __forceinline__ float frsq(float x) { return __builtin_amdgcn_rsqf(x); }
__device__ __forceinline__ float sigmoidf_(float x) { return frcp(1.0f + fexp(-x)); }
__device__ __forceinline__ float siluf_(float x) { return x * frcp(1.0f + fexp(-x)); }
__device__ __forceinline__ float softplusf_(float x) { const float e = fexp(-fabsf(x)); const float l = e < 1e-3f ? e * (1.0f - 0.5f * e) : __builtin_amdgcn_logf(1.0f + e) * 0.6931471805599453f; return fmaxf(x, 0.f) + l; }
__device__ __forceinline__ float wave_sum(float v) { v += sx<1>(v); v += sx<2>(v); v += sx<4>(v); v += sx<8>(v); v += sx<16>(v); v += sx<32>(v); return v; }

#define XB_TMO      128
#define XB_XCNT(j)  (256  + 64 * (j))
#define XB_XSUB(j)  (1280 + 64 * (j))
#define XB_XGEN(j)  (2304 + 64 * (j))
#define XB_TOP      3328
#define XB_TOPGEN   3392
#define XCD_BAR_WORDS 3456
#define XB_SPIN_CAP (1u << 18)
__device__ __forceinline__ unsigned xb_ld(unsigned* p)              { return __hip_atomic_load(p, __ATOMIC_RELAXED, __HIP_MEMORY_SCOPE_AGENT); }
__device__ __forceinline__ unsigned xb_add(unsigned* p, unsigned v) { return __hip_atomic_fetch_add(p, v, __ATOMIC_RELAXED, __HIP_MEMORY_SCOPE_AGENT); }
__device__ __forceinline__ unsigned xb_xcc_id() { return (unsigned)__builtin_amdgcn_s_getreg((3 << 11) | 20) & 0xFu; }
#define XB_SPIN(cond, bar) do { unsigned _sp = 0; while (cond) { __builtin_amdgcn_s_sleep(1); \
    if ((++_sp & 255u) == 0u) { if (xb_ld(&(bar)[XB_TMO])) break; if (_sp > XB_SPIN_CAP) { atomicAdd(&(bar)[XB_TMO], 1u); break; } } } } while (0)
struct XcdBarrier { unsigned* bar; unsigned x; volatile LAS unsigned* st; };
__device__ __forceinline__ XcdBarrier xcd_barrier_post(unsigned* bar, volatile LAS unsigned* st, bool leader) {
    XcdBarrier b; b.bar = bar; b.x = xb_xcc_id(); b.st = st;
    if (leader) (void)xb_add(&bar[XB_XCNT(b.x)], 1u);
    return b;
}
__device__ __forceinline__ void xcd_barrier_complete(unsigned* bar, unsigned x, unsigned& nloc, unsigned& nx) {
    const unsigned G = gridDim.x * gridDim.y * gridDim.z;
    unsigned sum, cnt, mine, sp = 0u;
    for (;;) {
        sum = 0u; cnt = 0u; mine = 0u;
#pragma unroll
        for (unsigned j = 0; j < 16; ++j) { const unsigned c = xb_ld(&bar[XB_XCNT(j)]); sum += c; cnt += (c > 0u) ? 1u : 0u; mine = (j == x) ? c : mine; }
        if (sum == G) break;
        __builtin_amdgcn_s_sleep(1);
        if ((++sp & 255u) == 0u) { if (xb_ld(&bar[XB_TMO])) break; if (sp > XB_SPIN_CAP) { atomicAdd(&bar[XB_TMO], 1u); break; } }
    }
    nloc = mine > 0u ? mine : 1u; nx = cnt > 0u ? cnt : 1u;
}
__device__ __forceinline__ void xcd_barrier(const XcdBarrier& b, bool leader) {
    asm volatile("s_waitcnt vmcnt(0)" ::: "memory");
    __syncthreads();
    if (leader) {
        unsigned* bar = b.bar;
        __builtin_amdgcn_s_waitcnt(0);
        unsigned nloc = b.st[0], nx = b.st[1];
        if (nloc == 0u) { xcd_barrier_complete(bar, b.x, nloc, nx); b.st[0] = nloc; b.st[1] = nx; }
        const unsigned old = xb_add(&bar[XB_XSUB(b.x)], 1u);
        const unsigned gen = old / nloc;
        if (old + 1u == (gen + 1u) * nloc) {
            __builtin_amdgcn_fence(__ATOMIC_RELEASE, "agent");
            asm volatile("s_waitcnt vmcnt(0)" ::: "memory");
            const unsigned og = xb_add(&bar[XB_TOP], 1u);
            const unsigned tg = og / nx;
            if (og + 1u == (tg + 1u) * nx) xb_add(&bar[XB_TOPGEN], 1u);
            else XB_SPIN(xb_ld(&bar[XB_TOPGEN]) == tg, bar);
            __builtin_amdgcn_fence(__ATOMIC_ACQUIRE, "agent");
            xb_add(&bar[XB_XGEN(b.x)], 1u);
            asm volatile("s_waitcnt vmcnt(0)" ::: "memory");
        } else {
            XB_SPIN(xb_ld(&bar[XB_XGEN(b.x)]) == gen, bar);
            __builtin_amdgcn_fence(__ATOMIC_ACQUIRE, "agent");
            asm volatile("s_waitcnt vmcnt(0)" ::: "memory");
        }
    }
    __syncthreads();
}

struct P { const float* in[23]; float* out; unsigned char* ws; int ph_lo, ph_hi; };
enum { I_X = 0, I_META, I_ELG, I_ELB, I_WIN, I_CONVW, I_ALOG, I_DTB, I_GNW, I_SINK, I_WBG, I_WBS, I_WOUT, I_L1G, I_L1B, I_WR, I_BR, I_W1, I_B1, I_W2, I_B2, I_L2G, I_L2B };
#ifndef AMP_MASK
#define AMP_MASK 0
#endif
#ifndef AMP_F
#define AMP_F 4
#endif
#define AMP_BEGIN(j) unsigned long long amp_t0 = 0; if ((AMP_MASK >> (j)) & 1) amp_t0 = __builtin_amdgcn_s_memrealtime();
#define AMP_END(j) if ((AMP_MASK >> (j)) & 1) { const unsigned long long amp_t1 = __builtin_amdgcn_s_memrealtime(); const unsigned long long amp_d = (amp_t1 - amp_t0) * AMP_F; while (__builtin_amdgcn_s_memrealtime() - amp_t1 < amp_d) __builtin_amdgcn_s_sleep(16); }

__device__ __forceinline__ void std_tile(int L, int nwg, int nM, int nN, int& pm, int& pn) {
    int wgid = L; { const int q = nwg / pg8::NXCD, r = nwg % pg8::NXCD, xcd = wgid % pg8::NXCD, off = wgid / pg8::NXCD; wgid = (xcd < r ? xcd * (q + 1) : r * (q + 1) + (xcd - r) * q) + off; }
    const int nig = pg8::WGM * nN, gid = wgid / nig, fm = gid * pg8::WGM, gsz = (nM - fm) < pg8::WGM ? (nM - fm) : pg8::WGM;
    pm = fm + ((wgid % nig) % gsz); pn = (wgid % nig) / gsz;
}
__device__ __forceinline__ int xcd_chunk(int L, int nwg) {
    const int q = nwg / pg8::NXCD, r = nwg % pg8::NXCD, xcd = L % pg8::NXCD, off = L / pg8::NXCD; return (xcd < r ? xcd * (q + 1) : r * (q + 1) + (xcd - r) * q) + off;
}
struct SchedStd {
    int nM, nN, nwg, G, c; const char* A; const char* B; size_t tstep;
    __device__ __forceinline__ void init(int M, int N, int KB, int G_, int c_, const void* A_, const void* B_) { nM = M / 256; nN = N / 256; nwg = nM * nN; G = G_; c = c_; A = (const char*)A_; B = (const char*)B_; tstep = (size_t)256 * KB; }
    __device__ __forceinline__ bool next(int i, pg8::Unit& u) const {
        const int L = i * G + c; if (L >= nwg) return false;
        int pm, pn; std_tile(L, nwg, nM, nN, pm, pn);
        u.pm = pm; u.pn = pn; u.e = 0; u.kind = 0; u.A = A + (size_t)pm * tstep; u.B = B + (size_t)pn * tstep; return true;
    }
    __device__ __forceinline__ void a_ready(const pg8::Unit&) const {}
    __device__ __forceinline__ void done(const pg8::Unit&) const {}
    __device__ __forceinline__ unsigned rowoff(int, int) const { return 0u; }
};
struct SchedPair {
    int nM, nN, nwg, G, c; const char *A0, *B0, *A1, *B1; size_t tstep;
    __device__ __forceinline__ void init(int M, int N, int KB, int G_, int c_, const void* A0_, const void* B0_, const void* A1_, const void* B1_) { nM = M / 256; nN = N / 256; nwg = nM * nN; G = G_; c = c_;
        A0 = (const char*)A0_; B0 = (const char*)B0_; A1 = (const char*)A1_; B1 = (const char*)B1_; tstep = (size_t)256 * KB; }
    __device__ __forceinline__ bool next(int i, pg8::Unit& u) const {
        const int L = (i >> 1) * G + c, kind = i & 1; if (L >= nwg) return false;
        int pm, pn; std_tile(L, nwg, nM, nN, pm, pn);
        u.pm = pm; u.pn = pn; u.e = 0; u.kind = kind; u.A = (kind ? A1 : A0) + (size_t)pm * tstep; u.B = (kind ? B1 : B0) + (size_t)pn * tstep; return true;
    }
    __device__ __forceinline__ void a_ready(const pg8::Unit&) const {}
    __device__ __forceinline__ void done(const pg8::Unit&) const {}
    __device__ __forceinline__ unsigned rowoff(int, int) const { return 0u; }
};
struct SchedMoe {
    int nN, nwg, G, c, i0, ni; const char* A; const char* W; size_t tstep, wexp; const volatile LAS unsigned char* te;
    __device__ __forceinline__ void init(int ntiles, int N, int KB, int G_, int c_, const void* A_, const void* W_, const volatile LAS unsigned* te_) { nN = N / 256; nwg = ntiles * nN; G = G_; c = c_; i0 = 0; ni = 1 << 20;
        A = (const char*)A_; W = (const char*)W_; tstep = (size_t)256 * KB; wexp = (size_t)N * KB; te = (const volatile LAS unsigned char*)te_; }
    __device__ __forceinline__ bool next(int i, pg8::Unit& u) const {
        const int L = (i + i0) * G + c; if (i >= ni || L >= nwg) return false;
        const int w = xcd_chunk(L, nwg), rt = w / nN, pn = w - rt * nN; const int e = __builtin_amdgcn_readfirstlane((int)te[rt]);
        u.pm = rt; u.pn = pn; u.e = e; u.kind = 0; u.A = A + (size_t)rt * tstep; u.B = W + (size_t)e * wexp + (size_t)pn * tstep; return true;
    }
    __device__ __forceinline__ void a_ready(const pg8::Unit&) const {}
    __device__ __forceinline__ void done(const pg8::Unit&) const {}
    __device__ __forceinline__ unsigned rowoff(int, int) const { return 0u; }
};

struct SchedMoeG : SchedMoe {
    const volatile LAS unsigned short* tokt;
    __device__ __forceinline__ bool next(int i, pg8::Unit& u) const { const bool ok = SchedMoe::next(i, u); if (ok) u.A = A; return ok; }
    __device__ __forceinline__ unsigned rowoff(int i, int Rg) const { return (unsigned)tokt[i * 256 + Rg] * (unsigned)D; }
};
using pg8::Unit;
typedef pg8::f32x4 (AccT)[2][2][4][2];
__device__ __forceinline__ u32x4 pack8(f32x4 v0, f32x4 v1) { u32x4 w; w.x = pg8::cvt_pk_bf16(v0[0], v0[1]); w.y = pg8::cvt_pk_bf16(v0[2], v0[3]); w.z = pg8::cvt_pk_bf16(v1[0], v1[1]); w.w = pg8::cvt_pk_bf16(v1[2], v1[3]); return w; }
__device__ __forceinline__ void unpack8(u32x4 w, f32x4& v0, f32x4& v1) { v0 = (f32x4){bflo(w.x), bfhi(w.x), bflo(w.y), bfhi(w.y)}; v1 = (f32x4){bflo(w.z), bfhi(w.z), bflo(w.w), bfhi(w.w)}; }
__device__ __forceinline__ unsigned pack4_fp8(float a, float b, float c2, float d) { int w = __builtin_amdgcn_cvt_pk_fp8_f32(a, b, 0, false); w = __builtin_amdgcn_cvt_pk_fp8_f32(c2, d, w, true); return (unsigned)w; }
constexpr float W8_SCALE = 64.0f, W8_INV = 1.0f / 64.0f, YS_SCALE = 64.0f, YS_INV = 1.0f / 64.0f;
struct EpiG1 {
    static constexpr bool PERM = true, AFTER_DRAIN = false;
    bf16_t *qkvg, *zs, *qs, *ks, *vs, *sg, *ss; int g;
    float asc;
    float *beta, *logg; const float *alog, *dtb;
    __device__ __forceinline__ void operator()(const AccT& acc, const Unit& u, int wr, int wc, int fr, int fq) const {
        if (u.pn == 30) {
            if (wc == 0 && fq < 2) {
                float ea[8], db[8];
#pragma unroll
                for (int h = 0; h < 8; ++h) { ea[h] = alog[h]; db[h] = dtb[h]; }
#pragma unroll
                for (int h = 0; h < 8; ++h) ea[h] = -fexp(ea[h]);
#pragma unroll
                for (int ai = 0; ai < 2; ++ai)
#pragma unroll
                    for (int m = 0; m < 4; ++m) { const size_t r = (size_t)(u.pm * 256 + ai * 128 + wr * 64 + m * 16 + fr);
#pragma unroll
                        for (int n = 0; n < 2; ++n) { f32x4 o;
#pragma unroll
                            for (int i = 0; i < 4; ++i) { const int h = 4 * n + i; const float x = acc[ai][0][m][n][i] * asc; o[i] = fq == 0 ? sigmoidf_(x) : ea[h] * softplusf_(x + db[h]); }
                            *(f32x4*)((fq == 0 ? beta : logg) + r * 8 + 4 * n) = o; } } }
            return; }
        const int pn = u.pn; bf16_t* base; int ldc, colt, act = 0; float sc = 1.f; const bool kv = (pn == 20 || pn == 21);
        if (pn < 12) { base = qkvg; ldc = 3072; colt = pn * 256; }
        else if (pn < 16) { base = zs; ldc = 1024; colt = (pn - 12) * 256; act = 1; }
        else if (pn < 20) { base = qs; ldc = 1024; colt = (pn - 16) * 256; sc = 0.125f * 1.4426950408889634f; }
        else if (pn == 20) { base = ks; ldc = 256; colt = 0; }
        else if (pn == 21) { base = vs; ldc = 256; colt = 0; }
        else if (pn < 26) { base = sg; ldc = 1024; colt = (pn - 22) * 256; act = 2; }
        else { base = ss; ldc = 1024; colt = (pn - 26) * 256; act = 2; }
        const int row0 = u.pm * 256 + wr * 64 + fr, col0 = colt + wc * 32 + 8 * fq; const float asc_sc = asc * sc, nl2e_asc = -1.4426950408889634f * asc;
#pragma unroll
        for (int ai = 0; ai < 2; ++ai)
#pragma unroll
            for (int m = 0; m < 4; ++m) { const int r = row0 + ai * 128 + m * 16, rr = kv ? ((r >> 9) * SEQ + g * TSL + (r & (TSL - 1))) : r; bf16_t* rowp = base + (size_t)rr * ldc + col0;
#pragma unroll
                for (int bj = 0; bj < 2; ++bj) { f32x4 v0, v1;
                    if (act == 0) { v0 = acc[ai][bj][m][0] * asc_sc; v1 = acc[ai][bj][m][1] * asc_sc; }
                    else {
#pragma unroll
                        for (int n = 0; n < 2; ++n)
#pragma unroll
                            for (int hh = 0; hh < 2; ++hh) { const f32x2 a = {acc[ai][bj][m][n][2 * hh], acc[ai][bj][m][n][2 * hh + 1]};
                                f32x2 t = a * nl2e_asc; t.x = __builtin_amdgcn_exp2f(t.x); t.y = __builtin_amdgcn_exp2f(t.y); t = t + 1.0f; t.x = __builtin_amdgcn_rcpf(t.x); t.y = __builtin_amdgcn_rcpf(t.y);
                                if (act == 1) t = t * (a * asc);
                                if (n == 0) { v0[2 * hh] = t.x; v0[2 * hh + 1] = t.y; } else { v1[2 * hh] = t.x; v1[2 * hh + 1] = t.y; } } }
                    *(u32x4*)(rowp + bj * 128) = pack8(v0, v1); } }
    }
};
struct EpiBr {
    static constexpr bool PERM = true, AFTER_DRAIN = false;
    const bf16_t *sg, *ss; bf16_t* y;
    template <bool K1>
    __device__ __forceinline__ void body(const AccT& acc, const bf16_t* __restrict__ gate, const bf16_t* yin, bf16_t* yout, const int row0, const int col0) const {
#pragma unroll
        for (int ai = 0; ai < 2; ++ai) { u32x4 gv[4][2], yv[4][2];
#pragma unroll
            for (int m = 0; m < 4; ++m) { const size_t off = (size_t)(row0 + ai * 128 + m * 16) * D + col0;
#pragma unroll
                for (int bj = 0; bj < 2; ++bj) { gv[m][bj] = *(const u32x4*)(gate + off + bj * 128); if constexpr (K1) yv[m][bj] = *(const u32x4*)(yin + off + bj * 128); } }
#pragma unroll
            for (int m = 0; m < 4; ++m) { const size_t off = (size_t)(row0 + ai * 128 + m * 16) * D + col0;
#pragma unroll
                for (int bj = 0; bj < 2; ++bj) { f32x4 g0, g1; unpack8(gv[m][bj], g0, g1);
                    f32x4 v0 = acc[ai][bj][m][0] * g0, v1 = acc[ai][bj][m][1] * g1;
                    if constexpr (K1) { f32x4 y0, y1; unpack8(yv[m][bj], y0, y1); v0 = v0 + y0; v1 = v1 + y1; }
                    *(u32x4*)(yout + off + bj * 128) = pack8(v0, v1); } } }
    }
    __device__ __forceinline__ void operator()(const AccT& acc, const Unit& u, int wr, int wc, int fr, int fq) const {
        const int row0 = u.pm * 256 + wr * 64 + fr, col0 = u.pn * 256 + wc * 32 + 8 * fq;
        if (u.kind) body<true>(acc, ss, y, y, row0, col0); else body<false>(acc, sg, y, y, row0, col0);
    }
};
struct EpiOut {
    static constexpr bool PERM = true, AFTER_DRAIN = false;
    const bf16_t* h0; bf16_t* pre1;
    __device__ __forceinline__ void operator()(const AccT& acc, const Unit& u, int wr, int wc, int fr, int fq) const {
        const int row0 = u.pm * 256 + wr * 64 + fr, col0 = u.pn * 256 + wc * 32 + 8 * fq;
#pragma unroll
        for (int ai = 0; ai < 2; ++ai) { u32x4 hv[4][2];
#pragma unroll
            for (int m = 0; m < 4; ++m) { const size_t off = (size_t)(row0 + ai * 128 + m * 16) * D + col0;
#pragma unroll
                for (int bj = 0; bj < 2; ++bj) hv[m][bj] = *(const u32x4*)(h0 + off + bj * 128); }
#pragma unroll
            for (int m = 0; m < 4; ++m) { const size_t off = (size_t)(row0 + ai * 128 + m * 16) * D + col0;
#pragma unroll
                for (int bj = 0; bj < 2; ++bj) { f32x4 h0a, h0b; unpack8(hv[m][bj], h0a, h0b);
                    *(u32x4*)(pre1 + off + bj * 128) = pack8(h0a * DN_ALPHA + acc[ai][bj][m][0], h0b * DN_ALPHA + acc[ai][bj][m][1]); } } }
    }
};
struct EpiMoe1 {
    static constexpr bool PERM = true, AFTER_DRAIN = false;
    const float* b1; unsigned char* hid;
    __device__ __forceinline__ void operator()(const AccT& acc, const Unit& u, int wr, int wc, int fr, int fq) const {
        const int row0 = u.pm * 256 + wr * 64 + fr, j0 = u.pn * 128 + wc * 32 + 8 * fq; const float* bb = b1 + (size_t)u.e * 2048 + j0;
        f32x2 bg[4], bu[4];
#pragma unroll
        for (int k = 0; k < 4; ++k) { bg[k] = *(const f32x2*)(bb + 2 * k); bu[k] = *(const f32x2*)(bb + 1024 + 2 * k) + 1.0f; }
#pragma unroll
        for (int ai = 0; ai < 2; ++ai)
#pragma unroll
            for (int m = 0; m < 4; ++m) { f32x2 o[4];
#pragma unroll
                for (int k = 0; k < 4; ++k) { const int n = k >> 1, j = (k & 1) * 2;
                    const f32x2 ga = {acc[ai][0][m][n][j], acc[ai][0][m][n][j + 1]}, ua = {acc[ai][1][m][n][j], acc[ai][1][m][n][j + 1]};
                    f32x2 g = ga * W8_INV + bg[k], up = ua * W8_INV + bu[k];
                    g.x = fminf(g.x, 7.0f); g.y = fminf(g.y, 7.0f);
                    up.x = __builtin_amdgcn_fmed3f(up.x, -6.0f, 8.0f); up.y = __builtin_amdgcn_fmed3f(up.y, -6.0f, 8.0f);
                    f32x2 t = g * (-1.702f * 1.4426950408889634f);
                    t.x = __builtin_amdgcn_exp2f(t.x); t.y = __builtin_amdgcn_exp2f(t.y);
                    t = t + 1.0f;
                    t.x = __builtin_amdgcn_rcpf(t.x); t.y = __builtin_amdgcn_rcpf(t.y);
                    o[k] = (g * t) * up; }
                u32x2 w8; w8.x = pack4_fp8(o[0].x, o[0].y, o[1].x, o[1].y); w8.y = pack4_fp8(o[2].x, o[2].y, o[3].x, o[3].y);
                *(u32x2*)(hid + (size_t)(row0 + ai * 128 + m * 16) * DFF + j0) = w8; }
    }
};
struct EpiMoe2 {
    static constexpr bool PERM = true, AFTER_DRAIN = false;
    const float* b2; const float* rww; unsigned char* ys; const volatile LAS unsigned* misc;
    __device__ __forceinline__ void operator()(const AccT& acc, const Unit& u, int wr, int wc, int fr, int fq) const {
        const int row0 = u.pm * 256 + wr * 64 + fr, col0 = u.pn * 256 + wc * 32 + 8 * fq; const float* bb = b2 + (size_t)u.e * D + col0;
        f32x4 bv[2][2];
#pragma unroll
        for (int bj = 0; bj < 2; ++bj)
#pragma unroll
            for (int n = 0; n < 2; ++n) bv[bj][n] = *(const f32x4*)(bb + bj * 128 + 4 * n);
        const unsigned eoff = misc[MI_OFF + u.e], ecnt = misc[MI_CNT + u.e]; const float* rwe = rww + (size_t)u.e * TOKP;
        float wv[2][4];
#pragma unroll
        for (int ai = 0; ai < 2; ++ai)
#pragma unroll
            for (int m = 0; m < 4; ++m) { const unsigned pos = (unsigned)(row0 + ai * 128 + m * 16) - eoff; wv[ai][m] = rwe[pos < ecnt ? pos : 0u]; }
#pragma unroll
        for (int ai = 0; ai < 2; ++ai)
#pragma unroll
            for (int m = 0; m < 4; ++m) { const int row = row0 + ai * 128 + m * 16; const unsigned pos = (unsigned)row - eoff;
                const float w64 = pos < ecnt ? wv[ai][m] * YS_SCALE : 0.f;
#pragma unroll
                for (int bj = 0; bj < 2; ++bj) { const f32x4 v0 = (acc[ai][bj][m][0] * W8_INV + bv[bj][0]) * w64, v1 = (acc[ai][bj][m][1] * W8_INV + bv[bj][1]) * w64;
                    u32x2 o8; o8.x = pack4_fp8(v0[0], v0[1], v0[2], v0[3]); o8.y = pack4_fp8(v1[0], v1[1], v1[2], v1[3]); *(u32x2*)(ys + (size_t)row * D + col0 + bj * 128) = o8; } }
    }
};

struct Ctx { LAS unsigned char* lds; volatile LAS unsigned* MISC; int tid, lane, wave, G, gw, NGW; unsigned char* ws; };

__device__ __forceinline__ void transpose_item(const float* W, int ldw, int k0, int srccol, bf16_t* WT, int ldt, int dstrow, LAS float* scr, int lane) {
    float wv_[32];
#pragma unroll
    for (int i = 0; i < 32; ++i) { const int kk = 2 * i + (lane >> 5); wv_[i] = W[(size_t)(k0 + kk) * ldw + srccol + (lane & 31)]; }
#pragma unroll
    for (int i = 0; i < 32; ++i) { const int kk = 2 * i + (lane >> 5); scr[kk * 33 + (lane & 31)] = wv_[i]; }
    LDS_WAIT(); asm volatile("" ::: "memory");
    const int c = lane & 7;
#pragma unroll
    for (int j = 0; j < 4; ++j) { const int n = (lane >> 3) + 8 * j; const LAS float* s = scr + (8 * c) * 33 + n;
        u32x4 o; o.x = pk2(s[0 * 33], s[1 * 33]); o.y = pk2(s[2 * 33], s[3 * 33]); o.z = pk2(s[4 * 33], s[5 * 33]); o.w = pk2(s[6 * 33], s[7 * 33]);
        *(u32x4*)(WT + (size_t)(dstrow + n) * ldt + k0 + 8 * c) = o; }
    LDS_WAIT(); asm volatile("" ::: "memory");
}
__device__ __forceinline__ void transpose_item8(const float* W, int ldw, int k0, int srccol, unsigned char* WT, int ldt, int dstrow, LAS float* scr, int lane) {
    float wv_[32];
#pragma unroll
    for (int i = 0; i < 32; ++i) { const int kk = 2 * i + (lane >> 5); wv_[i] = W[(size_t)(k0 + kk) * ldw + srccol + (lane & 31)]; }
#pragma unroll
    for (int i = 0; i < 32; ++i) { const int kk = 2 * i + (lane >> 5); scr[kk * 33 + (lane & 31)] = wv_[i]; }
    LDS_WAIT(); asm volatile("" ::: "memory");
    const int c = lane & 7;
#pragma unroll
    for (int j = 0; j < 4; ++j) { const int n = (lane >> 3) + 8 * j; const LAS float* s = scr + (8 * c) * 33 + n;
        u32x2 o; o.x = pack4_fp8(s[0 * 33] * W8_SCALE, s[1 * 33] * W8_SCALE, s[2 * 33] * W8_SCALE, s[3 * 33] * W8_SCALE); o.y = pack4_fp8(s[4 * 33] * W8_SCALE, s[5 * 33] * W8_SCALE, s[6 * 33] * W8_SCALE, s[7 * 33] * W8_SCALE);
        *(u32x2*)(WT + (size_t)(dstrow + n) * ldt + k0 + 8 * c) = o; }
    LDS_WAIT(); asm volatile("" ::: "memory");
}
__device__ __forceinline__ void ln_row(const float* xrow, const float* gam, const float* bet, int lane, f32x4 (&y)[4]) {
    const f32x4* xr = (const f32x4*)xrow + lane; float s = 0.f;
#pragma unroll
    for (int j = 0; j < 4; ++j) { y[j] = xr[64 * j]; s += (y[j].x + y[j].y) + (y[j].z + y[j].w); }
    const float mean = wave_sum(s) * (1.f / D); float s2 = 0.f;
#pragma unroll
    for (int j = 0; j < 4; ++j) { y[j] = y[j] - mean; s2 += (y[j].x * y[j].x + y[j].y * y[j].y) + (y[j].z * y[j].z + y[j].w * y[j].w); }
    const float rstd = frsq(wave_sum(s2) * (1.f / D) + LN_EPS);
#pragma unroll
    for (int j = 0; j < 4; ++j) { const f32x4 gv = ((const f32x4*)gam)[lane + 64 * j], bv = ((const f32x4*)bet)[lane + 64 * j]; y[j] = y[j] * rstd * gv + bv; }
}
__device__ __forceinline__ void store_row_bf16(bf16_t* orow, int lane, const f32x4 (&y)[4]) {
    u32x2* o8 = (u32x2*)orow + lane;
#pragma unroll
    for (int j = 0; j < 4; ++j) { u32x2 w; w.x = pk2(y[j].x, y[j].y); w.y = pk2(y[j].z, y[j].w); o8[64 * j] = w; }
}
__device__ __forceinline__ void phase_prep(const P& p, const Ctx& c) {
    const float* w_in = p.in[I_WIN];
    if ((int)blockIdx.x * 32 < CIN) {
        LAS float* h0m = (LAS float*)c.lds; LAS float* red = (LAS float*)(c.lds + 65536);
#pragma unroll
        for (int rr = 0; rr < 2; ++rr) { const int m = 2 * c.wave + rr; f32x4 y[4]; ln_row(p.in[I_META] + (size_t)m * D, p.in[I_ELG], p.in[I_ELB], c.lane, y);
#pragma unroll
            for (int j = 0; j < 4; ++j) *(LAS f32x4*)(h0m + m * D + 4 * c.lane + 256 * j) = y[j]; }
        __syncthreads();
        const int cc = c.tid & 31, ks = c.tid >> 5, col = blockIdx.x * 32 + cc; float acc[16];
#pragma unroll
        for (int m = 0; m < 16; ++m) acc[m] = 0.f;
        if (col < CIN) {
#pragma unroll 1
            for (int k0 = ks * 64; k0 < ks * 64 + 64; k0 += 32) { float wv[32];
#pragma unroll
                for (int i = 0; i < 32; ++i) wv[i] = w_in[(size_t)(k0 + i) * CIN + col];
                __builtin_amdgcn_sched_barrier(0);
#pragma unroll
                for (int i = 0; i < 32; ++i) {
#pragma unroll
                    for (int m = 0; m < 16; ++m) acc[m] += h0m[m * D + k0 + i] * wv[i];
                    if (i & 1) __builtin_amdgcn_sched_barrier(0); } } }
#pragma unroll
        for (int m = 0; m < 16; ++m) red[(ks * 16 + m) * 32 + cc] = acc[m];
        __syncthreads();
        { const int m = c.tid >> 5; float s = 0.f;
#pragma unroll
          for (int k2 = 0; k2 < 16; ++k2) s += red[(k2 * 16 + m) * 32 + cc];
          if (col < CIN) ((float*)(c.ws + WS_PM))[(size_t)m * CIN + col] = s; }
        __syncthreads();
    }
    { const int gid = (int)blockIdx.x * NTHR + c.tid; if (gid < NEXP * D) { const int k = gid >> 5, e = gid & 31; ((bf16_t*)(c.ws + WS_WRT))[e * D + k] = (bf16_t)f2bf(p.in[I_WR][gid]); } }
    for (int i = c.gw * 64 + c.lane; i < 224 * 128; i += c.NGW * 64) { const u32x4 z = {0u, 0u, 0u, 0u}; ((u32x4*)(c.ws + WS_WIN + (size_t)7712 * D * (G1_FP8 ? 1 : 2)))[i] = z; }
    LAS float* scr = (LAS float*)(c.lds + c.wave * 17408);
    constexpr int I_IN = 241 * 16, I_SQ = 512, I_1 = 32 * 1024, I_2 = 32 * 512, NITEMS = I_IN + 3 * I_SQ + I_1 + I_2;
    bf16_t* WIN = (bf16_t*)(c.ws + WS_WIN);
    for (int it = c.gw; it < I_IN + 3 * I_SQ; it += c.NGW) {
        int r = it;
#if G1_FP8
        if (r < I_IN) { const int nb = r % 241, kb = r / 241, dr = 32 * nb; transpose_item8(w_in, CIN, 64 * kb, nb == 240 ? C_BG : (dr < 4096 ? dr : dr + 16), c.ws + WS_WIN, D, dr, scr, c.lane); continue; } r -= I_IN;
#else
        if (r < I_IN) { const int nb = r % 241, kb = r / 241, dr = 32 * nb; transpose_item(w_in, CIN, 64 * kb, nb == 240 ? C_BG : (dr < 4096 ? dr : dr + 16), WIN, D, dr, scr, c.lane); continue; } r -= I_IN;
#endif
        if (r < I_SQ) { const int nb = r % 32, kb = r / 32; transpose_item(p.in[I_WBG], D, 64 * kb, 32 * nb, (bf16_t*)(c.ws + WS_WBG), D, 32 * nb, scr, c.lane); continue; } r -= I_SQ;
        if (r < I_SQ) { const int nb = r % 32, kb = r / 32; transpose_item(p.in[I_WBS], D, 64 * kb, 32 * nb, (bf16_t*)(c.ws + WS_WBS), D, 32 * nb, scr, c.lane); continue; } r -= I_SQ;
        if (r < I_SQ) { const int nb = r % 32, kb = r / 32; transpose_item(p.in[I_WOUT], D, 64 * kb, 32 * nb, (bf16_t*)(c.ws + WS_WOUT), D, 32 * nb, scr, c.lane); continue; } r -= I_SQ;
        (void)r; }
    { const int kr = c.lane >> 3, n4 = (c.lane & 7) * 4; (void)NITEMS;
      auto decode = [&](int r, const float*& src, int& ldw, unsigned char*& dst) {
          if (r < I_1) { const int e = r / 1024, q = r % 1024, nb = q % 64, kb = q / 64, dr = 32 * nb; const int sc = ((dr >> 7) & 1) * 1024 + (dr >> 8) * 128 + (dr & 127);
              ldw = 2048; src = p.in[I_W1] + (size_t)e * D * 2048 + (size_t)(64 * kb) * 2048 + sc; dst = c.ws + WS_W1 + (size_t)e * 2048 * D + (size_t)dr * D + 64 * kb; }
          else { r -= I_1; const int e = r / 512, q = r % 512, nb = q % 32, kb = q / 32;
              ldw = D; src = p.in[I_W2] + (size_t)e * DFF * D + (size_t)(64 * kb) * D + 32 * nb; dst = c.ws + WS_W2 + (size_t)e * D * DFF + (size_t)(32 * nb) * DFF + 64 * kb; } };
      static_assert((I_1 + I_2) % 2 == 0, "item pairs");
      f32x4 va[8], vb[8]; const float* src; unsigned char *dsta, *dstb; int ldw;
      LAS float* scrb = scr + 64 * 33;
      int it = c.gw; const int NI = I_1 + I_2;
      auto loadp = [&](int i0) {
          decode(i0, src, ldw, dsta);
#pragma unroll
          for (int j = 0; j < 8; ++j) va[j] = *(const f32x4*)(src + (size_t)(8 * j + kr) * ldw + n4);
          if (i0 + c.NGW < NI) { decode(i0 + c.NGW, src, ldw, dstb);
#pragma unroll
              for (int j = 0; j < 8; ++j) vb[j] = *(const f32x4*)(src + (size_t)(8 * j + kr) * ldw + n4); } };
      if (it < NI) loadp(it);
#pragma unroll 1
      for (; it < NI; it += 2 * c.NGW) { const bool hasb = it + c.NGW < NI;
#pragma unroll
          for (int j = 0; j < 8; ++j) { LAS float* sp = scr + (8 * j + kr) * 33 + n4; sp[0] = va[j].x; sp[1] = va[j].y; sp[2] = va[j].z; sp[3] = va[j].w;
              LAS float* sq2 = scrb + (8 * j + kr) * 33 + n4; sq2[0] = vb[j].x; sq2[1] = vb[j].y; sq2[2] = vb[j].z; sq2[3] = vb[j].w; }
          unsigned char* da = dsta; unsigned char* db = dstb;
          if (it + 2 * c.NGW < NI) loadp(it + 2 * c.NGW);
          LDS_WAIT(); asm volatile("" ::: "memory");
          const int cc = c.lane & 7;
#pragma unroll
          for (int j = 0; j < 4; ++j) { const int n = (c.lane >> 3) + 8 * j; const LAS float* sq = scr + (8 * cc) * 33 + n;
              u32x2 o; o.x = pack4_fp8(sq[0 * 33] * W8_SCALE, sq[1 * 33] * W8_SCALE, sq[2 * 33] * W8_SCALE, sq[3 * 33] * W8_SCALE); o.y = pack4_fp8(sq[4 * 33] * W8_SCALE, sq[5 * 33] * W8_SCALE, sq[6 * 33] * W8_SCALE, sq[7 * 33] * W8_SCALE);
              *(u32x2*)(da + (size_t)n * D + 8 * cc) = o;
              if (hasb) { const LAS float* sr = scrb + (8 * cc) * 33 + n;
                  u32x2 o2; o2.x = pack4_fp8(sr[0 * 33] * W8_SCALE, sr[1 * 33] * W8_SCALE, sr[2 * 33] * W8_SCALE, sr[3 * 33] * W8_SCALE); o2.y = pack4_fp8(sr[4 * 33] * W8_SCALE, sr[5 * 33] * W8_SCALE, sr[6 * 33] * W8_SCALE, sr[7 * 33] * W8_SCALE);
                  *(u32x2*)(db + (size_t)n * D + 8 * cc) = o2; } }
          LDS_WAIT(); asm volatile("" ::: "memory");
      } }
}

__device__ __forceinline__ void meta_state(const P& p, const Ctx& c, int h, LAS unsigned char* lb) {
    LAS float* kf = (LAS float*)lb; LAS float* vf = kf + 16 * 128; LAS float* red = vf + 16 * 128; LAS float* bet = red + 2 * 4 * 128; LAS float* gg = bet + 16;
    const float* PM = (const float*)(c.ws + WS_PM); const float* cw = p.in[I_CONVW];
    { const int tl = c.tid >> 5, cg = c.tid & 31; float kk[4], vv[4]; float ss = 0.f;
#pragma unroll
      for (int j = 0; j < 4; ++j) { const int ch = h * 128 + 4 * cg + j; float ak = 0.f, av = 0.f;
#pragma unroll
          for (int i = 0; i < 4; ++i) { const int tt = tl - 3 + i; if (tt >= 0) { ak += cw[(size_t)(1024 + ch) * 4 + i] * PM[(size_t)tt * CIN + C_KG + ch]; av += cw[(size_t)(2048 + ch) * 4 + i] * PM[(size_t)tt * CIN + C_VG + ch]; } }
          kk[j] = siluf_(ak); vv[j] = siluf_(av); ss += kk[j] * kk[j]; }
      ss += sx<1>(ss); ss += sx<2>(ss); ss += sx<4>(ss); ss += sx<8>(ss); ss += sx<16>(ss);
      const float rn = frsq(ss + RMS_EPS);
#pragma unroll
      for (int j = 0; j < 4; ++j) { kf[tl * 128 + 4 * cg + j] = kk[j] * rn; vf[tl * 128 + 4 * cg + j] = vv[j]; }
      if (cg == 0) { bet[tl] = sigmoidf_(PM[(size_t)tl * CIN + C_BG + h]); gg[tl] = fexp(-fexp(p.in[I_ALOG][h]) * softplusf_(PM[(size_t)tl * CIN + C_AG + h] + p.in[I_DTB][h])); } }
    __syncthreads();
    float S[32];
#pragma unroll
    for (int k = 0; k < 32; ++k) S[k] = 0.f;
    const int v = c.tid & 127, rg = c.tid >> 7;
#pragma unroll 1
    for (int t = 0; t < 16; ++t) { float pk = 0.f;
#pragma unroll
        for (int k = 0; k < 32; ++k) pk += S[k] * kf[t * 128 + rg * 32 + k];
        red[((t & 1) * 4 + rg) * 128 + v] = pk;
        __syncthreads();
        const float sk = (red[((t & 1) * 4 + 0) * 128 + v] + red[((t & 1) * 4 + 1) * 128 + v]) + (red[((t & 1) * 4 + 2) * 128 + v] + red[((t & 1) * 4 + 3) * 128 + v]);
        const float g = gg[t], u = bet[t] * (vf[t * 128 + v] - g * sk);
#pragma unroll
        for (int k = 0; k < 32; ++k) S[k] = g * S[k] + kf[t * 128 + rg * 32 + k] * u; }
    float* S1 = (float*)(c.ws + WS_S1) + (size_t)h * 128 * 128;
#pragma unroll
    for (int k = 0; k < 32; ++k) S1[(rg * 32 + k) * 128 + v] = S[k];
    bf16_t* HALO = (bf16_t*)(c.ws + WS_HALO);
    for (int it = c.tid; it < BATCH * 3 * 3 * 16; it += NTHR) { const int cg2 = it & 15, which = (it >> 4) % 3, i = (it / 48) % 3, b = it / 144; const int ch0 = which * 1024 + h * 128 + 8 * cg2;
        const float* mp = PM + (size_t)(NMETA - 3 + i) * CIN + ch0; const f32x4 m0 = *(const f32x4*)mp, m1 = *(const f32x4*)(mp + 4);
        *(u32x4*)(HALO + ((size_t)(BATCH + b) * 3 + i) * 3072 + ch0) = pack8(m0, m1); }
    __syncthreads();
}


__device__ __forceinline__ float red16(float v) { v += sx<1>(v); v += sx<2>(v); v += sx<4>(v); v += sx<8>(v); return v; }
__device__ __forceinline__ void quad_load(const float* row, int sub, f32x4 (&y)[16]) { const f32x4* xr = (const f32x4*)row + sub;
#pragma unroll
    for (int j = 0; j < 16; ++j) y[j] = xr[16 * j]; }
__device__ __forceinline__ void quad_load_bf16(const bf16_t* row, int sub, f32x4 (&y)[16]) { const u32x2* xr = (const u32x2*)row + sub;
#pragma unroll
    for (int j = 0; j < 16; ++j) { const u32x2 w = xr[16 * j]; y[j] = (f32x4){bflo(w.x), bfhi(w.x), bflo(w.y), bfhi(w.y)}; } }
__device__ __forceinline__ void stage_gb(const Ctx& c, const float* g, const float* b, LAS float* dst) {
    if (c.tid < 256) *(LAS f32x4*)(dst + 4 * c.tid) = *(const f32x4*)(g + 4 * c.tid); else *(LAS f32x4*)(dst + 1024 + 4 * (c.tid - 256)) = *(const f32x4*)(b + 4 * (c.tid - 256));
}
__device__ __forceinline__ void quad_norm(f32x4 (&y)[16], const LAS float* gam, const LAS float* bet, int sub) {
    float s = 0.f;
#pragma unroll
    for (int j = 0; j < 16; ++j) s += (y[j].x + y[j].y) + (y[j].z + y[j].w);
    const float mean = red16(s) * (1.f / D); float s2 = 0.f;
#pragma unroll
    for (int j = 0; j < 16; ++j) { y[j] = y[j] - mean; s2 += (y[j].x * y[j].x + y[j].y * y[j].y) + (y[j].z * y[j].z + y[j].w * y[j].w); }
    const float rstd = frsq(red16(s2) * (1.f / D) + LN_EPS);
#pragma unroll
    for (int j = 0; j < 16; ++j) { const f32x4 gv = ((const LAS f32x4*)gam)[16 * j + sub], bv = ((const LAS f32x4*)bet)[16 * j + sub]; y[j] = y[j] * rstd * gv + bv;
        if ((j & 3) == 3) __builtin_amdgcn_sched_barrier(0); }
}
__device__ __forceinline__ void quad_store_bf16(bf16_t* orow, int sub, const f32x4 (&y)[16]) { u32x2* o8 = (u32x2*)orow + sub;
#pragma unroll
    for (int j = 0; j < 16; ++j) { u32x2 w; w.x = pg8::cvt_pk_bf16(y[j].x, y[j].y); w.y = pg8::cvt_pk_bf16(y[j].z, y[j].w); o8[16 * j] = w; } }

__device__ __forceinline__ void quad_store_fp8(unsigned char* orow, int sub, const f32x4 (&y)[16]) { unsigned* o4 = (unsigned*)orow + sub;
#pragma unroll
    for (int j = 0; j < 16; ++j) o4[16 * j] = pack4_fp8(y[j].x, y[j].y, y[j].z, y[j].w); }
constexpr int GB_LN2 = 0, GB_EMB = 8192, GB_LN1 = 98304;
constexpr int GB_EMB2 = 106496;
__device__ __forceinline__ void phase_ln0(const P& p, const Ctx& c, int g, int wid, int nw, int gboff) {
    bf16_t* H0 = (bf16_t*)(c.ws + WS_H0); const int sub = c.lane & 15, rs = c.lane >> 4; const LAS float* gL = (const LAS float*)(c.lds + gboff); const LAS float* bL = gL + 1024;
    for (int q0 = wid; q0 < TOK / 4; q0 += 2 * nw) { const int q1 = q0 + nw; const bool has1 = q1 < TOK / 4;
        const int r0 = 4 * q0 + rs, r1 = 4 * (has1 ? q1 : q0) + rs;
        f32x4 y0[16], y1[16];
        quad_load(p.in[I_X] + ((size_t)(r0 >> 9) * SEQ + g * TSL + (r0 & (TSL - 1))) * D, sub, y0);
        quad_load(p.in[I_X] + ((size_t)(r1 >> 9) * SEQ + g * TSL + (r1 & (TSL - 1))) * D, sub, y1);
        quad_norm(y0, gL, bL, sub); quad_store_bf16(H0 + (size_t)r0 * D, sub, y0); quad_store_fp8(c.ws + WS_H0Q + (size_t)r0 * D, sub, y0);
        if (has1) { quad_norm(y1, gL, bL, sub); quad_store_bf16(H0 + (size_t)r1 * D, sub, y1); quad_store_fp8(c.ws + WS_H0Q + (size_t)r1 * D, sub, y1); }
    }
}

__device__ __forceinline__ void ln1_norm(const P& p, const Ctx& c, int r, int sub, f32x4 (&y)[16]) {
    bf16_t* H1 = (bf16_t*)(c.ws + WS_H1);
    quad_norm(y, (const LAS float*)(c.lds + GB_LN1), (const LAS float*)(c.lds + GB_LN1) + 1024, sub);
    quad_store_bf16(H1 + (size_t)r * D, sub, y);
    int r2 = r, sub2 = sub; asm volatile("" : "+v"(r2), "+v"(sub2));
    unsigned* h8 = (unsigned*)(c.ws + WS_H1Q + (size_t)r2 * D) + sub2;
#pragma unroll
    for (int j = 0; j < 16; ++j) h8[16 * j] = pack4_fp8(y[j].x, y[j].y, y[j].z, y[j].w);
}
constexpr int RT_WS = 1032;
__device__ __forceinline__ void phase_ln1_router(const P& p, const Ctx& c, int g, int ln0_next) {
    LAS bf16_t* wrb = (LAS bf16_t*)c.lds;
    LAS float* lgs = (LAS float*)(c.lds + 32 * RT_WS * 2);
    { const u32x4* wrt = (const u32x4*)(c.ws + WS_WRT); u32x4 wv[8];
#pragma unroll
      for (int i = 0; i < 8; ++i) wv[i] = wrt[c.tid + NTHR * i];
#pragma unroll
      for (int i = 0; i < 8; ++i) { const int ch = c.tid + NTHR * i, e = ch >> 7, k8 = ch & 127; *(LAS u32x4*)(wrb + e * RT_WS + 8 * k8) = wv[i]; } }
    stage_gb(c, p.in[I_L1G], p.in[I_L1B], (LAS float*)(c.lds + GB_LN1));
    if (ln0_next >= 0) stage_gb(c, p.in[I_ELG], p.in[I_ELB], (LAS float*)(c.lds + GB_EMB2));
    if (c.tid < NEXP) c.MISC[MI_LCNT + c.tid] = 0u;
    __syncthreads();
    const bf16_t* PRE1 = (const bf16_t*)(c.ws + WS_PRE1); const int sub = c.lane & 15, rs = c.lane >> 4;
    const int rloc = 64 * blockIdx.x, rbase = (g % NP) * TOK + rloc;
    { const int r0 = rbase + 8 * c.wave + rs, r1 = r0 + 4, l0 = rloc + 8 * c.wave + rs, l1 = l0 + 4; f32x4 y0[16], y1[16]; u32x2 w0[16], w1[16];
      { const u32x2* x0 = (const u32x2*)(PRE1 + (size_t)l0 * D) + sub; const u32x2* x1 = (const u32x2*)(PRE1 + (size_t)l1 * D) + sub;
#pragma unroll
        for (int j = 0; j < 16; ++j) { w0[j] = x0[16 * j]; w1[j] = x1[16 * j]; } }
      __builtin_amdgcn_sched_barrier(0);
#pragma unroll
      for (int j = 0; j < 16; ++j) { y0[j] = (f32x4){bflo(w0[j].x), bfhi(w0[j].x), bflo(w0[j].y), bfhi(w0[j].y)}; y1[j] = (f32x4){bflo(w1[j].x), bfhi(w1[j].x), bflo(w1[j].y), bfhi(w1[j].y)}; }
      ln1_norm(p, c, r0, sub, y0); ln1_norm(p, c, r1, sub, y1); }
    asm volatile("s_waitcnt vmcnt(0)" ::: "memory");
    __syncthreads();
    int* TOPI = (int*)(c.ws + WS_TOPI); float* TOPW = (float*)(c.ws + WS_TOPW); int* RANK = (int*)(c.ws + WS_RANK);
    if (c.wave < 4) {
        const int i15 = c.lane & 15, kq = c.lane >> 4, R0 = rbase + 16 * c.wave; const bf16_t* H1 = (const bf16_t*)(c.ws + WS_H1);
        const bf16_t* hrow = H1 + (size_t)(R0 + i15) * D + 8 * kq;
        f32x4 a0 = *(const f32x4*)(p.in[I_BR] + 4 * kq), a1 = *(const f32x4*)(p.in[I_BR] + 16 + 4 * kq);
        pg8::bf16x8 bf[32];
#pragma unroll
        for (int j = 0; j < 32; ++j) bf[j] = *(const pg8::bf16x8*)(hrow + 32 * j);
        __builtin_amdgcn_sched_barrier(0);
#pragma unroll
        for (int j = 0; j < 32; ++j) { const int ko = 32 * j + 8 * kq;
            const pg8::bf16x8 w0 = *(const LAS pg8::bf16x8*)(wrb + i15 * RT_WS + ko), w1 = *(const LAS pg8::bf16x8*)(wrb + (16 + i15) * RT_WS + ko);
            a0 = __builtin_amdgcn_mfma_f32_16x16x32_bf16(w0, bf[j], a0, 0, 0, 0); a1 = __builtin_amdgcn_mfma_f32_16x16x32_bf16(w1, bf[j], a1, 0, 0, 0); }
        LAS float* lg = lgs + c.wave * 16 * 33;
#pragma unroll
        for (int r = 0; r < 4; ++r) { lg[i15 * 33 + 4 * kq + r] = a0[r]; lg[i15 * 33 + 16 + 4 * kq + r] = a1[r]; }
        asm volatile("s_waitcnt lgkmcnt(0)" ::: "memory");
        if (c.lane < 16) { const int r = R0 + c.lane; float v[32];
#pragma unroll
            for (int e = 0; e < 32; ++e) v[e] = lg[c.lane * 33 + e];
            int sel[4]; float val[4];
#pragma unroll
            for (int k = 0; k < 4; ++k) { float best = -3.0e38f; int bi = 0;
#pragma unroll
                for (int e = 0; e < 32; ++e) if (v[e] > best) { best = v[e]; bi = e; }
                sel[k] = bi; val[k] = best;
#pragma unroll
                for (int e = 0; e < 32; ++e) v[e] = (e == bi) ? -3.0e38f : v[e]; }
            const float e1 = fexp(val[1] - val[0]), e2 = fexp(val[2] - val[0]), e3 = fexp(val[3] - val[0]); const float inv = frcp(1.0f + e1 + e2 + e3);
            const float ww[4] = {inv, e1 * inv, e2 * inv, e3 * inv};
#pragma unroll
            for (int k = 0; k < 4; ++k) { const unsigned rk = __hip_atomic_fetch_add((LAS unsigned*)(c.MISC + MI_LCNT + sel[k]), 1u, __ATOMIC_RELAXED, __HIP_MEMORY_SCOPE_WORKGROUP);
                TOPI[(size_t)r * 4 + k] = sel[k]; TOPW[(size_t)r * 4 + k] = ww[k]; RANK[(size_t)r * 4 + k] = (int)rk; } }
    } else if (ln0_next >= 0) {
        phase_ln0(p, c, ln0_next, (int)blockIdx.x * 4 + (c.wave - 4), (int)gridDim.x * 4, GB_EMB2);
    }
    asm volatile("s_waitcnt vmcnt(0)" ::: "memory");
    __syncthreads();
    int lane2 = lane_fresh(); const int tid2 = c.wave * 64 + lane2;
    if (tid2 < NEXP) { unsigned* gc = (unsigned*)(c.ws + WS_CTL) + CW_CNT + ((g / NP) * NEXP + tid2) * 32; c.MISC[MI_LBASE + tid2] = atomicAdd(gc, (unsigned)c.MISC[MI_LCNT + tid2]); }
    __syncthreads();
    if (tid2 < 256) { const size_t i = (size_t)rbase * 4 + tid2; const int e = __hip_atomic_load(TOPI + i, __ATOMIC_RELAXED, __HIP_MEMORY_SCOPE_AGENT); const int pos = RANK[i] + (int)c.MISC[MI_LBASE + e]; RANK[i] = pos;
        ((int*)(c.ws + WS_RTOK))[(size_t)e * TOKP + pos] = (int)(i >> 2); ((float*)(c.ws + WS_RWW))[(size_t)e * TOKP + pos] = TOPW[i]; }
}
__device__ __forceinline__ int moe_tables(const Ctx& c, int pr) {
    const unsigned* cnt = (const unsigned*)(c.ws + WS_CTL) + CW_CNT + pr * NEXP * 32;
    if (c.wave == 0) { const int e = c.lane & 31; const unsigned cv = __hip_atomic_load(cnt + e * 32, __ATOMIC_RELAXED, __HIP_MEMORY_SCOPE_AGENT), pd = (cv + 255u) & ~255u; unsigned inc = pd;
#pragma unroll
        for (int o = 1; o < 32; o <<= 1) { const unsigned t = shfl_up_u(inc, o, c.lane); if (e >= o) inc += t; }
        if (c.lane < 32) { c.MISC[MI_OFF + e] = inc - pd; c.MISC[MI_CNT + e] = cv; if (e == 31) c.MISC[MI_OFF + NEXP] = inc; } }
    __syncthreads();
    const int ntiles = (int)(c.MISC[MI_OFF + NEXP] >> 8);
    for (int t = c.tid; t < ntiles; t += NTHR) { int e = 0; for (int k = 1; k < NEXP; ++k) if ((unsigned)(t * 256) >= c.MISC[MI_OFF + k]) e = k; ((volatile LAS unsigned char*)(c.MISC + MI_TE))[t] = (unsigned char)e; }
    __syncthreads();
    return ntiles;
}
__device__ __forceinline__ void phase_combine(const P& p, const Ctx& c, int pr) {
    const bf16_t* H1 = (const bf16_t*)(c.ws + WS_H1); const unsigned char* YS = c.ws + WS_YS; const int* TOPI = (const int*)(c.ws + WS_TOPI); const int* RANK = (const int*)(c.ws + WS_RANK);
    const int sub = c.lane & 15, rs = c.lane >> 4;
    for (int q = c.gw; q < TOKP / 4; q += c.NGW) { const int r = 4 * q + rs;
        int sl[4];
#pragma unroll
        for (int k = 0; k < 4; ++k) sl[k] = (int)c.MISC[MI_OFF + TOPI[(size_t)r * 4 + k]] + RANK[(size_t)r * 4 + k];
        f32x4 v[16];
        u32x4 hw[8]; u32x2 yw[4][8];
#pragma unroll
        for (int j = 0; j < 8; ++j) { hw[j] = ((const u32x4*)(H1 + (size_t)r * D))[16 * j + sub];
#pragma unroll
            for (int k = 0; k < 4; ++k) yw[k][j] = ((const u32x2*)(YS + (size_t)sl[k] * D))[16 * j + sub]; }
#pragma unroll
        for (int j = 0; j < 8; ++j) { f32x4 a0, a1; unpack8(hw[j], a0, a1); a0 = a0 * DN_ALPHA; a1 = a1 * DN_ALPHA; f32x4 y0 = {0.f, 0.f, 0.f, 0.f}, y1 = {0.f, 0.f, 0.f, 0.f};
#pragma unroll
            for (int k = 0; k < 4; ++k) { const f32x2 p0 = __builtin_amdgcn_cvt_pk_f32_fp8((int)yw[k][j].x, false), p1 = __builtin_amdgcn_cvt_pk_f32_fp8((int)yw[k][j].x, true), p2 = __builtin_amdgcn_cvt_pk_f32_fp8((int)yw[k][j].y, false), p3 = __builtin_amdgcn_cvt_pk_f32_fp8((int)yw[k][j].y, true);
                y0 = y0 + (f32x4){p0.x, p0.y, p1.x, p1.y}; y1 = y1 + (f32x4){p2.x, p2.y, p3.x, p3.y}; }
            v[2 * j] = a0 + y0 * YS_INV; v[2 * j + 1] = a1 + y1 * YS_INV; }
        float s = 0.f;
#pragma unroll
        for (int j = 0; j < 16; ++j) s += (v[j].x + v[j].y) + (v[j].z + v[j].w);
        const float mean = red16(s) * (1.f / D); float s2 = 0.f;
#pragma unroll
        for (int j = 0; j < 16; ++j) { v[j] = v[j] - mean; s2 += (v[j].x * v[j].x + v[j].y * v[j].y) + (v[j].z * v[j].z + v[j].w * v[j].w); }
        const float rstd = frsq(red16(s2) * (1.f / D) + LN_EPS);
        const int rl = r & (TOK - 1), gs = NP * pr + r / TOK;
        float* orow = p.out + ((size_t)(rl >> 9) * SEQ + gs * TSL + (rl & (TSL - 1))) * D;
#pragma unroll
        for (int j = 0; j < 8; ++j) { const int k0 = 128 * j + 8 * sub;
            const LAS float* gL = (const LAS float*)(c.lds + GB_LN2); const f32x4 g0 = *(const LAS f32x4*)(gL + k0), g1 = *(const LAS f32x4*)(gL + k0 + 4), b0 = *(const LAS f32x4*)(gL + 1024 + k0), b1 = *(const LAS f32x4*)(gL + 1024 + k0 + 4);
            *(f32x4*)(orow + k0) = v[2 * j] * rstd * g0 + b0; *(f32x4*)(orow + k0 + 4) = v[2 * j + 1] * rstd * g1 + b1;
            if (j & 1) __builtin_amdgcn_sched_barrier(0); }
    }
}

typedef short bf16x8 __attribute__((ext_vector_type(8)));
typedef float f32x16 __attribute__((ext_vector_type(16)));
typedef short bf16x4 __attribute__((ext_vector_type(4)));
constexpr int SW_K = 0, SW_KT = 9216, SW_VT = 36864, SW_VTT = 8704, SW_KM = 71680, SW_VTM = 76288;
constexpr float L2E = 1.4426950408889634f;
__device__ __forceinline__ bf16x8 mk8(bf16x4 a, bf16x4 b) { return (bf16x8){a[0], a[1], a[2], a[3], b[0], b[1], b[2], b[3]}; }
template <int MODE>
__device__ __forceinline__ void swa_tile(LAS unsigned char* lds, int kt, int jt, int iq, int lane, float slope2, const bf16x8 (&qf)[4], float& m, float& l, f32x16& ot0, f32x16& ot1) {
    const int r31 = lane & 31, h = lane >> 5;
    const int dq = iq - jt - 4 * h;
    const float cl = -slope2 * (float)dq; const int dmax = iq < 127 ? iq : 127;
    f32x16 s0, s1;
#pragma unroll
    for (int r = 0; r < 16; ++r) { const int ko = 8 * (r >> 2) + (r & 3);
        float t0 = fmaf(slope2, (float)ko, cl), t1 = fmaf(slope2, (float)(ko + 32), cl);
        if (MODE == 1) { const int d0 = dq - ko, d1 = dq - ko - 32; t0 = ((unsigned)d0 <= (unsigned)dmax) ? t0 : -3.0e38f; t1 = ((unsigned)d1 <= (unsigned)dmax) ? t1 : -3.0e38f; }
        s0[r] = t0; s1[r] = t1; }
    const LAS unsigned char* kb0 = lds + SW_K + kt * SW_KT + r31 * 144 + h * 16;
#pragma unroll
    for (int ks = 0; ks < 4; ++ks) { const bf16x8 a0 = *(const LAS bf16x8*)(kb0 + ks * 32), a1 = *(const LAS bf16x8*)(kb0 + 32 * 144 + ks * 32);
        s0 = __builtin_amdgcn_mfma_f32_32x32x16_bf16(a0, qf[ks], s0, 0, 0, 0); s1 = __builtin_amdgcn_mfma_f32_32x32x16_bf16(a1, qf[ks], s1, 0, 0, 0); }
    __builtin_amdgcn_sched_barrier(0);
    float mx = -3.0e38f;
#pragma unroll
    for (int r = 0; r < 16; ++r) mx = fmaxf(mx, fmaxf(s0[r], s1[r]));
    mx = fmaxf(mx, sx<32>(mx));
    const float mn = fmaxf(m, mx), sc = __builtin_amdgcn_exp2f(m - mn); m = mn;
    float ls = 0.f;
#pragma unroll
    for (int r = 0; r < 16; ++r) { s0[r] = __builtin_amdgcn_exp2f(s0[r] - mn); s1[r] = __builtin_amdgcn_exp2f(s1[r] - mn); ls += s0[r] + s1[r]; }
    l = l * sc + ls;
#pragma unroll
    for (int r = 0; r < 16; ++r) { ot0[r] *= sc; ot1[r] *= sc; }
    bf16x8 pf[2][2];
#pragma unroll
    for (int s = 0; s < 2; ++s) {
        u32x4 w0, w1;
        w0.x = pg8::cvt_pk_bf16(s0[8 * s + 0], s0[8 * s + 1]); w0.y = pg8::cvt_pk_bf16(s0[8 * s + 2], s0[8 * s + 3]); w0.z = pg8::cvt_pk_bf16(s0[8 * s + 4], s0[8 * s + 5]); w0.w = pg8::cvt_pk_bf16(s0[8 * s + 6], s0[8 * s + 7]);
        w1.x = pg8::cvt_pk_bf16(s1[8 * s + 0], s1[8 * s + 1]); w1.y = pg8::cvt_pk_bf16(s1[8 * s + 2], s1[8 * s + 3]); w1.z = pg8::cvt_pk_bf16(s1[8 * s + 4], s1[8 * s + 5]); w1.w = pg8::cvt_pk_bf16(s1[8 * s + 6], s1[8 * s + 7]);
        pf[0][s] = __builtin_bit_cast(bf16x8, w0); pf[1][s] = __builtin_bit_cast(bf16x8, w1); }
    __builtin_amdgcn_sched_barrier(0);
    const LAS unsigned char* vb0 = lds + SW_VT + kt * SW_VTT + r31 * 136 + h * 8; const int swz = (r31 >> 3) & 3;
#pragma unroll
    for (int kb = 0; kb < 2; ++kb)
#pragma unroll
        for (int s = 0; s < 2; ++s) { const int g0 = 4 * kb + 2 * s;
            const bf16x8 a0 = mk8(*(const LAS bf16x4*)(vb0 + ((g0 ^ swz) << 4)), *(const LAS bf16x4*)(vb0 + (((g0 + 1) ^ swz) << 4))),
                         a1 = mk8(*(const LAS bf16x4*)(vb0 + 32 * 136 + ((g0 ^ (swz + 4)) << 4)), *(const LAS bf16x4*)(vb0 + 32 * 136 + (((g0 + 1) ^ (swz + 4)) << 4)));
            ot0 = __builtin_amdgcn_mfma_f32_32x32x16_bf16(a0, pf[kb][s], ot0, 0, 0, 0); ot1 = __builtin_amdgcn_mfma_f32_32x32x16_bf16(a1, pf[kb][s], ot1, 0, 0, 0); }
    __builtin_amdgcn_sched_barrier(0);
}
__device__ __forceinline__ void swa_meta(LAS unsigned char* lds, int iq, int lane, float slope2, const bf16x8 (&qf)[4], float& m, float& l, f32x16& ot0, f32x16& ot1) {
    const int r31 = lane & 31, h = lane >> 5;
    const float cl = -slope2 * (float)(NMETA + iq - 4 * h);
    f32x16 s0;
#pragma unroll
    for (int r = 0; r < 16; ++r) { const int ko = 8 * (r >> 2) + (r & 3); s0[r] = r < 8 ? fmaf(slope2, (float)ko, cl) : 0.f; }
    const LAS unsigned char* kb0 = lds + SW_KM + r31 * 144 + h * 16;
#pragma unroll
    for (int ks = 0; ks < 4; ++ks) { const bf16x8 a0 = *(const LAS bf16x8*)(kb0 + ks * 32); s0 = __builtin_amdgcn_mfma_f32_32x32x16_bf16(a0, qf[ks], s0, 0, 0, 0); }
    float mx = -3.0e38f;
#pragma unroll
    for (int r = 0; r < 8; ++r) mx = fmaxf(mx, s0[r]);
    mx = fmaxf(mx, sx<32>(mx));
    const float mn = fmaxf(m, mx), sc = __builtin_amdgcn_exp2f(m - mn); m = mn;
    float ls = 0.f;
#pragma unroll
    for (int r = 0; r < 8; ++r) { s0[r] = __builtin_amdgcn_exp2f(s0[r] - mn); ls += s0[r]; }
    l = l * sc + ls;
#pragma unroll
    for (int r = 0; r < 16; ++r) { ot0[r] *= sc; ot1[r] *= sc; }
    u32x4 w0; w0.x = pg8::cvt_pk_bf16(s0[0], s0[1]); w0.y = pg8::cvt_pk_bf16(s0[2], s0[3]); w0.z = pg8::cvt_pk_bf16(s0[4], s0[5]); w0.w = pg8::cvt_pk_bf16(s0[6], s0[7]);
    const bf16x8 pf = __builtin_bit_cast(bf16x8, w0);
    const LAS unsigned char* vb0 = lds + SW_VTM + r31 * 72 + h * 8;
    const bf16x8 a0 = mk8(*(const LAS bf16x4*)(vb0), *(const LAS bf16x4*)(vb0 + 16)), a1 = mk8(*(const LAS bf16x4*)(vb0 + 32 * 72), *(const LAS bf16x4*)(vb0 + 32 * 72 + 16));
    ot0 = __builtin_amdgcn_mfma_f32_32x32x16_bf16(a0, pf, ot0, 0, 0, 0); ot1 = __builtin_amdgcn_mfma_f32_32x32x16_bf16(a1, pf, ot1, 0, 0, 0);
    __builtin_amdgcn_sched_barrier(0);
}
__device__ __forceinline__ void swa_unit(const P& p, const Ctx& c, int g, int u) {
    const int b = u >> 4, hk = (u >> 2) & 3, qt = u & 3, i0 = g * TSL + qt * 128;
    const bf16_t* KSF = (const bf16_t*)(c.ws + WS_KSF); const bf16_t* VSF = (const bf16_t*)(c.ws + WS_VSF); const float* PM = (const float*)(c.ws + WS_PM);
    const bf16_t* QS = (const bf16_t*)(c.ws + WS_QS); bf16_t* OS = (bf16_t*)(c.ws + WS_OSW);
    LAS unsigned char* lds = c.lds;
    { const int kk = c.tid >> 3, ch = c.tid & 7;
      u32x4 kv[4], vv[4]; f32x4 mk0 = {0.f, 0.f, 0.f, 0.f}, mk1 = {0.f, 0.f, 0.f, 0.f}; float mv[4] = {0.f, 0.f, 0.f, 0.f};
#pragma unroll
      for (int kt = 0; kt < 4; ++kt) { const int j = i0 - 128 + 64 * kt + kk, jc = j < 0 ? 0 : j; const size_t off = ((size_t)b * SEQ + jc) * 256 + hk * 64 + ch * 8;
          kv[kt] = *(const u32x4*)(KSF + off); vv[kt] = *(const u32x4*)(VSF + off); }
      const int mrow = c.tid >> 3, md = c.tid >> 3, m4 = (c.tid & 7) * 4;
      if (c.tid < 256 && mrow < NMETA) { const float* kp = PM + (size_t)mrow * CIN + C_KS + hk * 64 + ch * 8; mk0 = *(const f32x4*)kp; mk1 = *(const f32x4*)(kp + 4); }
      if (m4 < NMETA) { const float* vp = PM + (size_t)m4 * CIN + C_VS + hk * 64 + md; mv[0] = vp[0]; mv[1] = vp[CIN]; mv[2] = vp[2 * CIN]; mv[3] = vp[3 * CIN]; }
#pragma unroll
      for (int kt = 0; kt < 4; ++kt) {
          *(LAS u32x4*)(lds + SW_K + kt * SW_KT + kk * 144 + ch * 16) = kv[kt];
          LAS unsigned char* vt = lds + SW_VT + kt * SW_VTT + (ch * 8) * 136 + ((((kk >> 3) ^ ch) << 3) + (kk & 7)) * 2;
          *(LAS bf16_t*)(vt + 0 * 136) = (bf16_t)(vv[kt].x & 0xffffu); *(LAS bf16_t*)(vt + 1 * 136) = (bf16_t)(vv[kt].x >> 16); *(LAS bf16_t*)(vt + 2 * 136) = (bf16_t)(vv[kt].y & 0xffffu); *(LAS bf16_t*)(vt + 3 * 136) = (bf16_t)(vv[kt].y >> 16);
          *(LAS bf16_t*)(vt + 4 * 136) = (bf16_t)(vv[kt].z & 0xffffu); *(LAS bf16_t*)(vt + 5 * 136) = (bf16_t)(vv[kt].z >> 16); *(LAS bf16_t*)(vt + 6 * 136) = (bf16_t)(vv[kt].w & 0xffffu); *(LAS bf16_t*)(vt + 7 * 136) = (bf16_t)(vv[kt].w >> 16); }
      if (c.tid < 256) *(LAS u32x4*)(lds + SW_KM + mrow * 144 + ch * 16) = pack8(mk0, mk1);
      { u32x2 w; w.x = pg8::cvt_pk_bf16(mv[0], mv[1]); w.y = pg8::cvt_pk_bf16(mv[2], mv[3]); *(LAS u32x2*)(lds + SW_VTM + md * 72 + m4 * 2) = w; } }
    bf16x8 qf[4];
    { const int hq_ = 4 * hk + (c.wave & 3), r31_ = c.lane & 31, h_ = c.lane >> 5; const size_t row_ = (size_t)b * TSL + qt * 128 + (c.wave >> 2) * 64 + r31_;
#pragma unroll
      for (int ks = 0; ks < 4; ++ks) qf[ks] = *(const bf16x8*)(QS + row_ * D + hq_ * 64 + 16 * ks + 8 * h_); }
    __syncthreads();
    { const int gh = c.wave & 3, half = c.wave >> 2, hq = 4 * hk + gh, lane = c.lane, r31 = lane & 31, h = lane >> 5;
      const float slope2 = __builtin_amdgcn_exp2f(-0.5f * (float)(hq + 1)) * L2E, sink2 = p.in[I_SINK][hq] * L2E;
#pragma unroll 1
      for (int qb = 0; qb < 2; ++qb) {
          const int tl = qt * 128 + half * 64 + qb * 32 + r31, iq = g * TSL + tl; const size_t row = (size_t)b * TSL + tl;
          if (qb) {
#pragma unroll
              for (int ks = 0; ks < 4; ++ks) qf[ks] = *(const bf16x8*)(QS + row * D + hq * 64 + 16 * ks + 8 * h); }
          float m = sink2, l = h == 0 ? 1.0f : 0.0f; f32x16 ot0, ot1;
#pragma unroll
          for (int r = 0; r < 16; ++r) { ot0[r] = 0.f; ot1[r] = 0.f; }
          swa_meta(lds, iq, lane, slope2, qf, m, l, ot0, ot1);
          const int jt0 = i0 - 128 + 64 * half;
          swa_tile<1>(lds, half, jt0, iq, lane, slope2, qf, m, l, ot0, ot1);
          if (jt0 + 64 < 0) swa_tile<1>(lds, half + 1, jt0 + 64, iq, lane, slope2, qf, m, l, ot0, ot1); else swa_tile<0>(lds, half + 1, jt0 + 64, iq, lane, slope2, qf, m, l, ot0, ot1);
          swa_tile<1>(lds, half + 2, jt0 + 128, iq, lane, slope2, qf, m, l, ot0, ot1);
          const float inv = frcp(l + sx<32>(l));
          bf16_t* op = OS + row * D + hq * 64 + 4 * h;
#pragma unroll
          for (int gq = 0; gq < 4; ++gq) { u32x2 w0, w1;
              w0.x = pg8::cvt_pk_bf16(ot0[4 * gq] * inv, ot0[4 * gq + 1] * inv); w0.y = pg8::cvt_pk_bf16(ot0[4 * gq + 2] * inv, ot0[4 * gq + 3] * inv);
              w1.x = pg8::cvt_pk_bf16(ot1[4 * gq] * inv, ot1[4 * gq + 1] * inv); w1.y = pg8::cvt_pk_bf16(ot1[4 * gq + 2] * inv, ot1[4 * gq + 3] * inv);
              *(u32x2*)(op + 8 * gq) = w0; *(u32x2*)(op + 32 + 8 * gq) = w1; }
      } }
    __syncthreads();
}

constexpr int IM_W = 0, IM_QD = 16384, IM_QK = 32768, IM_KDT = 40960, IM_UV = 57344, UNIT_BYTES = 73728;
constexpr size_t WS_IMG = WS_IMG_BASE, WS_GT = 251 * MiB;
constexpr int GA_A = 0, GA_T = 16896, GA_GAM = 26112, GA_K = 27136, GA_Q = 44544, GA_KBT = 61952, GA_VBT = 80384;
__device__ __forceinline__ u32x4 pack8r(const f32x16& v, int s, float sc) {
    u32x4 w; w.x = pg8::cvt_pk_bf16(v[8 * s + 0] * sc, v[8 * s + 1] * sc); w.y = pg8::cvt_pk_bf16(v[8 * s + 2] * sc, v[8 * s + 3] * sc); w.z = pg8::cvt_pk_bf16(v[8 * s + 4] * sc, v[8 * s + 5] * sc); w.w = pg8::cvt_pk_bf16(v[8 * s + 6] * sc, v[8 * s + 7] * sc); return w; }
struct GdnRaw { u32x4 r[3][5]; float lg, be; };
__device__ __forceinline__ void gdn_a_prefetch(const Ctx& c, int g, int u, GdnRaw& R) {
    const int n = u & 7, h = (u >> 3) & 7, b = u >> 6, cg = c.tid & 15;
    const bf16_t* QKVG = (const bf16_t*)(c.ws + WS_QKVG); const bf16_t* HALO = (const bf16_t*)(c.ws + WS_HALO);
    const int tok0 = n * 64 + 2 * (c.tid >> 4);
#pragma unroll
    for (int i = 0; i < 5; ++i) { const int tt = tok0 - 3 + i;
        const bf16_t* mid = (tt >= 0 ? QKVG + ((size_t)b * TSL + tt) * 3072 : HALO + ((size_t)(((g + 1) & 1) * BATCH + b) * 3 + (3 + tt)) * 3072) + 1024 + h * 128 + 8 * cg;
        R.r[0][i] = *(const u32x4*)(mid - 1024); R.r[1][i] = *(const u32x4*)(mid); R.r[2][i] = *(const u32x4*)(mid + 1024); }
    const size_t row = (size_t)b * TSL + n * 64 + (c.lane);
    R.lg = ((const float*)(c.ws + WS_LOGG))[row * 8 + h]; R.be = ((const float*)(c.ws + WS_BETA))[row * 8 + h];
}
template <int R0>
__device__ __forceinline__ void gdn_conv8(const LAS float* cw, const u32x4 (&rawr)[5], f32x2 (&y)[4]) {
    f32x2 acc[4];
#pragma unroll
    for (int i = 0; i < 4; ++i) { const f32x4 w0 = *(const LAS f32x4*)(cw + i * 128), w1 = *(const LAS f32x4*)(cw + i * 128 + 4); const u32x4 rw = rawr[R0 + i];
        const f32x2 x0 = {bflo(rw.x), bfhi(rw.x)}, x1 = {bflo(rw.y), bfhi(rw.y)}, x2 = {bflo(rw.z), bfhi(rw.z)}, x3 = {bflo(rw.w), bfhi(rw.w)};
        const f32x2 wa = {w0.x, w0.y}, wb = {w0.z, w0.w}, wc = {w1.x, w1.y}, wd = {w1.z, w1.w};
        if (i == 0) { acc[0] = wa * x0; acc[1] = wb * x1; acc[2] = wc * x2; acc[3] = wd * x3; }
        else { acc[0] = acc[0] + wa * x0; acc[1] = acc[1] + wb * x1; acc[2] = acc[2] + wc * x2; acc[3] = acc[3] + wd * x3; } }
#pragma unroll
    for (int p = 0; p < 4; ++p) { f32x2 t = acc[p] * (-1.4426950408889634f);
        t.x = __builtin_amdgcn_exp2f(t.x); t.y = __builtin_amdgcn_exp2f(t.y); t = t + 1.0f; t.x = __builtin_amdgcn_rcpf(t.x); t.y = __builtin_amdgcn_rcpf(t.y);
        y[p] = acc[p] * t; }
}
constexpr int GA_CW = 98816, GA_TF = 104960, GA_XS = 121856;
constexpr int GA_LD = 66;
#define LDS_BAR() do { asm volatile("s_waitcnt lgkmcnt(0)" ::: "memory"); __builtin_amdgcn_s_barrier(); asm volatile("" ::: "memory"); } while (0)
__device__ __forceinline__ void gdn_a_unit(const P& p, const Ctx& c, int g, int u, GdnRaw& R, int unext) {
    const int n = u & 7, h = (u >> 3) & 7, b = u >> 6;
    LAS unsigned char* lds = c.lds;
    LAS float* gam = (LAS float*)(lds + GA_GAM); LAS float* bet = gam + 64; LAS float* egam = gam + 128; LAS float* ekd = gam + 192;
    LAS float* Amat = (LAS float*)(lds + GA_A); LAS float* TF = (LAS float*)(lds + GA_TF);
    const bf16_t* QKVG = (const bf16_t*)(c.ws + WS_QKVG); bf16_t* HALO = (bf16_t*)(c.ws + WS_HALO);
    unsigned char* img = c.ws + WS_IMG + (size_t)u * UNIT_BYTES;
    const int lane = c.lane, l31 = lane & 31, hh = lane >> 5;
    { AMP_BEGIN(16)
    if (c.wave == 0) { float ps = R.lg;
#pragma unroll
        for (int o = 1; o < 64; o <<= 1) { const float t = shfl_up_f(ps, o, lane); if (lane >= o) ps += t; }
        const float last = __builtin_bit_cast(float, __builtin_amdgcn_readlane(__builtin_bit_cast(int, ps), 63));
        gam[lane] = ps; bet[lane] = R.be; egam[lane] = fexp(ps); ekd[lane] = fexp(last - ps);
        if (lane == 63) ((float*)(c.ws + WS_GT))[u] = fexp(ps); }
    if (n == 7 && c.tid >= 64 && c.tid < 64 + 144) { const int t2 = c.tid - 64, i = t2 / 48, which = (t2 / 16) % 3, cg2 = t2 & 15;
        *(u32x4*)(HALO + ((size_t)((g & 1) * BATCH + b) * 3 + i) * 3072 + which * 1024 + h * 128 + 8 * cg2) = *(const u32x4*)(QKVG + ((size_t)b * TSL + (TSL - 3 + i)) * 3072 + which * 1024 + h * 128 + 8 * cg2); }
    LDS_BAR(); AMP_END(16) }
    { AMP_BEGIN(17)
    const LAS float* cwb = (const LAS float*)(lds + GA_CW) + 8 * (c.tid & 15);
    { const int cg = c.tid & 15, cl0 = 2 * (c.tid >> 4); f32x2 kbp[2][4], vbp[2][4];
#pragma unroll
      for (int pass = 0; pass < 2; ++pass) { const int cl = cl0 + pass; f32x2 yq[4], yk[4], yv[4];
        if (pass == 0) { gdn_conv8<0>(cwb, R.r[0], yq); gdn_conv8<0>(cwb + 512, R.r[1], yk); gdn_conv8<0>(cwb + 1024, R.r[2], yv); }
        else           { gdn_conv8<1>(cwb, R.r[0], yq); gdn_conv8<1>(cwb + 512, R.r[1], yk); gdn_conv8<1>(cwb + 1024, R.r[2], yv); }
        f32x2 sq2 = yq[0] * yq[0], sk2 = yk[0] * yk[0];
#pragma unroll
        for (int p = 1; p < 4; ++p) { sq2 = sq2 + yq[p] * yq[p]; sk2 = sk2 + yk[p] * yk[p]; }
        float sq = sq2.x + sq2.y, sk = sk2.x + sk2.y;
        sq += sx<1>(sq); sk += sx<1>(sk); sq += sx<2>(sq); sk += sx<2>(sk); sq += sx<4>(sq); sk += sx<4>(sk); sq += sx<8>(sq); sk += sx<8>(sk);
        const float rq_ = 0.08838834764831845f * frsq(sq + RMS_EPS), rk_ = frsq(sk + RMS_EPS), be = bet[cl] * egam[cl], bv = bet[cl];
        u32x4 qw, kw;
#pragma unroll
        for (int p = 0; p < 4; ++p) { const f32x2 qs = yq[p] * rq_, ks = yk[p] * rk_; qw[p] = pg8::cvt_pk_bf16(qs.x, qs.y); kw[p] = pg8::cvt_pk_bf16(ks.x, ks.y); kbp[pass][p] = ks * be; vbp[pass][p] = yv[p] * bv; }
        *(LAS u32x4*)(lds + GA_Q + cl * 272 + cg * 16) = qw; *(LAS u32x4*)(lds + GA_K + cl * 272 + cg * 16) = kw; }
#pragma unroll
      for (int j = 0; j < 8; ++j) { const float k0v = (j & 1) ? kbp[0][j >> 1].y : kbp[0][j >> 1].x, k1v = (j & 1) ? kbp[1][j >> 1].y : kbp[1][j >> 1].x, v0v = (j & 1) ? vbp[0][j >> 1].y : vbp[0][j >> 1].x, v1v = (j & 1) ? vbp[1][j >> 1].y : vbp[1][j >> 1].x;
          const int so = (8 * cg + j) * 144 + ((((cl0 >> 3) ^ (cg & 7)) << 3) + (cl0 & 7)) * 2;
          *(LAS unsigned*)(lds + GA_KBT + so) = pg8::cvt_pk_bf16(k0v, k1v); *(LAS unsigned*)(lds + GA_VBT + so) = pg8::cvt_pk_bf16(v0v, v1v); } }
    if (unext >= 0) gdn_a_prefetch(c, g, unext, R);
    LDS_BAR(); AMP_END(17) }
    { AMP_BEGIN(18)
    { const int w = c.wave & 3, rb = w >> 1, cb = w & 1; const bool isqk = c.wave >= 4;
      f32x16 acc;
#pragma unroll
      for (int r = 0; r < 16; ++r) acc[r] = 0.f;
      const bool zero = isqk ? (rb == 1 && cb == 0) : (rb == 0 && cb == 1);
      if (!zero) { const LAS unsigned char* ap = lds + GA_K + (32 * rb + l31) * 272 + hh * 16; const LAS unsigned char* bp = lds + (isqk ? GA_Q : GA_K) + (32 * cb + l31) * 272 + hh * 16;
#pragma unroll
          for (int ks = 0; ks < 8; ++ks) acc = __builtin_amdgcn_mfma_f32_32x32x16_bf16(*(const LAS bf16x8*)(ap + ks * 32), *(const LAS bf16x8*)(bp + ks * 32), acc, 0, 0, 0); }
      const int colx = 32 * cb + l31; const float gcol = gam[colx];
      if (!isqk) {
#pragma unroll
          for (int r = 0; r < 16; ++r) { const int cc = 32 * rb + 8 * (r >> 2) + 4 * hh + (r & 3); Amat[cc * GA_LD + colx] = (cc > colx) ? bet[cc] * acc[r] * fexp(gam[cc] - gcol) : 0.f; } }
      else {
#pragma unroll
          for (int r = 0; r < 16; ++r) { const int sp = 32 * rb + 8 * (r >> 2) + 4 * hh + (r & 3); acc[r] = (sp <= colx) ? acc[r] * fexp(gcol - gam[sp]) : 0.f; }
#pragma unroll
          for (int s = 0; s < 2; ++s) *(u32x4*)(img + IM_QK + ((((cb * 2 + rb) * 2 + s) * 64 + lane) * 16)) = pack8r(acc, s, 1.0f); } }
    LDS_BAR(); AMP_END(18) }
    { AMP_BEGIN(19)
    if (c.wave == 0) {
        const int blk = lane >> 4, cc = lane & 15; const LAS float* Ab = Amat + (16 * blk) * GA_LD + 16 * blk; float t[16]; const float lf = (float)cc;
#pragma unroll
        for (int i = 0; i < 16; ++i) { float s = fmaxf(1.0f - fabsf(lf - (float)i), 0.0f);
#pragma unroll
            for (int j = 0; j < i; ++j) s -= Ab[i * GA_LD + j] * t[j];
            t[i] = s; }
#pragma unroll
        for (int i = 0; i < 16; ++i) TF[(16 * blk + i) * GA_LD + 16 * blk + cc] = t[i];
    } else {
        for (int pid = c.tid - 64; pid < 2048; pid += NTHR - 64) { const int which = pid >> 10, f = (pid >> 6) & 15, ln = pid & 63, pl = ln & 31, ph = ln >> 5;
            if (which == 0) { const int ct = f >> 3, kt = (f >> 1) & 3, s = f & 1, cc = 32 * ct + pl; const float e = egam[cc];
                const LAS unsigned char* qp = lds + GA_Q + cc * 272 + (32 * kt + 16 * s + 4 * ph) * 2; const u32x2 a = *(const LAS u32x2*)qp, d = *(const LAS u32x2*)(qp + 16);
                u32x4 w; w.x = pg8::cvt_pk_bf16(bflo(a.x) * e, bfhi(a.x) * e); w.y = pg8::cvt_pk_bf16(bflo(a.y) * e, bfhi(a.y) * e); w.z = pg8::cvt_pk_bf16(bflo(d.x) * e, bfhi(d.x) * e); w.w = pg8::cvt_pk_bf16(bflo(d.y) * e, bfhi(d.y) * e);
                *(u32x4*)(img + IM_QD + (f * 64 + ln) * 16) = w; }
            else { const int kt = f >> 2, ctp = (f >> 1) & 1, s = f & 1, dk = 32 * kt + pl, c0 = 32 * ctp + 16 * s + 4 * ph; float v[8];
#pragma unroll
                for (int j = 0; j < 8; ++j) { const int cc = c0 + 8 * (j >> 2) + (j & 3); v[j] = bf1(*(const LAS bf16_t*)(lds + GA_K + cc * 272 + dk * 2)) * ekd[cc]; }
                u32x4 w; w.x = pg8::cvt_pk_bf16(v[0], v[1]); w.y = pg8::cvt_pk_bf16(v[2], v[3]); w.z = pg8::cvt_pk_bf16(v[4], v[5]); w.w = pg8::cvt_pk_bf16(v[6], v[7]);
                *(u32x4*)(img + IM_KDT + (f * 64 + ln) * 16) = w; } }
    }
    LDS_BAR(); AMP_END(19) }
    { AMP_BEGIN(20)
    { const int i15 = lane & 15, kq = lane >> 4; LAS float* XS = (LAS float*)(lds + GA_XS) + (c.wave < 3 ? c.wave : 0) * 16 * 17;
#pragma unroll 1
      for (int bi = 1; bi < 4; ++bi) {
          if (c.wave < bi) { const int cb = c.wave; f32x4 x = {0.f, 0.f, 0.f, 0.f};
#pragma unroll 1
              for (int bj = cb; bj < bi; ++bj)
#pragma unroll
                  for (int kk = 0; kk < 4; ++kk) x = __builtin_amdgcn_mfma_f32_16x16x4f32(Amat[(16 * bi + i15) * GA_LD + 16 * bj + 4 * kk + kq], TF[(16 * bj + 4 * kk + kq) * GA_LD + 16 * cb + i15], x, 0, 0, 0);
#pragma unroll
              for (int r = 0; r < 4; ++r) XS[(4 * kq + r) * 17 + i15] = x[r];
              asm volatile("s_waitcnt lgkmcnt(0)" ::: "memory");
              f32x4 t = {0.f, 0.f, 0.f, 0.f};
#pragma unroll
              for (int kk = 0; kk < 4; ++kk) t = __builtin_amdgcn_mfma_f32_16x16x4f32(TF[(16 * bi + i15) * GA_LD + 16 * bi + 4 * kk + kq], XS[(4 * kk + kq) * 17 + i15], t, 0, 0, 0);
#pragma unroll
              for (int r = 0; r < 4; ++r) TF[(16 * bi + 4 * kq + r) * GA_LD + 16 * cb + i15] = -t[r]; }
          LDS_BAR(); } }
    AMP_END(20) }
    { AMP_BEGIN(21)
    { const int row = c.tid >> 3, c8 = (c.tid & 7) * 8; f32x4 a, d;
#pragma unroll
      for (int j = 0; j < 4; ++j) { a[j] = (c8 <= (row | 15)) ? TF[row * GA_LD + c8 + j] : 0.f; d[j] = (c8 <= (row | 15)) ? TF[row * GA_LD + c8 + 4 + j] : 0.f; }
      *(LAS u32x4*)(lds + GA_T + row * 144 + c8 * 2) = pack8(a, d); }
    LDS_BAR();
    { const int kt = c.wave >> 1, ct = c.wave & 1; f32x16 acc;
#pragma unroll
      for (int r = 0; r < 16; ++r) acc[r] = 0.f;
      const LAS unsigned char* ap = lds + GA_KBT + (32 * kt + l31) * 144; const LAS unsigned char* bp = lds + GA_T + (32 * ct + l31) * 144 + hh * 16; const int swz = (4 * kt + (l31 >> 3)) & 7;
#pragma unroll
      for (int ks = 0; ks < 4; ++ks) acc = __builtin_amdgcn_mfma_f32_32x32x16_bf16(*(const LAS bf16x8*)(ap + (((hh + 2 * ks) ^ swz) << 4)), *(const LAS bf16x8*)(bp + ks * 32), acc, 0, 0, 0);
#pragma unroll
      for (int s = 0; s < 2; ++s) *(u32x4*)(img + IM_W + ((((ct * 4 + kt) * 2 + s) * 64 + lane) * 16)) = pack8r(acc, s, -1.0f); }
    { const int ct = c.wave >> 2, vt = c.wave & 3; f32x16 acc;
#pragma unroll
      for (int r = 0; r < 16; ++r) acc[r] = 0.f;
      const LAS unsigned char* ap = lds + GA_T + (32 * ct + l31) * 144 + hh * 16; const LAS unsigned char* bp = lds + GA_VBT + (32 * vt + l31) * 144; const int swz = (4 * vt + (l31 >> 3)) & 7;
#pragma unroll
      for (int ks = 0; ks < 4; ++ks) acc = __builtin_amdgcn_mfma_f32_32x32x16_bf16(*(const LAS bf16x8*)(ap + ks * 32), *(const LAS bf16x8*)(bp + (((hh + 2 * ks) ^ swz) << 4)), acc, 0, 0, 0);
#pragma unroll
      for (int s = 0; s < 2; ++s) *(u32x4*)(img + IM_UV + (((ct * 4 + vt) * 64 + lane) * 32 + s * 16)) = pack8r(acc, s, 1.0f); }
    LDS_BAR(); AMP_END(21) }
}
__device__ __forceinline__ void gdn_a_units(const P& p, Ctx& c, int g, int bh) {
    { const int h = bh & 7; const float* cw = p.in[I_CONVW]; LAS float* cwl = (LAS float*)(c.lds + GA_CW);
      for (int i = c.tid; i < 3 * 128; i += NTHR) { const int which = i >> 7, ch = i & 127; const f32x4 w4 = *(const f32x4*)(cw + (size_t)(which * 1024 + h * 128 + ch) * 4); LAS float* o = cwl + which * 512 + ch; o[0] = w4.x; o[128] = w4.y; o[256] = w4.z; o[384] = w4.w; } }
    GdnRaw R; gdn_a_prefetch(c, g, bh * 8, R);
    LDS_BAR();
    c.lane = lane_fresh(); c.tid = c.wave * 64 + c.lane;
    gdn_a_unit(p, c, g, bh * 8, R, bh * 8 + 1);
#pragma unroll 1
    for (int n = 1; n < 8; ++n) { const int u = bh * 8 + n, un = n < 7 ? u + 1 : -1;
        c.lane = lane_fresh(); c.tid = c.wave * 64 + c.lane;
        gdn_a_unit(p, c, g, u, R, un); }
}

constexpr int GS_S = 0, GS_U = 32768, GS_O = 49152, GS_WQ = 66560, GS_KK = 99328;
__device__ __forceinline__ void gdn_scan_unit(const P& p, const Ctx& c, int g, int bh) {
    const int b = bh >> 3, h = bh & 7, ct = c.wave >> 2, vt = c.wave & 3, lane = c.lane, l31 = lane & 31, hh = lane >> 5;
    LAS unsigned char* lds = c.lds;
    const bf16_t* ZS = (const bf16_t*)(c.ws + WS_ZS); bf16_t* OG = (bf16_t*)(c.ws + WS_OG); const float* GT = (const float*)(c.ws + WS_GT);
    float* SC = (float*)(c.ws + WS_SC) + (size_t)bh * 128 * 128; const float* Sin = g == 0 ? (const float*)(c.ws + WS_S1) + (size_t)h * 128 * 128 : SC;
    f32x16 S0, S1;
#pragma unroll
    for (int r = 0; r < 16; ++r) { const int dk = 8 * (r >> 2) + 4 * hh + (r & 3); S0[r] = Sin[(size_t)(64 * ct + dk) * 128 + 32 * vt + l31]; S1[r] = Sin[(size_t)(64 * ct + 32 + dk) * 128 + 32 * vt + l31]; }
#pragma unroll
    for (int s = 0; s < 2; ++s) { *(LAS u32x4*)(lds + GS_S + ((((2 * ct) * 4 + vt) * 2 + s) * 64 + lane) * 16) = pack8r(S0, s, 1.0f); *(LAS u32x4*)(lds + GS_S + ((((2 * ct + 1) * 4 + vt) * 2 + s) * 64 + lane) * 16) = pack8r(S1, s, 1.0f); }
    const unsigned char* img0 = c.ws + WS_IMG + (size_t)(bh * 8) * UNIT_BYTES;
    u32x4 t0[4], t1[3], uv0, uv1; float gtn;
    { const unsigned char* img = img0;
#pragma unroll
      for (int i = 0; i < 4; ++i) t0[i] = *(const u32x4*)(img + IM_W + (size_t)(i * NTHR + c.tid) * 16);
#pragma unroll
      for (int i = 0; i < 3; ++i) t1[i] = *(const u32x4*)(img + IM_QK + (size_t)(i * NTHR + c.tid) * 16);
      uv0 = *(const u32x4*)(img + IM_UV + ((ct * 4 + vt) * 64 + lane) * 32); uv1 = *(const u32x4*)(img + IM_UV + ((ct * 4 + vt) * 64 + lane) * 32 + 16);
      gtn = __hip_atomic_load(GT + bh * 8, __ATOMIC_RELAXED, __HIP_MEMORY_SCOPE_AGENT); }
    auto chunk = [&](const int n) __attribute__((always_inline)) {
#pragma unroll
        for (int i = 0; i < 4; ++i) *(LAS u32x4*)(lds + GS_WQ + (i * NTHR + c.tid) * 16) = t0[i];
#pragma unroll
        for (int i = 0; i < 3; ++i) *(LAS u32x4*)(lds + GS_KK + (i * NTHR + c.tid) * 16) = t1[i];
        f32x16 U, O;
        U[0] = bflo(uv0.x); U[1] = bfhi(uv0.x); U[2] = bflo(uv0.y); U[3] = bfhi(uv0.y); U[4] = bflo(uv0.z); U[5] = bfhi(uv0.z); U[6] = bflo(uv0.w); U[7] = bfhi(uv0.w);
        U[8] = bflo(uv1.x); U[9] = bfhi(uv1.x); U[10] = bflo(uv1.y); U[11] = bfhi(uv1.y); U[12] = bflo(uv1.z); U[13] = bfhi(uv1.z); U[14] = bflo(uv1.w); U[15] = bfhi(uv1.w);
        const float gt = gtn;
#pragma unroll
        for (int r = 0; r < 16; ++r) O[r] = 0.f;
        LDS_BAR();
        { const unsigned char* img = img0 + (size_t)(n < 7 ? n + 1 : 7) * UNIT_BYTES;
#pragma unroll
          for (int i = 0; i < 4; ++i) t0[i] = *(const u32x4*)(img + IM_W + (size_t)(i * NTHR + c.tid) * 16);
#pragma unroll
          for (int i = 0; i < 3; ++i) t1[i] = *(const u32x4*)(img + IM_QK + (size_t)(i * NTHR + c.tid) * 16);
          uv0 = *(const u32x4*)(img + IM_UV + ((ct * 4 + vt) * 64 + lane) * 32); uv1 = *(const u32x4*)(img + IM_UV + ((ct * 4 + vt) * 64 + lane) * 32 + 16);
          gtn = __hip_atomic_load(GT + bh * 8 + (n < 7 ? n + 1 : 7), __ATOMIC_RELAXED, __HIP_MEMORY_SCOPE_AGENT); }
        const int zc = c.tid >> 3, zseg = c.tid & 7; const size_t zrow = (size_t)b * TSL + n * 64 + zc;
        const u32x4 z0 = *(const u32x4*)(ZS + zrow * D + h * 128 + zseg * 16), z1 = *(const u32x4*)(ZS + zrow * D + h * 128 + zseg * 16 + 8);
        f32x4 nwv[4];
#pragma unroll
        for (int j = 0; j < 4; ++j) nwv[j] = *(const f32x4*)(p.in[I_GNW] + zseg * 16 + 4 * j);
#pragma unroll
        for (int kt = 0; kt < 4; ++kt)
#pragma unroll
            for (int s = 0; s < 2; ++s) { const bf16x8 sb = *(const LAS bf16x8*)(lds + GS_S + (((kt * 4 + vt) * 2 + s) * 64 + lane) * 16);
                const bf16x8 aw = *(const LAS bf16x8*)(lds + GS_WQ + (((ct * 4 + kt) * 2 + s) * 64 + lane) * 16), aq = *(const LAS bf16x8*)(lds + GS_WQ + 16384 + (((ct * 4 + kt) * 2 + s) * 64 + lane) * 16);
                U = __builtin_amdgcn_mfma_f32_32x32x16_bf16(aw, sb, U, 0, 0, 0); O = __builtin_amdgcn_mfma_f32_32x32x16_bf16(aq, sb, O, 0, 0, 0); }
#pragma unroll
        for (int s = 0; s < 2; ++s) *(LAS u32x4*)(lds + GS_U + (((ct * 4 + vt) * 2 + s) * 64 + lane) * 16) = pack8r(U, s, 1.0f);
        LDS_BAR();
#pragma unroll
        for (int r = 0; r < 16; ++r) { S0[r] *= gt; S1[r] *= gt; }
#pragma unroll
        for (int cp = 0; cp < 2; ++cp)
#pragma unroll
            for (int s = 0; s < 2; ++s) { const bf16x8 ub = *(const LAS bf16x8*)(lds + GS_U + (((cp * 4 + vt) * 2 + s) * 64 + lane) * 16);
                const bf16x8 aqk = *(const LAS bf16x8*)(lds + GS_KK + (((ct * 2 + cp) * 2 + s) * 64 + lane) * 16);
                const bf16x8 ak0 = *(const LAS bf16x8*)(lds + GS_KK + 8192 + ((((2 * ct) * 2 + cp) * 2 + s) * 64 + lane) * 16), ak1 = *(const LAS bf16x8*)(lds + GS_KK + 8192 + ((((2 * ct + 1) * 2 + cp) * 2 + s) * 64 + lane) * 16);
                O = __builtin_amdgcn_mfma_f32_32x32x16_bf16(aqk, ub, O, 0, 0, 0); S0 = __builtin_amdgcn_mfma_f32_32x32x16_bf16(ak0, ub, S0, 0, 0, 0); S1 = __builtin_amdgcn_mfma_f32_32x32x16_bf16(ak1, ub, S1, 0, 0, 0); }
#pragma unroll
        for (int r = 0; r < 16; ++r) { const int cc = 32 * ct + 8 * (r >> 2) + 4 * hh + (r & 3); *(LAS bf16_t*)(lds + GS_O + cc * 272 + (32 * vt + l31) * 2) = (bf16_t)f2bf(O[r]); }
#pragma unroll
        for (int s = 0; s < 2; ++s) { *(LAS u32x4*)(lds + GS_S + ((((2 * ct) * 4 + vt) * 2 + s) * 64 + lane) * 16) = pack8r(S0, s, 1.0f); *(LAS u32x4*)(lds + GS_S + ((((2 * ct + 1) * 4 + vt) * 2 + s) * 64 + lane) * 16) = pack8r(S1, s, 1.0f); }
        LDS_BAR();
        { f32x4 o[4]; float ss = 0.f;
          const u32x4 w0 = *(const LAS u32x4*)(lds + GS_O + zc * 272 + zseg * 32), w1 = *(const LAS u32x4*)(lds + GS_O + zc * 272 + zseg * 32 + 16);
          unpack8(w0, o[0], o[1]); unpack8(w1, o[2], o[3]);
#pragma unroll
          for (int j = 0; j < 4; ++j) ss += (o[j].x * o[j].x + o[j].y * o[j].y) + (o[j].z * o[j].z + o[j].w * o[j].w);
          ss += sx<1>(ss); ss += sx<2>(ss); ss += sx<4>(ss);
          const float rn = frsq(ss * (1.f / 128.f) + RMS_EPS);
          f32x4 z[4]; unpack8(z0, z[0], z[1]); unpack8(z1, z[2], z[3]);
#pragma unroll
          for (int j = 0; j < 4; ++j) o[j] = o[j] * rn * nwv[j] * z[j];
          *(u32x4*)(OG + zrow * D + h * 128 + zseg * 16) = pack8(o[0], o[1]); *(u32x4*)(OG + zrow * D + h * 128 + zseg * 16 + 8) = pack8(o[2], o[3]); }
    };
    chunk(0);
#pragma unroll 1
    for (int n = 1; n < 8; ++n) chunk(n);
    { int l2 = l31, h2 = hh; asm volatile("" : "+v"(l2), "+v"(h2));
#pragma unroll
      for (int r = 0; r < 16; ++r) { const int dk = 8 * (r >> 2) + 4 * h2 + (r & 3); SC[(size_t)(64 * ct + dk) * 128 + 32 * vt + l2] = S0[r]; SC[(size_t)(64 * ct + 32 + dk) * 128 + 32 * vt + l2] = S1[r]; } }
    __syncthreads();
}


constexpr int NPH_G = 11, NPHASES = 1 + NG * NPH_G;
__global__ void __launch_bounds__(NTHR, 2) fwd(P p) {
    extern __shared__ __attribute__((aligned(16))) unsigned char lds_raw[];
    Ctx c; c.lds = (LAS unsigned char*)lds_raw; c.MISC = (volatile LAS unsigned*)(c.lds + MISC_OFF);
    c.tid = threadIdx.x; c.lane = c.tid & 63; c.wave = __builtin_amdgcn_readfirstlane(c.tid >> 6); c.G = gridDim.x; c.ws = p.ws;
    { const int bx = blockIdx.x; const int vcu = (c.G % 8 == 0) ? (bx % 8) * (c.G / 8) + bx / 8 : bx; c.gw = vcu * NWAVES + c.wave; c.NGW = c.G * NWAVES; }
    unsigned* ctl = (unsigned*)(p.ws + WS_CTL);
    if (c.tid < 16) c.MISC[c.tid] = 0u;
    __syncthreads();
#if MK_SINGLE
    XcdBarrier bar = xcd_barrier_post(ctl + CW_BAR, c.MISC, c.tid == 0);
#define SEAM(k) do { if (IN(k) && IN((k) + 1)) { FRESH(); xcd_barrier(bar, c.tid == 0); } } while (0)
#else
#define SEAM(k) do { } while (0)
#endif
#ifndef PHASE_MASK
#define PHASE_MASK 0xFFFF
#endif
#define IN(k) (p.ph_lo <= (k) && (k) < p.ph_hi)
#define ON(j) (((PHASE_MASK) >> (j)) & 1)
    const int bx = blockIdx.x;
#if defined(__HIP_DEVICE_COMPILE__)
    typedef const P __attribute__((address_space(4)))* KP;
    KP kp0 = (KP)__builtin_amdgcn_kernarg_segment_ptr();
#define PLOAD() KP kp_ = kp0; asm volatile("" : "+s"(kp_)); const P q = *kp_;
#else
#define PLOAD() const P q = p;
#endif
#define FRESH() do { c.lane = lane_fresh(); c.tid = c.wave * 64 + c.lane; } while (0)
    { AMP_BEGIN(11) if (ON(11) && IN(0)) { FRESH(); PLOAD(); phase_prep(q, c); __syncthreads(); FRESH(); stage_gb(c, q.in[I_ELG], q.in[I_ELB], (LAS float*)(c.lds + GB_EMB)); __syncthreads(); phase_ln0(q, c, 0, c.gw, c.NGW, GB_EMB); }
    SEAM(0); AMP_END(11) }
    for (int g = 0; g < NG; ++g) {
        const int pb = 1 + g * NPH_G;
        { AMP_BEGIN(1)
        if (ON(1) && IN(pb + 1)) { FRESH(); PLOAD();
#if G1_FP8
            SchedStd S; S.init(TOK, N1, D, c.G, bx, q.ws + WS_H0Q, q.ws + WS_WIN);
#else
            SchedStd S; S.init(TOK, N1, 2 * D, c.G, bx, q.ws + WS_H0, q.ws + WS_WIN);
#endif
            if (g == 0 && bx >= 256 - NHG) { meta_state(q, c, bx - (256 - NHG), c.lds); FRESH(); }
            EpiG1 E{(bf16_t*)(q.ws + WS_QKVG), (bf16_t*)(q.ws + WS_ZS), (bf16_t*)(q.ws + WS_QS), (bf16_t*)(q.ws + WS_KSF), (bf16_t*)(q.ws + WS_VSF), (bf16_t*)(q.ws + WS_SG), (bf16_t*)(q.ws + WS_SS), g, G1_FP8 ? W8_INV : 1.0f,
                    (float*)(q.ws + WS_BETA), (float*)(q.ws + WS_LOGG), q.in[I_ALOG], q.in[I_DTB]};
#if G1_FP8
            pg8::gemm_phase<EpiG1, SchedStd, true, true, true>(c.lds, D, S, E, c.wave);
#else
            pg8::gemm_phase<EpiG1, SchedStd, true, true>(c.lds, 2 * D, S, E, c.wave);
#endif
        }
        SEAM(pb + 1); AMP_END(1) }
        { AMP_BEGIN(2)
        if (ON(2) && IN(pb + 2)) { FRESH(); PLOAD();
            { AMP_BEGIN(12) for (int bh = bx; bh < BATCH * NHG; bh += c.G) { { AMP_BEGIN(14) gdn_a_units(q, c, g, bh); AMP_END(14) }
                asm volatile("s_waitcnt vmcnt(0)" ::: "memory"); __syncthreads();
                FRESH(); gdn_scan_unit(q, c, g, bh); } AMP_END(12) }
            { AMP_BEGIN(13) for (int u = bx; u < BATCH * NHK * 4; u += c.G) { FRESH(); swa_unit(q, c, g, u); } AMP_END(13) }
        }
        SEAM(pb + 2); AMP_END(2) }
        { AMP_BEGIN(4)
        if (ON(4) && IN(pb + 4)) { FRESH(); PLOAD();
            SchedPair S; S.init(TOK, D, 2 * D, c.G, bx, q.ws + WS_OG, q.ws + WS_WBG, q.ws + WS_OSW, q.ws + WS_WBS);
            EpiBr E{(const bf16_t*)(q.ws + WS_SG), (const bf16_t*)(q.ws + WS_SS), (bf16_t*)(q.ws + WS_Y)};
            pg8::gemm_phase<EpiBr, SchedPair, true, true>(c.lds, 2 * D, S, E, c.wave);
        }
        SEAM(pb + 4); AMP_END(4) }
        { AMP_BEGIN(5)
        if (ON(5) && IN(pb + 5)) { FRESH(); PLOAD();
            SchedStd S; S.init(TOK, D, 2 * D, c.G, bx, q.ws + WS_Y, q.ws + WS_WOUT);
            EpiOut E{(const bf16_t*)(q.ws + WS_H0), (bf16_t*)(q.ws + WS_PRE1)};
            pg8::gemm_phase<EpiOut, SchedStd, true, true>(c.lds, 2 * D, S, E, c.wave);
        }
        SEAM(pb + 5); AMP_END(5) }
        { AMP_BEGIN(6)
        if (ON(6) && IN(pb + 6)) { FRESH(); PLOAD(); phase_ln1_router(q, c, g, g + 1 < NG ? g + 1 : -1); }
        SEAM(pb + 6); AMP_END(6) }
        if ((g % NP) == NP - 1) {
        const int pr = g / NP;
        { AMP_BEGIN(8)
        if (ON(8) && IN(pb + 8)) { FRESH(); PLOAD();
            const int ntiles = moe_tables(c, pr);
            LAS unsigned short* tokt = (LAS unsigned short*)(c.lds + RING_BYTES);
            const int* RTOK = (const int*)(q.ws + WS_RTOK); const int nwg_ = ntiles * 8;
#pragma unroll 1
            for (int win = 0; win < 2; ++win) {
                { int tv[9];
#pragma unroll
                  for (int k = 0; k < 9; ++k) { const int it = c.tid + NTHR * k, i = it >> 8, R = it & 255, L = (i + 17 * win) * c.G + bx; tv[k] = 0;
                      if (i < 17 && L < nwg_) { const int rt = xcd_chunk(L, nwg_) >> 3, e = (int)((volatile LAS unsigned char*)(c.MISC + MI_TE))[rt]; const unsigned pos = (unsigned)(rt * 256 + R) - c.MISC[MI_OFF + e];
                          if (pos < c.MISC[MI_CNT + e]) tv[k] = RTOK[(size_t)e * TOKP + pos]; } }
#pragma unroll
                  for (int k = 0; k < 9; ++k) { const int it = c.tid + NTHR * k, i = it >> 8, L = (i + 17 * win) * c.G + bx; if (i < 17 && L < nwg_) tokt[it] = (unsigned short)tv[k]; } }
                __syncthreads();
                SchedMoeG S; S.init(ntiles, 2 * DFF, D, c.G, bx, q.ws + WS_H1Q, q.ws + WS_W1, c.MISC + MI_TE); S.tokt = tokt; S.i0 = 17 * win; S.ni = 17;
                EpiMoe1 E{q.in[I_B1], q.ws + WS_HID};
                pg8::gemm_phase<EpiMoe1, SchedMoeG, true, true, true, true>(c.lds, D, S, E, c.wave);
                FRESH(); __syncthreads(); }
        }
        SEAM(pb + 8); AMP_END(8) }
        { AMP_BEGIN(9)
        if (ON(9) && IN(pb + 9)) { FRESH(); PLOAD();
            const int ntiles = (int)(c.MISC[MI_OFF + NEXP] >> 8);
            SchedMoe S; S.init(ntiles, D, DFF, c.G, bx, q.ws + WS_HID, q.ws + WS_W2, c.MISC + MI_TE);
            EpiMoe2 E{q.in[I_B2], (const float*)(q.ws + WS_RWW), q.ws + WS_YS, c.MISC};
            pg8::gemm_phase<EpiMoe2, SchedMoe, true, true, true>(c.lds, DFF, S, E, c.wave);
        }
        SEAM(pb + 9); AMP_END(9) }
        { AMP_BEGIN(10)
        if (ON(10) && IN(pb + 10)) { FRESH(); PLOAD(); stage_gb(c, q.in[I_L2G], q.in[I_L2B], (LAS float*)(c.lds + GB_LN2)); __syncthreads();
            phase_combine(q, c, pr); }
        SEAM(pb + 10); AMP_END(10) }
        }
    }
#if defined(EXTRA_BARRIERS) && MK_SINGLE
    for (int xb = 0; xb < EXTRA_BARRIERS; ++xb) { FRESH(); xcd_barrier(bar, c.tid == 0); }
#endif
#undef IN
#undef PLOAD
#undef FRESH
#undef SEAM
}

extern "C" void kernel_launch(void* const* d_in, const int* in_sizes, int n_in, void* d_out, int out_size, void* d_ws, size_t ws_size, hipStream_t stream) {
    static int grid = 0;
    if (grid == 0) {
        if (n_in != 23 || in_sizes[0] != BATCH * SEQ * D || out_size != BATCH * SEQ * D || ws_size < WS_END) {
            fprintf(stderr, "kernel_launch: unexpected shapes (n_in %d, in0 %d, out %d, ws %zu, need %zu); nothing launched\n", n_in, n_in > 0 ? in_sizes[0] : -1, out_size, ws_size, (size_t)WS_END); grid = -1; return; }
        int dev = 0, cus = 0;
        if (hipGetDevice(&dev) != hipSuccess || hipDeviceGetAttribute(&cus, hipDeviceAttributeMultiprocessorCount, dev) != hipSuccess) { grid = -1; return; }
        if (hipFuncSetAttribute((const void*)fwd, hipFuncAttributeMaxDynamicSharedMemorySize, LDS_BYTES) != hipSuccess) { fprintf(stderr, "kernel_launch: hipFuncSetAttribute failed\n"); grid = -1; return; }
        int per_cu = 0; (void)hipOccupancyMaxActiveBlocksPerMultiprocessor(&per_cu, (const void*)fwd, NTHR, LDS_BYTES); (void)hipGetLastError();
        if (cus != 256) { fprintf(stderr, "kernel_launch: built for a 256-CU device (one workgroup per CU, 64 token rows of a slice per workgroup in the router phase); found %d CUs; nothing launched\n", cus); grid = -1; return; }
        grid = cus;
    }
    if (grid < 0) return;
    if (hipMemsetAsync((char*)d_ws + WS_CTL, 0, CTL_ZERO_BYTES, stream) != hipSuccess) return;
    P a{};
    for (int i = 0; i < 23; ++i) a.in[i] = (const float*)d_in[i];
    a.out = (float*)d_out; a.ws = (unsigned char*)d_ws;
#if MK_SINGLE
    a.ph_lo = 0; a.ph_hi = NPHASES;
    hipLaunchKernelGGL(fwd, dim3(grid), dim3(NTHR), LDS_BYTES, stream, a);
#else
    for (int ph = 0; ph < NPHASES; ++ph) { a.ph_lo = ph; a.ph_hi = ph + 1; hipLaunchKernelGGL(fwd, dim3(grid), dim3(NTHR), LDS_BYTES, stream, a); }
#endif
}
```

```cpp
#include <hip/hip_runtime.h>
#include <cstdio>
#include <cstdint>
#ifndef MK_SINGLE
#define MK_SINGLE 1
#endif
__device__ __forceinline__ int lane_fresh() { int l; asm volatile("v_mbcnt_lo_u32_b32 %0, -1, 0\n\tv_mbcnt_hi_u32_b32 %0, -1, %0" : "=v"(l)); return l; }
template <int M> __device__ __forceinline__ float sx(float v) {
    if constexpr (M < 32) return __builtin_bit_cast(float, __builtin_amdgcn_ds_swizzle(__builtin_bit_cast(int, v), 0x1F | (M << 10)));
    else return __builtin_bit_cast(float, __builtin_amdgcn_ds_bpermute((lane_fresh() ^ M) << 2, __builtin_bit_cast(int, v))); }
__device__ __forceinline__ float shfl_up_f(float v, int o, int lane) { return __builtin_bit_cast(float, __builtin_amdgcn_ds_bpermute((lane - o) << 2, __builtin_bit_cast(int, v))); }
__device__ __forceinline__ unsigned shfl_up_u(unsigned v, int o, int lane) { return (unsigned)__builtin_amdgcn_ds_bpermute((lane - o) << 2, (int)v); }
namespace pg8 {
#define PG8_LAS __attribute__((address_space(3)))
typedef unsigned short bf16_t;
typedef short bf16x8 __attribute__((ext_vector_type(8)));
typedef float f32x4 __attribute__((ext_vector_type(4)));
typedef unsigned u32x4 __attribute__((ext_vector_type(4)));
typedef unsigned u32x2 __attribute__((ext_vector_type(2)));
constexpr int BM = 256, BK = 64, HALF = 128, HTB = HALF * BK * 2  , STAGE_BYTES = 8 * HTB, NXCD = 8, WGM = 8;
__host__ __device__ __forceinline__ int lds_byte(int r, int c) { const int st = (r >> 4) * 2 + (c >> 5), rr = r & 15, cc = c & 31, ob = rr * 64 + cc * 2; return st * 1024 + (ob ^ (((ob >> 9) & 1) << 5)); }
__host__ __device__ __forceinline__ void stage_rc(int b, int& R, int& C) { const int st = b / 1024, sb = b % 1024, swz = sb ^ (((sb >> 9) & 1) << 5); R = (st >> 1) * 16 + swz / 64; C = (st & 1) * 32 + (swz % 64) / 2; }
__host__ __device__ __forceinline__ int perm32(int rho) { const int n = rho >> 4, i = rho & 15; return 8 * (i >> 2) + 4 * n + (i & 3); }
struct Unit { int pm, pn, e, kind; const char* A; const char* B; };
typedef __bf16 bf16x2n __attribute__((ext_vector_type(2))); typedef float f32x2n __attribute__((ext_vector_type(2)));
typedef int i32x8 __attribute__((ext_vector_type(8))); typedef int i32x4 __attribute__((ext_vector_type(4)));
__device__ __forceinline__ i32x8 cat8(bf16x8 a, bf16x8 b) { const i32x4 x = __builtin_bit_cast(i32x4, a), y = __builtin_bit_cast(i32x4, b); return (i32x8){x[0], x[1], x[2], x[3], y[0], y[1], y[2], y[3]}; }
__device__ __forceinline__ unsigned cvt_pk_bf16(float lo, float hi) { return __builtin_bit_cast(unsigned, __builtin_convertvector((f32x2n){lo, hi}, bf16x2n)); }
template <class Epi, class Sched, bool ALIGN_EPI = false, bool SP2 = false, bool FP8 = false, bool GATHER = false>
__device__ __forceinline__ void gemm_phase(PG8_LAS unsigned char* lds, const int KB  , const Sched& S, const Epi& E, const int wid_in) {
    int lane_ = lane_fresh();
    const int wid = wid_in, lane = lane_, tid = wid * 64 + lane, wr = wid >> 2, wc = wid & 3, fr = lane & 15, fq = lane >> 4;
    const int nt = KB / (BK * 2);
    unsigned voffA[2], voffB[2];
#pragma unroll
    for (int i = 0; i < 2; ++i) { int R, C; stage_rc(tid * 16 + i * 8192, R, C); const int Rb = Epi::PERM ? ((R & ~31) + perm32(R & 31)) : R;
        voffA[i] = (unsigned)(R * KB + C * 2); voffB[i] = (unsigned)(Rb * KB + C * 2); }
    const size_t kstep = (size_t)(BK * 2);
    const size_t hstep = (size_t)HALF * KB;
    const size_t tstep = 2 * hstep;
    const unsigned ldsw = (unsigned)wid * 1024u;
    const int aoff = lds_byte(wr * 64 + fr, fq * 8), boff = lds_byte(wc * 32 + fr, fq * 8);
#define PG8_SA(b, h) (((b) * 2 + (h)) * HTB)
#define PG8_SB(b, h) ((4 + (b) * 2 + (h)) * HTB)
#define PG8_STAGE(bufoff, gbase, voff) do { _Pragma("unroll") for (int _i = 0; _i < 2; ++_i) \
        __builtin_amdgcn_global_load_lds((const unsigned*)((const char*)(gbase) + (voff)[_i]), (PG8_LAS unsigned*)(lds + (bufoff) + ldsw + _i * 8192), 16, 0, 0); } while (0)
#define PG8_STAGEV(bufoff, gbase, pair) PG8_STAGEV2(bufoff, gbase, pair)
#define PG8_STAGEV2(bufoff, gbase, v0, v1) do { \
        __builtin_amdgcn_global_load_lds((const unsigned*)((const char*)(gbase) + (v0)), (PG8_LAS unsigned*)(lds + (bufoff) + ldsw), 16, 0, 0); \
        __builtin_amdgcn_global_load_lds((const unsigned*)((const char*)(gbase) + (v1)), (PG8_LAS unsigned*)(lds + (bufoff) + ldsw + 8192), 16, 0, 0); } while (0)
#define PG8_CV(h) cvo[h][0], cvo[h][1]
#define PG8_XV(h) (last ? nvo[h][0] : cvo[h][0]), (last ? nvo[h][1] : cvo[h][1])
#define PG8_LD2(p0) __builtin_shufflevector(*(const PG8_LAS i32x4*)(p0), *(const PG8_LAS i32x4*)((p0) + 1024), 0, 1, 2, 3, 4, 5, 6, 7)
#define PG8_LO(v) __builtin_bit_cast(bf16x8, __builtin_shufflevector(v, v, 0, 1, 2, 3))
#define PG8_HI(v) __builtin_bit_cast(bf16x8, __builtin_shufflevector(v, v, 4, 5, 6, 7))
#define PG8_LDA(dst, b, h) do { _Pragma("unroll") for (int m = 0; m < 4; ++m) dst[m] = PG8_LD2(lds + PG8_SA(b, h) + aoff + m * 2048); } while (0)
#define PG8_LDB(dst, b, h) do { _Pragma("unroll") for (int n = 0; n < 2; ++n) dst[n] = PG8_LD2(lds + PG8_SB(b, h) + boff + n * 2048); } while (0)
#if defined(FP8_NONSCALED)
#define PG8_FP8MMA(C, Bv, Av) do { typedef long l4 __attribute__((ext_vector_type(4))); const l4 bq = __builtin_bit_cast(l4, Bv), aq = __builtin_bit_cast(l4, Av); _Pragma("unroll") for (int qq = 0; qq < 4; ++qq) C = __builtin_amdgcn_mfma_f32_16x16x32_fp8_fp8(bq[qq], aq[qq], C, 0, 0, 0); } while (0)
#else
#define PG8_FP8MMA(C, Bv, Av) asm volatile("v_mfma_scale_f32_16x16x128_f8f6f4 %0, %1, %2, %0, %3, %3 op_sel_hi:[0,0,0]" : "+v"(C) : "v"(Bv), "v"(Av), "v"(sc127))
#endif
#define PG8_MMA(ai, bj, At, Bt) do { __builtin_amdgcn_s_setprio(1); \
        if constexpr (FP8) { _Pragma("unroll") for (int m = 0; m < 4; ++m) _Pragma("unroll") for (int n = 0; n < 2; ++n) \
            PG8_FP8MMA(acc[ai][bj][m][n], Bt[n], At[m]); } \
        else { _Pragma("unroll") for (int m = 0; m < 4; ++m) _Pragma("unroll") for (int n = 0; n < 2; ++n) { \
            acc[ai][bj][m][n] = __builtin_amdgcn_mfma_f32_16x16x32_bf16(PG8_LO(Bt[n]), PG8_LO(At[m]), acc[ai][bj][m][n], 0, 0, 0); \
            acc[ai][bj][m][n] = __builtin_amdgcn_mfma_f32_16x16x32_bf16(PG8_HI(Bt[n]), PG8_HI(At[m]), acc[ai][bj][m][n], 0, 0, 0); } } \
        __builtin_amdgcn_s_setprio(0); } while (0)
#define PG8_WAIT_V(n) asm volatile("s_waitcnt vmcnt(" #n ")" ::: "memory")
#define PG8_WAIT_L(n) asm volatile("s_waitcnt lgkmcnt(" #n ")" ::: "memory")
#define PG8_BAR __builtin_amdgcn_s_barrier()
#define PG8_SCHED __builtin_amdgcn_sched_barrier(0)
    Unit cur, nxt; int ui = 0;
    if (!S.next(0, cur)) return;
    unsigned cvo[2][2], nvo[2][2];
#pragma unroll
    for (int h2 = 0; h2 < 2; ++h2)
#pragma unroll
        for (int i = 0; i < 2; ++i) { if constexpr (GATHER) { int R, C; stage_rc(tid * 16 + i * 8192, R, C); cvo[h2][i] = S.rowoff(0, h2 * HALF + R) + (unsigned)(C * 2); } else cvo[h2][i] = voffA[i] + (unsigned)(h2 * HALF * KB); nvo[h2][i] = cvo[h2][i]; }
    f32x4 acc[2][2][4][2];
#pragma unroll
    for (int a = 0; a < 2; ++a)
#pragma unroll
        for (int b = 0; b < 2; ++b)
#pragma unroll
            for (int m = 0; m < 4; ++m)
#pragma unroll
                for (int n = 0; n < 2; ++n) acc[a][b][m][n] = (f32x4){0.f, 0.f, 0.f, 0.f};
    int sc127 = 127; asm volatile("" : "+v"(sc127));
    i32x8 At[4], B0[2], B1[2];
    const char* cA = cur.A; const char* cB = cur.B;
    S.a_ready(cur);
    if constexpr (SP2) {
        PG8_STAGE(PG8_SB(0, 0), cB, voffB); PG8_STAGE(PG8_SB(0, 1), cB + hstep, voffB); PG8_STAGEV(PG8_SA(0, 0), cA, PG8_CV(0)); PG8_STAGEV(PG8_SA(0, 1), cA, PG8_CV(1));
        if (wr == 1) PG8_BAR;
        PG8_WAIT_V(2); PG8_BAR;
        PG8_STAGE(PG8_SB(1, 0), cB + kstep, voffB); PG8_STAGEV(PG8_SA(1, 0), cA + kstep, PG8_CV(0)); PG8_STAGE(PG8_SB(1, 1), cB + hstep + kstep, voffB);
        PG8_WAIT_V(6); PG8_BAR;
    } else {
        PG8_STAGE(PG8_SB(0, 0), cB, voffB); PG8_STAGEV(PG8_SA(0, 0), cA, PG8_CV(0)); PG8_STAGE(PG8_SB(0, 1), cB + hstep, voffB); PG8_STAGEV(PG8_SA(0, 1), cA, PG8_CV(1));
        if (wr == 1) PG8_BAR;
        PG8_WAIT_V(4); PG8_BAR;
        PG8_STAGE(PG8_SB(1, 0), cB + kstep, voffB); PG8_STAGEV(PG8_SA(1, 0), cA + kstep, PG8_CV(0)); PG8_STAGE(PG8_SB(1, 1), cB + hstep + kstep, voffB);
        PG8_WAIT_V(6); PG8_BAR;
    }
    for (;;) {
        const bool has_next = S.next(ui + 1, nxt);
        if constexpr (GATHER) { if (has_next) {
#pragma unroll
            for (int h2 = 0; h2 < 2; ++h2)
#pragma unroll
                for (int i = 0; i < 2; ++i) { int R, C; stage_rc(tid * 16 + i * 8192, R, C); nvo[h2][i] = S.rowoff(ui + 1, h2 * HALF + R) + (unsigned)(C * 2); } } }
        const char* nA = has_next ? nxt.A : cA; const char* nB = has_next ? nxt.B : cB;
#pragma unroll 1
        for (int t = 0; t < nt; t += 2) {
            const bool last = (t == nt - 2);
            const char* a1 = cA + (size_t)(t + 1) * kstep;
            const char* a2 = last ? nA : cA + (size_t)(t + 2) * kstep; const char* b2 = last ? nB : cB + (size_t)(t + 2) * kstep;
            const char* a3 = a2 + kstep; const char* b3 = b2 + kstep;
            if (last && has_next) S.a_ready(nxt);
            if constexpr (SP2) {
            PG8_LDB(B0, 0, 0); PG8_LDB(B1, 0, 1); PG8_SCHED; PG8_LDA(At, 0, 0); PG8_STAGEV(PG8_SA(1, 1), a1, PG8_CV(1));
            PG8_WAIT_V(8); PG8_WAIT_L(0); PG8_BAR; PG8_MMA(0, 0, At, B0); PG8_MMA(0, 1, At, B1); PG8_BAR; PG8_SCHED;
            PG8_LDA(At, 0, 1); PG8_STAGE(PG8_SB(0, 0), b2, voffB); PG8_STAGE(PG8_SB(0, 1), b2 + hstep, voffB); PG8_STAGEV(PG8_SA(0, 0), a2, PG8_XV(0));
            PG8_WAIT_V(8); PG8_WAIT_L(0); PG8_BAR; PG8_MMA(1, 0, At, B0); PG8_MMA(1, 1, At, B1); PG8_BAR; PG8_SCHED;
            PG8_LDB(B0, 1, 0); PG8_LDB(B1, 1, 1); PG8_SCHED; PG8_LDA(At, 1, 0); PG8_STAGEV(PG8_SA(0, 1), a2, PG8_XV(1));
            PG8_WAIT_V(8); PG8_WAIT_L(0); PG8_BAR; PG8_MMA(0, 0, At, B0); PG8_MMA(0, 1, At, B1); PG8_BAR; PG8_SCHED;
            PG8_LDA(At, 1, 1); PG8_STAGE(PG8_SB(1, 0), b3, voffB); PG8_STAGE(PG8_SB(1, 1), b3 + hstep, voffB); PG8_STAGEV(PG8_SA(1, 0), a3, PG8_XV(0));
            PG8_WAIT_V(8); PG8_WAIT_L(0); PG8_BAR; PG8_MMA(1, 0, At, B0); PG8_MMA(1, 1, At, B1); PG8_BAR; PG8_SCHED;
            } else {
            PG8_LDB(B0, 0, 0); PG8_SCHED; PG8_LDA(At, 0, 0); PG8_STAGEV(PG8_SA(1, 1), a1, PG8_CV(1));
            PG8_WAIT_L(8); PG8_BAR; PG8_WAIT_L(0); PG8_MMA(0, 0, At, B0); PG8_BAR; PG8_SCHED;
            PG8_LDB(B1, 0, 1); PG8_STAGE(PG8_SB(0, 0), b2, voffB);
            PG8_BAR; PG8_WAIT_L(0); PG8_MMA(0, 1, At, B1); PG8_BAR;
            PG8_LDA(At, 0, 1); PG8_STAGEV(PG8_SA(0, 0), a2, PG8_XV(0));
            PG8_BAR; PG8_WAIT_L(0); PG8_MMA(1, 0, At, B0); PG8_BAR; PG8_SCHED;
            PG8_STAGE(PG8_SB(0, 1), b2 + hstep, voffB);
            PG8_WAIT_V(6); PG8_BAR; PG8_MMA(1, 1, At, B1); PG8_BAR;
            PG8_LDB(B0, 1, 0); PG8_SCHED; PG8_LDA(At, 1, 0); PG8_STAGEV(PG8_SA(0, 1), a2, PG8_XV(1));
            PG8_WAIT_L(8); PG8_BAR; PG8_WAIT_L(0); PG8_MMA(0, 0, At, B0); PG8_BAR; PG8_SCHED;
            PG8_LDB(B1, 1, 1); PG8_STAGE(PG8_SB(1, 0), b3, voffB);
            PG8_BAR; PG8_WAIT_L(0); PG8_MMA(0, 1, At, B1); PG8_BAR;
            PG8_LDA(At, 1, 1); PG8_STAGEV(PG8_SA(1, 0), a3, PG8_XV(0));
            PG8_BAR; PG8_WAIT_L(0); PG8_MMA(1, 0, At, B0); PG8_BAR; PG8_SCHED;
            PG8_STAGE(PG8_SB(1, 1), b3 + hstep, voffB);
            PG8_WAIT_V(6); PG8_BAR; PG8_MMA(1, 1, At, B1); PG8_BAR;
            }
        }
        if constexpr (ALIGN_EPI) { if (wr == 0) PG8_BAR; }
        if constexpr (FP8) asm volatile("s_nop 15\n\ts_nop 15" ::: "memory");
        if constexpr (!Epi::AFTER_DRAIN) { int le_ = lane_fresh();
            E(acc, cur, wr, wc, le_ & 15, le_ >> 4); S.done(cur); }
        if (!has_next) break;
#pragma unroll
        for (int a = 0; a < 2; ++a)
#pragma unroll
            for (int b = 0; b < 2; ++b)
#pragma unroll
                for (int m = 0; m < 4; ++m)
#pragma unroll
                    for (int n = 0; n < 2; ++n) acc[a][b][m][n] = (f32x4){0.f, 0.f, 0.f, 0.f};
        cur = nxt; cA = nA; cB = nB; ++ui;
#pragma unroll
        for (int h2 = 0; h2 < 2; ++h2)
#pragma unroll
            for (int i = 0; i < 2; ++i) cvo[h2][i] = nvo[h2][i];
        if constexpr (ALIGN_EPI) { if (wr == 1) PG8_BAR; }
    }
    PG8_WAIT_V(0);
    if constexpr (!ALIGN_EPI) { if (wr == 0) PG8_BAR; }
    PG8_BAR;
    if constexpr (Epi::AFTER_DRAIN) { E.fused(acc, cur, wr, wc, fr, fq, lds, wid, lane); S.done(cur); }
#undef PG8_SA
#undef PG8_SB
#undef PG8_STAGE
#undef PG8_LDA
#undef PG8_LDB
#undef PG8_MMA
#undef PG8_WAIT_V
#undef PG8_WAIT_L
#undef PG8_BAR
#undef PG8_SCHED
}
}


#ifndef SWA_FAST
#define SWA_FAST 1
#endif
#ifndef G1_FP8
#define G1_FP8 1
#endif
#ifndef GDN_FAST
#define GDN_FAST 1
#endif
constexpr int D = 1024, BATCH = 32, SEQ = 2048, NMETA = 16, CIN = 7696;
constexpr int NG = 4, TSL = SEQ / NG, TOK = BATCH * TSL;
constexpr int C_QG = 0, C_KG = 1024, C_VG = 2048, C_ZG = 3072, C_BG = 4096, C_AG = 4104, C_QS = 4112, C_KS = 5136, C_VS = 5392, C_GG = 5648, C_GS = 6672;
constexpr int N1 = 7936;
constexpr int NEXP = 32, TOPK = 4, DFF = 1024, NHG = 8, NHQ = 16, NHK = 4;
constexpr int NP = 4, TOKP = NP * TOK;
constexpr int NASG = TOKP * TOPK, MAXROWS = NASG + NEXP * 256, MAXTILES = MAXROWS / 256;
constexpr float LN_EPS = 1e-5f, RMS_EPS = 1e-6f;
constexpr float DN_ALPHA = 1.189207115002721f;
constexpr int NWAVES = 8, NTHR = 512;
constexpr size_t MiB = 1u << 20;
constexpr size_t WS_CTL = 0, CTL_ZERO_BYTES = 64 * 1024;
constexpr size_t WS_PM = 1 * MiB, WS_WRT = 1 * MiB + 512 * 1024  , WS_S1 = 2 * MiB, WS_WIN = 3 * MiB, WS_WBG = 19 * MiB, WS_WBS = 21 * MiB, WS_WOUT = 23 * MiB, WS_W1 = 26 * MiB, WS_W2 = 152 * MiB;
static_assert(WS_WIN + (size_t)N1 * D * 2 <= WS_WBG && WS_WOUT + 2 * MiB <= WS_W1 && WS_W1 + 64 * MiB <= WS_W2, "weight copies overlap");
constexpr size_t WS_H0Q = 216 * MiB;
constexpr size_t WS_TOPI = 232 * MiB, WS_TOPW = 233 * MiB, WS_RANK = 234 * MiB;
constexpr size_t WS_ROWW = 249 * MiB, WS_BETA = 250 * MiB, WS_LOGG = WS_BETA + 512 * 1024;
constexpr size_t GR = 252 * MiB;
constexpr size_t WS_H0 = GR, WS_QKVG = GR + 32 * MiB, WS_ZS = GR + 128 * MiB, WS_QS = GR + 160 * MiB;
constexpr size_t WS_SG = GR + 192 * MiB, WS_SS = GR + 224 * MiB, WS_OG = GR + 256 * MiB, WS_OSW = GR + 288 * MiB, WS_Y = WS_ZS, WS_PRE1 = WS_QKVG;
constexpr size_t WS_IMG_BASE = GR + 320 * MiB;
constexpr size_t WS_KSF = GR + 464 * MiB, WS_VSF = GR + 496 * MiB, WS_SC = GR + 528 * MiB, WS_HALO = GR + 544 * MiB;
constexpr size_t WS_H1 = GR + 546 * MiB;
constexpr size_t WS_H1Q = GR + 674 * MiB;
constexpr size_t WS_RTOK = GR + 738 * MiB, WS_RWW = GR + 746 * MiB;
constexpr size_t WS_END = GR + 754 * MiB;
constexpr size_t WS_XS = GR, WS_HID = GR, WS_YS = GR + 264 * MiB;
static_assert(WS_HID + (size_t)MAXROWS * DFF <= WS_YS && WS_YS + (size_t)MAXROWS * D <= WS_H1 && WS_HALO + 2 * MiB <= WS_H1, "moe row buffers overlay only dead buffers");
static_assert((size_t)TOKP * TOPK * 4 <= MiB && (size_t)NEXP * TOKP * 4 <= 8 * MiB && (size_t)TOKP * D * 2 <= 128 * MiB, "routing tables");
constexpr int CW_TMO = 0, CW_BAR = 4096, CW_CNT = 8192;
constexpr int RING_BYTES = 131072, MISC_OFF = 143360, LDS_BYTES = 147456;
constexpr int MI_OFF = 16, MI_CNT = 64, MI_LCNT = 96, MI_LBASE = 128, MI_TE = 160, MI_TE_CAP = (LDS_BYTES - MISC_OFF) / 4 - MI_TE;
static_assert((size_t)NMETA * CIN * 4 <= 512 * 1024 && MAXTILES * 8 <= 2 * 17 * 256 && MI_TE_CAP * 4 >= MAXTILES && TOKP <= 65536, "proj_meta fits below the router weight copy; at most 2 x 17 MoE up-projection units per workgroup; byte tile table fits the LDS MISC words; token rows fit 16 bits");

#define GAS __attribute__((address_space(1)))
#define LAS __attribute__((address_space(3)))
typedef unsigned short bf16_t;
typedef float f32x4 __attribute__((ext_vector_type(4)));
typedef float f32x2 __attribute__((ext_vector_type(2)));
typedef unsigned u32x4 __attribute__((ext_vector_type(4)));
typedef unsigned u32x2 __attribute__((ext_vector_type(2)));
#define LDS_WAIT() asm volatile("s_waitcnt lgkmcnt(0)" ::: "memory")
#define VM_WAIT() asm volatile("s_waitcnt vmcnt(0)" ::: "memory")
__device__ __forceinline__ unsigned f2bf(float f) { unsigned u = __builtin_bit_cast(unsigned, f); return (u + 0x7fffu + ((u >> 16) & 1u)) >> 16; }
__device__ __forceinline__ unsigned pk2(float lo, float hi) { return f2bf(lo) | (f2bf(hi) << 16); }
__device__ __forceinline__ float bflo(unsigned w) { return __builtin_bit_cast(float, w << 16); }
__device__ __forceinline__ float bfhi(unsigned w) { return __builtin_bit_cast(float, w & 0xffff0000u); }
__device__ __forceinline__ float bf1(bf16_t h) { return __builtin_bit_cast(float, (unsigned)h << 16); }
__device__ __forceinline__ float fexp(float x) { return __builtin_amdgcn_exp2f(x * 1.4426950408889634f); }
__device__ __forceinline__ float frcp(float x) { return __builtin_amdgcn_rcpf(x); }
__device__ __forceinline__ float frsq(float x) { return __builtin_amdgcn_rsqf(x); }
__device__ __forceinline__ float sigmoidf_(float x) { return frcp(1.0f + fexp(-x)); }
__device__ __forceinline__ float siluf_(float x) { return x * frcp(1.0f + fexp(-x)); }
__device__ __forceinline__ float softplusf_(float x) { const float e = fexp(-fabsf(x)); const float l = e < 1e-3f ? e * (1.0f - 0.5f * e) : __builtin_amdgcn_logf(1.0f + e) * 0.6931471805599453f; return fmaxf(x, 0.f) + l; }
__device__ __forceinline__ float wave_sum(float v) { v += sx<1>(v); v += sx<2>(v); v += sx<4>(v); v += sx<8>(v); v += sx<16>(v); v += sx<32>(v); return v; }

#define XB_TMO      128
#define XB_XCNT(j)  (256  + 64 * (j))
#define XB_XSUB(j)  (1280 + 64 * (j))
#define XB_XGEN(j)  (2304 + 64 * (j))
#define XB_TOP      3328
#define XB_TOPGEN   3392
#define XCD_BAR_WORDS 3456
#define XB_SPIN_CAP (1u << 18)
__device__ __forceinline__ unsigned xb_ld(unsigned* p)              { return __hip_atomic_load(p, __ATOMIC_RELAXED, __HIP_MEMORY_SCOPE_AGENT); }
__device__ __forceinline__ unsigned xb_add(unsigned* p, unsigned v) { return __hip_atomic_fetch_add(p, v, __ATOMIC_RELAXED, __HIP_MEMORY_SCOPE_AGENT); }
__device__ __forceinline__ unsigned xb_xcc_id() { return (unsigned)__builtin_amdgcn_s_getreg((3 << 11) | 20) & 0xFu; }
#define XB_SPIN(cond, bar) do { unsigned _sp = 0; while (cond) { __builtin_amdgcn_s_sleep(1); \
    if ((++_sp & 255u) == 0u) { if (xb_ld(&(bar)[XB_TMO])) break; if (_sp > XB_SPIN_CAP) { atomicAdd(&(bar)[XB_TMO], 1u); break; } } } } while (0)
struct XcdBarrier { unsigned* bar; unsigned x; volatile LAS unsigned* st; };
__device__ __forceinline__ XcdBarrier xcd_barrier_post(unsigned* bar, volatile LAS unsigned* st, bool leader) {
    XcdBarrier b; b.bar = bar; b.x = xb_xcc_id(); b.st = st;
    if (leader) (void)xb_add(&bar[XB_XCNT(b.x)], 1u);
    return b;
}
__device__ __forceinline__ void xcd_barrier_complete(unsigned* bar, unsigned x, unsigned& nloc, unsigned& nx) {
    const unsigned G = gridDim.x * gridDim.y * gridDim.z;
    unsigned sum, cnt, mine, sp = 0u;
    for (;;) {
        sum = 0u; cnt = 0u; mine = 0u;
#pragma unroll
        for (unsigned j = 0; j < 16; ++j) { const unsigned c = xb_ld(&bar[XB_XCNT(j)]); sum += c; cnt += (c > 0u) ? 1u : 0u; mine = (j == x) ? c : mine; }
        if (sum == G) break;
        __builtin_amdgcn_s_sleep(1);
        if ((++sp & 255u) == 0u) { if (xb_ld(&bar[XB_TMO])) break; if (sp > XB_SPIN_CAP) { atomicAdd(&bar[XB_TMO], 1u); break; } }
    }
    nloc = mine > 0u ? mine : 1u; nx = cnt > 0u ? cnt : 1u;
}
__device__ __forceinline__ void xcd_barrier(const XcdBarrier& b, bool leader) {
    asm volatile("s_waitcnt vmcnt(0)" ::: "memory");
    __syncthreads();
    if (leader) {
        unsigned* bar = b.bar;
        __builtin_amdgcn_s_waitcnt(0);
        unsigned nloc = b.st[0], nx = b.st[1];
        if (nloc == 0u) { xcd_barrier_complete(bar, b.x, nloc, nx); b.st[0] = nloc; b.st[1] = nx; }
        const unsigned old = xb_add(&bar[XB_XSUB(b.x)], 1u);
        const unsigned gen = old / nloc;
        if (old + 1u == (gen + 1u) * nloc) {
            __builtin_amdgcn_fence(__ATOMIC_RELEASE, "agent");
            asm volatile("s_waitcnt vmcnt(0)" ::: "memory");
            const unsigned og = xb_add(&bar[XB_TOP], 1u);
            const unsigned tg = og / nx;
            if (og + 1u == (tg + 1u) * nx) xb_add(&bar[XB_TOPGEN], 1u);
            else XB_SPIN(xb_ld(&bar[XB_TOPGEN]) == tg, bar);
            __builtin_amdgcn_fence(__ATOMIC_ACQUIRE, "agent");
            xb_add(&bar[XB_XGEN(b.x)], 1u);
            asm volatile("s_waitcnt vmcnt(0)" ::: "memory");
        } else {
            XB_SPIN(xb_ld(&bar[XB_XGEN(b.x)]) == gen, bar);
            __builtin_amdgcn_fence(__ATOMIC_ACQUIRE, "agent");
            asm volatile("s_waitcnt vmcnt(0)" ::: "memory");
        }
    }
    __syncthreads();
}

struct P { const float* in[23]; float* out; unsigned char* ws; int ph_lo, ph_hi; };
enum { I_X = 0, I_META, I_ELG, I_ELB, I_WIN, I_CONVW, I_ALOG, I_DTB, I_GNW, I_SINK, I_WBG, I_WBS, I_WOUT, I_L1G, I_L1B, I_WR, I_BR, I_W1, I_B1, I_W2, I_B2, I_L2G, I_L2B };
#ifndef AMP_MASK
#define AMP_MASK 0
#endif
#ifndef AMP_F
#define AMP_F 4
#endif
#define AMP_BEGIN(j) unsigned long long amp_t0 = 0; if ((AMP_MASK >> (j)) & 1) amp_t0 = __builtin_amdgcn_s_memrealtime();
#define AMP_END(j) if ((AMP_MASK >> (j)) & 1) { const unsigned long long amp_t1 = __builtin_amdgcn_s_memrealtime(); const unsigned long long amp_d = (amp_t1 - amp_t0) * AMP_F; while (__builtin_amdgcn_s_memrealtime() - amp_t1 < amp_d) __builtin_amdgcn_s_sleep(16); }

__device__ __forceinline__ void std_tile(int L, int nwg, int nM, int nN, int& pm, int& pn) {
    int wgid = L; { const int q = nwg / pg8::NXCD, r = nwg % pg8::NXCD, xcd = wgid % pg8::NXCD, off = wgid / pg8::NXCD; wgid = (xcd < r ? xcd * (q + 1) : r * (q + 1) + (xcd - r) * q) + off; }
    const int nig = pg8::WGM * nN, gid = wgid / nig, fm = gid * pg8::WGM, gsz = (nM - fm) < pg8::WGM ? (nM - fm) : pg8::WGM;
    pm = fm + ((wgid % nig) % gsz); pn = (wgid % nig) / gsz;
}
__device__ __forceinline__ int xcd_chunk(int L, int nwg) {
    const int q = nwg / pg8::NXCD, r = nwg % pg8::NXCD, xcd = L % pg8::NXCD, off = L / pg8::NXCD; return (xcd < r ? xcd * (q + 1) : r * (q + 1) + (xcd - r) * q) + off;
}
struct SchedStd {
    int nM, nN, nwg, G, c; const char* A; const char* B; size_t tstep;
    __device__ __forceinline__ void init(int M, int N, int KB, int G_, int c_, const void* A_, const void* B_) { nM = M / 256; nN = N / 256; nwg = nM * nN; G = G_; c = c_; A = (const char*)A_; B = (const char*)B_; tstep = (size_t)256 * KB; }
    __device__ __forceinline__ bool next(int i, pg8::Unit& u) const {
        const int L = i * G + c; if (L >= nwg) return false;
        int pm, pn; std_tile(L, nwg, nM, nN, pm, pn);
        u.pm = pm; u.pn = pn; u.e = 0; u.kind = 0; u.A = A + (size_t)pm * tstep; u.B = B + (size_t)pn * tstep; return true;
    }
    __device__ __forceinline__ void a_ready(const pg8::Unit&) const {}
    __device__ __forceinline__ void done(const pg8::Unit&) const {}
    __device__ __forceinline__ unsigned rowoff(int, int) const { return 0u; }
};
struct SchedPair {
    int nM, nN, nwg, G, c; const char *A0, *B0, *A1, *B1; size_t tstep;
    __device__ __forceinline__ void init(int M, int N, int KB, int G_, int c_, const void* A0_, const void* B0_, const void* A1_, const void* B1_) { nM = M / 256; nN = N / 256; nwg = nM * nN; G = G_; c = c_;
        A0 = (const char*)A0_; B0 = (const char*)B0_; A1 = (const char*)A1_; B1 = (const char*)B1_; tstep = (size_t)256 * KB; }
    __device__ __forceinline__ bool next(int i, pg8::Unit& u) const {
        const int L = (i >> 1) * G + c, kind = i & 1; if (L >= nwg) return false;
        int pm, pn; std_tile(L, nwg, nM, nN, pm, pn);
        u.pm = pm; u.pn = pn; u.e = 0; u.kind = kind; u.A = (kind ? A1 : A0) + (size_t)pm * tstep; u.B = (kind ? B1 : B0) + (size_t)pn * tstep; return true;
    }
    __device__ __forceinline__ void a_ready(const pg8::Unit&) const {}
    __device__ __forceinline__ void done(const pg8::Unit&) const {}
    __device__ __forceinline__ unsigned rowoff(int, int) const { return 0u; }
};
struct SchedMoe {
    int nN, nwg, G, c, i0, ni; const char* A; const char* W; size_t tstep, wexp; const volatile LAS unsigned char* te;
    __device__ __forceinline__ void init(int ntiles, int N, int KB, int G_, int c_, const void* A_, const void* W_, const volatile LAS unsigned* te_) { nN = N / 256; nwg = ntiles * nN; G = G_; c = c_; i0 = 0; ni = 1 << 20;
        A = (const char*)A_; W = (const char*)W_; tstep = (size_t)256 * KB; wexp = (size_t)N * KB; te = (const volatile LAS unsigned char*)te_; }
    __device__ __forceinline__ bool next(int i, pg8::Unit& u) const {
        const int L = (i + i0) * G + c; if (i >= ni || L >= nwg) return false;
        const int w = xcd_chunk(L, nwg), rt = w / nN, pn = w - rt * nN; const int e = __builtin_amdgcn_readfirstlane((int)te[rt]);
        u.pm = rt; u.pn = pn; u.e = e; u.kind = 0; u.A = A + (size_t)rt * tstep; u.B = W + (size_t)e * wexp + (size_t)pn * tstep; return true;
    }
    __device__ __forceinline__ void a_ready(const pg8::Unit&) const {}
    __device__ __forceinline__ void done(const pg8::Unit&) const {}
    __device__ __forceinline__ unsigned rowoff(int, int) const { return 0u; }
};

struct SchedMoeG : SchedMoe {
    const volatile LAS unsigned short* tokt;
    __device__ __forceinline__ bool next(int i, pg8::Unit& u) const { const bool ok = SchedMoe::next(i, u); if (ok) u.A = A; return ok; }
    __device__ __forceinline__ unsigned rowoff(int i, int Rg) const { return (unsigned)tokt[i * 256 + Rg] * (unsigned)D; }
};
using pg8::Unit;
typedef pg8::f32x4 (AccT)[2][2][4][2];
__device__ __forceinline__ u32x4 pack8(f32x4 v0, f32x4 v1) { u32x4 w; w.x = pg8::cvt_pk_bf16(v0[0], v0[1]); w.y = pg8::cvt_pk_bf16(v0[2], v0[3]); w.z = pg8::cvt_pk_bf16(v1[0], v1[1]); w.w = pg8::cvt_pk_bf16(v1[2], v1[3]); return w; }
__device__ __forceinline__ void unpack8(u32x4 w, f32x4& v0, f32x4& v1) { v0 = (f32x4){bflo(w.x), bfhi(w.x), bflo(w.y), bfhi(w.y)}; v1 = (f32x4){bflo(w.z), bfhi(w.z), bflo(w.w), bfhi(w.w)}; }
__device__ __forceinline__ unsigned pack4_fp8(float a, float b, float c2, float d) { int w = __builtin_amdgcn_cvt_pk_fp8_f32(a, b, 0, false); w = __builtin_amdgcn_cvt_pk_fp8_f32(c2, d, w, true); return (unsigned)w; }
constexpr float W8_SCALE = 64.0f, W8_INV = 1.0f / 64.0f, YS_SCALE = 64.0f, YS_INV = 1.0f / 64.0f;
struct EpiG1 {
    static constexpr bool PERM = true, AFTER_DRAIN = false;
    bf16_t *qkvg, *zs, *qs, *ks, *vs, *sg, *ss; int g;
    float asc;
    float *beta, *logg; const float *alog, *dtb;
    __device__ __forceinline__ void operator()(const AccT& acc, const Unit& u, int wr, int wc, int fr, int fq) const {
        if (u.pn == 30) {
            if (wc == 0 && fq < 2) {
                float ea[8], db[8];
#pragma unroll
                for (int h = 0; h < 8; ++h) { ea[h] = alog[h]; db[h] = dtb[h]; }
#pragma unroll
                for (int h = 0; h < 8; ++h) ea[h] = -fexp(ea[h]);
#pragma unroll
                for (int ai = 0; ai < 2; ++ai)
#pragma unroll
                    for (int m = 0; m < 4; ++m) { const size_t r = (size_t)(u.pm * 256 + ai * 128 + wr * 64 + m * 16 + fr);
#pragma unroll
                        for (int n = 0; n < 2; ++n) { f32x4 o;
#pragma unroll
                            for (int i = 0; i < 4; ++i) { const int h = 4 * n + i; const float x = acc[ai][0][m][n][i] * asc; o[i] = fq == 0 ? sigmoidf_(x) : ea[h] * softplusf_(x + db[h]); }
                            *(f32x4*)((fq == 0 ? beta : logg) + r * 8 + 4 * n) = o; } } }
            return; }
        const int pn = u.pn; bf16_t* base; int ldc, colt, act = 0; float sc = 1.f; const bool kv = (pn == 20 || pn == 21);
        if (pn < 12) { base = qkvg; ldc = 3072; colt = pn * 256; }
        else if (pn < 16) { base = zs; ldc = 1024; colt = (pn - 12) * 256; act = 1; }
        else if (pn < 20) { base = qs; ldc = 1024; colt = (pn - 16) * 256; sc = 0.125f * 1.4426950408889634f; }
        else if (pn == 20) { base = ks; ldc = 256; colt = 0; }
        else if (pn == 21) { base = vs; ldc = 256; colt = 0; }
        else if (pn < 26) { base = sg; ldc = 1024; colt = (pn - 22) * 256; act = 2; }
        else { base = ss; ldc = 1024; colt = (pn - 26) * 256; act = 2; }
        const int row0 = u.pm * 256 + wr * 64 + fr, col0 = colt + wc * 32 + 8 * fq; const float asc_sc = asc * sc, nl2e_asc = -1.4426950408889634f * asc;
#pragma unroll
        for (int ai = 0; ai < 2; ++ai)
#pragma unroll
            for (int m = 0; m < 4; ++m) { const int r = row0 + ai * 128 + m * 16, rr = kv ? ((r >> 9) * SEQ + g * TSL + (r & (TSL - 1))) : r; bf16_t* rowp = base + (size_t)rr * ldc + col0;
#pragma unroll
                for (int bj = 0; bj < 2; ++bj) { f32x4 v0, v1;
                    if (act == 0) { v0 = acc[ai][bj][m][0] * asc_sc; v1 = acc[ai][bj][m][1] * asc_sc; }
                    else {
#pragma unroll
                        for (int n = 0; n < 2; ++n)
#pragma unroll
                            for (int hh = 0; hh < 2; ++hh) { const f32x2 a = {acc[ai][bj][m][n][2 * hh], acc[ai][bj][m][n][2 * hh + 1]};
                                f32x2 t = a * nl2e_asc; t.x = __builtin_amdgcn_exp2f(t.x); t.y = __builtin_amdgcn_exp2f(t.y); t = t + 1.0f; t.x = __builtin_amdgcn_rcpf(t.x); t.y = __builtin_amdgcn_rcpf(t.y);
                                if (act == 1) t = t * (a * asc);
                                if (n == 0) { v0[2 * hh] = t.x; v0[2 * hh + 1] = t.y; } else { v1[2 * hh] = t.x; v1[2 * hh + 1] = t.y; } } }
                    *(u32x4*)(rowp + bj * 128) = pack8(v0, v1); } }
    }
};
struct EpiBr {
    static constexpr bool PERM = true, AFTER_DRAIN = false;
    const bf16_t *sg, *ss; bf16_t* y;
    template <bool K1>
    __device__ __forceinline__ void body(const AccT& acc, const bf16_t* __restrict__ gate, const bf16_t* yin, bf16_t* yout, const int row0, const int col0) const {
#pragma unroll
        for (int ai = 0; ai < 2; ++ai) { u32x4 gv[4][2], yv[4][2];
#pragma unroll
            for (int m = 0; m < 4; ++m) { const size_t off = (size_t)(row0 + ai * 128 + m * 16) * D + col0;
#pragma unroll
                for (int bj = 0; bj < 2; ++bj) { gv[m][bj] = *(const u32x4*)(gate + off + bj * 128); if constexpr (K1) yv[m][bj] = *(const u32x4*)(yin + off + bj * 128); } }
#pragma unroll
            for (int m = 0; m < 4; ++m) { const size_t off = (size_t)(row0 + ai * 128 + m * 16) * D + col0;
#pragma unroll
                for (int bj = 0; bj < 2; ++bj) { f32x4 g0, g1; unpack8(gv[m][bj], g0, g1);
                    f32x4 v0 = acc[ai][bj][m][0] * g0, v1 = acc[ai][bj][m][1] * g1;
                    if constexpr (K1) { f32x4 y0, y1; unpack8(yv[m][bj], y0, y1); v0 = v0 + y0; v1 = v1 + y1; }
                    *(u32x4*)(yout + off + bj * 128) = pack8(v0, v1); } } }
    }
    __device__ __forceinline__ void operator()(const AccT& acc, const Unit& u, int wr, int wc, int fr, int fq) const {
        const int row0 = u.pm * 256 + wr * 64 + fr, col0 = u.pn * 256 + wc * 32 + 8 * fq;
        if (u.kind) body<true>(acc, ss, y, y, row0, col0); else body<false>(acc, sg, y, y, row0, col0);
    }
};
struct EpiOut {
    static constexpr bool PERM = true, AFTER_DRAIN = false;
    const bf16_t* h0; bf16_t* pre1;
    __device__ __forceinline__ void operator()(const AccT& acc, const Unit& u, int wr, int wc, int fr, int fq) const {
        const int row0 = u.pm * 256 + wr * 64 + fr, col0 = u.pn * 256 + wc * 32 + 8 * fq;
#pragma unroll
        for (int ai = 0; ai < 2; ++ai) { u32x4 hv[4][2];
#pragma unroll
            for (int m = 0; m < 4; ++m) { const size_t off = (size_t)(row0 + ai * 128 + m * 16) * D + col0;
#pragma unroll
                for (int bj = 0; bj < 2; ++bj) hv[m][bj] = *(const u32x4*)(h0 + off + bj * 128); }
#pragma unroll
            for (int m = 0; m < 4; ++m) { const size_t off = (size_t)(row0 + ai * 128 + m * 16) * D + col0;
#pragma unroll
                for (int bj = 0; bj < 2; ++bj) { f32x4 h0a, h0b; unpack8(hv[m][bj], h0a, h0b);
                    *(u32x4*)(pre1 + off + bj * 128) = pack8(h0a * DN_ALPHA + acc[ai][bj][m][0], h0b * DN_ALPHA + acc[ai][bj][m][1]); } } }
    }
};
struct EpiMoe1 {
    static constexpr bool PERM = true, AFTER_DRAIN = false;
    const float* b1; unsigned char* hid;
    __device__ __forceinline__ void operator()(const AccT& acc, const Unit& u, int wr, int wc, int fr, int fq) const {
        const int row0 = u.pm * 256 + wr * 64 + fr, j0 = u.pn * 128 + wc * 32 + 8 * fq; const float* bb = b1 + (size_t)u.e * 2048 + j0;
        f32x2 bg[4], bu[4];
#pragma unroll
        for (int k = 0; k < 4; ++k) { bg[k] = *(const f32x2*)(bb + 2 * k); bu[k] = *(const f32x2*)(bb + 1024 + 2 * k) + 1.0f; }
#pragma unroll
        for (int ai = 0; ai < 2; ++ai)
#pragma unroll
            for (int m = 0; m < 4; ++m) { f32x2 o[4];
#pragma unroll
                for (int k = 0; k < 4; ++k) { const int n = k >> 1, j = (k & 1) * 2;
                    const f32x2 ga = {acc[ai][0][m][n][j], acc[ai][0][m][n][j + 1]}, ua = {acc[ai][1][m][n][j], acc[ai][1][m][n][j + 1]};
                    f32x2 g = ga * W8_INV + bg[k], up = ua * W8_INV + bu[k];
                    g.x = fminf(g.x, 7.0f); g.y = fminf(g.y, 7.0f);
                    up.x = __builtin_amdgcn_fmed3f(up.x, -6.0f, 8.0f); up.y = __builtin_amdgcn_fmed3f(up.y, -6.0f, 8.0f);
                    f32x2 t = g * (-1.702f * 1.4426950408889634f);
                    t.x = __builtin_amdgcn_exp2f(t.x); t.y = __builtin_amdgcn_exp2f(t.y);
                    t = t + 1.0f;
                    t.x = __builtin_amdgcn_rcpf(t.x); t.y = __builtin_amdgcn_rcpf(t.y);
                    o[k] = (g * t) * up; }
                u32x2 w8; w8.x = pack4_fp8(o[0].x, o[0].y, o[1].x, o[1].y); w8.y = pack4_fp8(o[2].x, o[2].y, o[3].x, o[3].y);
                *(u32x2*)(hid + (size_t)(row0 + ai * 128 + m * 16) * DFF + j0) = w8; }
    }
};
struct EpiMoe2 {
    static constexpr bool PERM = true, AFTER_DRAIN = false;
    const float* b2; const float* rww; unsigned char* ys; const volatile LAS unsigned* misc;
    __device__ __forceinline__ void operator()(const AccT& acc, const Unit& u, int wr, int wc, int fr, int fq) const {
        const int row0 = u.pm * 256 + wr * 64 + fr, col0 = u.pn * 256 + wc * 32 + 8 * fq; const float* bb = b2 + (size_t)u.e * D + col0;
        f32x4 bv[2][2];
#pragma unroll
        for (int bj = 0; bj < 2; ++bj)
#pragma unroll
            for (int n = 0; n < 2; ++n) bv[bj][n] = *(const f32x4*)(bb + bj * 128 + 4 * n);
        const unsigned eoff = misc[MI_OFF + u.e], ecnt = misc[MI_CNT + u.e]; const float* rwe = rww + (size_t)u.e * TOKP;
        float wv[2][4];
#pragma unroll
        for (int ai = 0; ai < 2; ++ai)
#pragma unroll
            for (int m = 0; m < 4; ++m) { const unsigned pos = (unsigned)(row0 + ai * 128 + m * 16) - eoff; wv[ai][m] = rwe[pos < ecnt ? pos : 0u]; }
#pragma unroll
        for (int ai = 0; ai < 2; ++ai)
#pragma unroll
            for (int m = 0; m < 4; ++m) { const int row = row0 + ai * 128 + m * 16; const unsigned pos = (unsigned)row - eoff;
                const float w64 = pos < ecnt ? wv[ai][m] * YS_SCALE : 0.f;
#pragma unroll
                for (int bj = 0; bj < 2; ++bj) { const f32x4 v0 = (acc[ai][bj][m][0] * W8_INV + bv[bj][0]) * w64, v1 = (acc[ai][bj][m][1] * W8_INV + bv[bj][1]) * w64;
                    u32x2 o8; o8.x = pack4_fp8(v0[0], v0[1], v0[2], v0[3]); o8.y = pack4_fp8(v1[0], v1[1], v1[2], v1[3]); *(u32x2*)(ys + (size_t)row * D + col0 + bj * 128) = o8; } }
    }
};

struct Ctx { LAS unsigned char* lds; volatile LAS unsigned* MISC; int tid, lane, wave, G, gw, NGW; unsigned char* ws; };

__device__ __forceinline__ void transpose_item(const float* W, int ldw, int k0, int srccol, bf16_t* WT, int ldt, int dstrow, LAS float* scr, int lane) {
    float wv_[32];
#pragma unroll
    for (int i = 0; i < 32; ++i) { const int kk = 2 * i + (lane >> 5); wv_[i] = W[(size_t)(k0 + kk) * ldw + srccol + (lane & 31)]; }
#pragma unroll
    for (int i = 0; i < 32; ++i) { const int kk = 2 * i + (lane >> 5); scr[kk * 33 + (lane & 31)] = wv_[i]; }
    LDS_WAIT(); asm volatile("" ::: "memory");
    const int c = lane & 7;
#pragma unroll
    for (int j = 0; j < 4; ++j) { const int n = (lane >> 3) + 8 * j; const LAS float* s = scr + (8 * c) * 33 + n;
        u32x4 o; o.x = pk2(s[0 * 33], s[1 * 33]); o.y = pk2(s[2 * 33], s[3 * 33]); o.z = pk2(s[4 * 33], s[5 * 33]); o.w = pk2(s[6 * 33], s[7 * 33]);
        *(u32x4*)(WT + (size_t)(dstrow + n) * ldt + k0 + 8 * c) = o; }
    LDS_WAIT(); asm volatile("" ::: "memory");
}
__device__ __forceinline__ void transpose_item8(const float* W, int ldw, int k0, int srccol, unsigned char* WT, int ldt, int dstrow, LAS float* scr, int lane) {
    float wv_[32];
#pragma unroll
    for (int i = 0; i < 32; ++i) { const int kk = 2 * i + (lane >> 5); wv_[i] = W[(size_t)(k0 + kk) * ldw + srccol + (lane & 31)]; }
#pragma unroll
    for (int i = 0; i < 32; ++i) { const int kk = 2 * i + (lane >> 5); scr[kk * 33 + (lane & 31)] = wv_[i]; }
    LDS_WAIT(); asm volatile("" ::: "memory");
    const int c = lane & 7;
#pragma unroll
    for (int j = 0; j < 4; ++j) { const int n = (lane >> 3) + 8 * j; const LAS float* s = scr + (8 * c) * 33 + n;
        u32x2 o; o.x = pack4_fp8(s[0 * 33] * W8_SCALE, s[1 * 33] * W8_SCALE, s[2 * 33] * W8_SCALE, s[3 * 33] * W8_SCALE); o.y = pack4_fp8(s[4 * 33] * W8_SCALE, s[5 * 33] * W8_SCALE, s[6 * 33] * W8_SCALE, s[7 * 33] * W8_SCALE);
        *(u32x2*)(WT + (size_t)(dstrow + n) * ldt + k0 + 8 * c) = o; }
    LDS_WAIT(); asm volatile("" ::: "memory");
}
__device__ __forceinline__ void ln_row(const float* xrow, const float* gam, const float* bet, int lane, f32x4 (&y)[4]) {
    const f32x4* xr = (const f32x4*)xrow + lane; float s = 0.f;
#pragma unroll
    for (int j = 0; j < 4; ++j) { y[j] = xr[64 * j]; s += (y[j].x + y[j].y) + (y[j].z + y[j].w); }
    const float mean = wave_sum(s) * (1.f / D); float s2 = 0.f;
#pragma unroll
    for (int j = 0; j < 4; ++j) { y[j] = y[j] - mean; s2 += (y[j].x * y[j].x + y[j].y * y[j].y) + (y[j].z * y[j].z + y[j].w * y[j].w); }
    const float rstd = frsq(wave_sum(s2) * (1.f / D) + LN_EPS);
#pragma unroll
    for (int j = 0; j < 4; ++j) { const f32x4 gv = ((const f32x4*)gam)[lane + 64 * j], bv = ((const f32x4*)bet)[lane + 64 * j]; y[j] = y[j] * rstd * gv + bv; }
}
__device__ __forceinline__ void store_row_bf16(bf16_t* orow, int lane, const f32x4 (&y)[4]) {
    u32x2* o8 = (u32x2*)orow + lane;
#pragma unroll
    for (int j = 0; j < 4; ++j) { u32x2 w; w.x = pk2(y[j].x, y[j].y); w.y = pk2(y[j].z, y[j].w); o8[64 * j] = w; }
}
constexpr int MW_I1 = 32 * 1024, MW_I2 = 32 * 512, MW_NI = MW_I1 + MW_I2;
constexpr int MW_PRO = MW_NI * 3 / 4, MW_TAIL = (MW_NI - MW_PRO) / NG;
static_assert(MW_PRO % 2 == 0 && MW_TAIL * NG == MW_NI - MW_PRO && MW_TAIL % (64 * NWAVES * 2) == 0, "item split");
__device__ __forceinline__ void moe_convert(const P& p, const Ctx& c, int first, int stride, int last) {
    LAS float* scr = (LAS float*)(c.lds + c.wave * 17408);
    { const int kr = c.lane >> 3, n4 = (c.lane & 7) * 4;
      auto decode = [&](int r, const float*& src, int& ldw, unsigned char*& dst) {
          if (r < MW_I1) { const int e = r / 1024, q = r % 1024, nb = q % 64, kb = q / 64, dr = 32 * nb; const int sc = ((dr >> 7) & 1) * 1024 + (dr >> 8) * 128 + (dr & 127);
              ldw = 2048; src = p.in[I_W1] + (size_t)e * D * 2048 + (size_t)(64 * kb) * 2048 + sc; dst = c.ws + WS_W1 + (size_t)e * 2048 * D + (size_t)dr * D + 64 * kb; }
          else { r -= MW_I1; const int e = r / 512, q = r % 512, nb = q % 32, kb = q / 32;
              ldw = D; src = p.in[I_W2] + (size_t)e * DFF * D + (size_t)(64 * kb) * D + 32 * nb; dst = c.ws + WS_W2 + (size_t)e * D * DFF + (size_t)(32 * nb) * DFF + 64 * kb; } };
      f32x4 va[8], vb[8]; const float* src; unsigned char *dsta, *dstb; int ldw;
      LAS float* scrb = scr + 64 * 33;
      int it = first;
      auto loadp = [&](int i0) {
          decode(i0, src, ldw, dsta);
#pragma unroll
          for (int j = 0; j < 8; ++j) va[j] = *(const f32x4*)(src + (size_t)(8 * j + kr) * ldw + n4);
          if (i0 + stride < last) { decode(i0 + stride, src, ldw, dstb);
#pragma unroll
              for (int j = 0; j < 8; ++j) vb[j] = *(const f32x4*)(src + (size_t)(8 * j + kr) * ldw + n4); } };
      if (it < last) loadp(it);
#pragma unroll 1
      for (; it < last; it += 2 * stride) { const bool hasb = it + stride < last;
#pragma unroll
          for (int j = 0; j < 8; ++j) { LAS float* sp = scr + (8 * j + kr) * 33 + n4; sp[0] = va[j].x; sp[1] = va[j].y; sp[2] = va[j].z; sp[3] = va[j].w;
              LAS float* sq2 = scrb + (8 * j + kr) * 33 + n4; sq2[0] = vb[j].x; sq2[1] = vb[j].y; sq2[2] = vb[j].z; sq2[3] = vb[j].w; }
          unsigned char* da = dsta; unsigned char* db = dstb;
          if (it + 2 * stride < last) loadp(it + 2 * stride);
          LDS_WAIT(); asm volatile("" ::: "memory");
          const int cc = c.lane & 7;
#pragma unroll
          for (int j = 0; j < 4; ++j) { const int n = (c.lane >> 3) + 8 * j; const LAS float* sq = scr + (8 * cc) * 33 + n;
              u32x2 o; o.x = pack4_fp8(sq[0 * 33] * W8_SCALE, sq[1 * 33] * W8_SCALE, sq[2 * 33] * W8_SCALE, sq[3 * 33] * W8_SCALE); o.y = pack4_fp8(sq[4 * 33] * W8_SCALE, sq[5 * 33] * W8_SCALE, sq[6 * 33] * W8_SCALE, sq[7 * 33] * W8_SCALE);
              *(u32x2*)(da + (size_t)n * D + 8 * cc) = o;
              if (hasb) { const LAS float* sr = scrb + (8 * cc) * 33 + n;
                  u32x2 o2; o2.x = pack4_fp8(sr[0 * 33] * W8_SCALE, sr[1 * 33] * W8_SCALE, sr[2 * 33] * W8_SCALE, sr[3 * 33] * W8_SCALE); o2.y = pack4_fp8(sr[4 * 33] * W8_SCALE, sr[5 * 33] * W8_SCALE, sr[6 * 33] * W8_SCALE, sr[7 * 33] * W8_SCALE);
                  *(u32x2*)(db + (size_t)n * D + 8 * cc) = o2; } }
          LDS_WAIT(); asm volatile("" ::: "memory");
      } }
}
__device__ __forceinline__ void phase_prep(const P& p, const Ctx& c) {
    const float* w_in = p.in[I_WIN];
    if ((int)blockIdx.x * 32 < CIN) {
        LAS float* h0m = (LAS float*)c.lds; LAS float* red = (LAS float*)(c.lds + 65536);
#pragma unroll
        for (int rr = 0; rr < 2; ++rr) { const int m = 2 * c.wave + rr; f32x4 y[4]; ln_row(p.in[I_META] + (size_t)m * D, p.in[I_ELG], p.in[I_ELB], c.lane, y);
#pragma unroll
            for (int j = 0; j < 4; ++j) *(LAS f32x4*)(h0m + m * D + 4 * c.lane + 256 * j) = y[j]; }
        __syncthreads();
        const int cc = c.tid & 31, ks = c.tid >> 5, col = blockIdx.x * 32 + cc; float acc[16];
#pragma unroll
        for (int m = 0; m < 16; ++m) acc[m] = 0.f;
        if (col < CIN) {
#pragma unroll 1
            for (int k0 = ks * 64; k0 < ks * 64 + 64; k0 += 32) { float wv[32];
#pragma unroll
                for (int i = 0; i < 32; ++i) wv[i] = w_in[(size_t)(k0 + i) * CIN + col];
                __builtin_amdgcn_sched_barrier(0);
#pragma unroll
                for (int i = 0; i < 32; ++i) {
#pragma unroll
                    for (int m = 0; m < 16; ++m) acc[m] += h0m[m * D + k0 + i] * wv[i];
                    if (i & 1) __builtin_amdgcn_sched_barrier(0); } } }
#pragma unroll
        for (int m = 0; m < 16; ++m) red[(ks * 16 + m) * 32 + cc] = acc[m];
        __syncthreads();
        { const int m = c.tid >> 5; float s = 0.f;
#pragma unroll
          for (int k2 = 0; k2 < 16; ++k2) s += red[(k2 * 16 + m) * 32 + cc];
          if (col < CIN) ((float*)(c.ws + WS_PM))[(size_t)m * CIN + col] = s; }
        __syncthreads();
    }
    { const int gid = (int)blockIdx.x * NTHR + c.tid; if (gid < NEXP * D) { const int k = gid >> 5, e = gid & 31; ((bf16_t*)(c.ws + WS_WRT))[e * D + k] = (bf16_t)f2bf(p.in[I_WR][gid]); } }
    for (int i = c.gw * 64 + c.lane; i < 224 * 128; i += c.NGW * 64) { const u32x4 z = {0u, 0u, 0u, 0u}; ((u32x4*)(c.ws + WS_WIN + (size_t)7712 * D * (G1_FP8 ? 1 : 2)))[i] = z; }
    LAS float* scr = (LAS float*)(c.lds + c.wave * 17408);
    constexpr int I_IN = 241 * 16, I_SQ = 512, I_1 = 32 * 1024, I_2 = 32 * 512, NITEMS = I_IN + 3 * I_SQ + I_1 + I_2;
    bf16_t* WIN = (bf16_t*)(c.ws + WS_WIN);
    for (int it = c.gw; it < I_IN + 3 * I_SQ; it += c.NGW) {
        int r = it;
#if G1_FP8
        if (r < I_IN) { const int nb = r % 241, kb = r / 241, dr = 32 * nb; transpose_item8(w_in, CIN, 64 * kb, nb == 240 ? C_BG : (dr < 4096 ? dr : dr + 16), c.ws + WS_WIN, D, dr, scr, c.lane); continue; } r -= I_IN;
#else
        if (r < I_IN) { const int nb = r % 241, kb = r / 241, dr = 32 * nb; transpose_item(w_in, CIN, 64 * kb, nb == 240 ? C_BG : (dr < 4096 ? dr : dr + 16), WIN, D, dr, scr, c.lane); continue; } r -= I_IN;
#endif
        if (r < I_SQ) { const int nb = r % 32, kb = r / 32; transpose_item(p.in[I_WBG], D, 64 * kb, 32 * nb, (bf16_t*)(c.ws + WS_WBG), D, 32 * nb, scr, c.lane); continue; } r -= I_SQ;
        if (r < I_SQ) { const int nb = r % 32, kb = r / 32; transpose_item(p.in[I_WBS], D, 64 * kb, 32 * nb, (bf16_t*)(c.ws + WS_WBS), D, 32 * nb, scr, c.lane); continue; } r -= I_SQ;
        if (r < I_SQ) { const int nb = r % 32, kb = r / 32; transpose_item(p.in[I_WOUT], D, 64 * kb, 32 * nb, (bf16_t*)(c.ws + WS_WOUT), D, 32 * nb, scr, c.lane); continue; } r -= I_SQ;
        (void)r; }
    moe_convert(p, c, c.gw, c.NGW, MW_PRO);
}

__device__ __forceinline__ void meta_state(const P& p, const Ctx& c, int h, LAS unsigned char* lb) {
    LAS float* kf = (LAS float*)lb; LAS float* vf = kf + 16 * 128; LAS float* red = vf + 16 * 128; LAS float* bet = red + 2 * 4 * 128; LAS float* gg = bet + 16;
    const float* PM = (const float*)(c.ws + WS_PM); const float* cw = p.in[I_CONVW];
    { const int tl = c.tid >> 5, cg = c.tid & 31; float kk[4], vv[4]; float ss = 0.f;
#pragma unroll
      for (int j = 0; j < 4; ++j) { const int ch = h * 128 + 4 * cg + j; float ak = 0.f, av = 0.f;
#pragma unroll
          for (int i = 0; i < 4; ++i) { const int tt = tl - 3 + i; if (tt >= 0) { ak += cw[(size_t)(1024 + ch) * 4 + i] * PM[(size_t)tt * CIN + C_KG + ch]; av += cw[(size_t)(2048 + ch) * 4 + i] * PM[(size_t)tt * CIN + C_VG + ch]; } }
          kk[j] = siluf_(ak); vv[j] = siluf_(av); ss += kk[j] * kk[j]; }
      ss += sx<1>(ss); ss += sx<2>(ss); ss += sx<4>(ss); ss += sx<8>(ss); ss += sx<16>(ss);
      const float rn = frsq(ss + RMS_EPS);
#pragma unroll
      for (int j = 0; j < 4; ++j) { kf[tl * 128 + 4 * cg + j] = kk[j] * rn; vf[tl * 128 + 4 * cg + j] = vv[j]; }
      if (cg == 0) { bet[tl] = sigmoidf_(PM[(size_t)tl * CIN + C_BG + h]); gg[tl] = fexp(-fexp(p.in[I_ALOG][h]) * softplusf_(PM[(size_t)tl * CIN + C_AG + h] + p.in[I_DTB][h])); } }
    __syncthreads();
    float S[32];
#pragma unroll
    for (int k = 0; k < 32; ++k) S[k] = 0.f;
    const int v = c.tid & 127, rg = c.tid >> 7;
#pragma unroll 1
    for (int t = 0; t < 16; ++t) { float pk = 0.f;
#pragma unroll
        for (int k = 0; k < 32; ++k) pk += S[k] * kf[t * 128 + rg * 32 + k];
        red[((t & 1) * 4 + rg) * 128 + v] = pk;
        __syncthreads();
        const float sk = (red[((t & 1) * 4 + 0) * 128 + v] + red[((t & 1) * 4 + 1) * 128 + v]) + (red[((t & 1) * 4 + 2) * 128 + v] + red[((t & 1) * 4 + 3) * 128 + v]);
        const float g = gg[t], u = bet[t] * (vf[t * 128 + v] - g * sk);
#pragma unroll
        for (int k = 0; k < 32; ++k) S[k] = g * S[k] + kf[t * 128 + rg * 32 + k] * u; }
    float* S1 = (float*)(c.ws + WS_S1) + (size_t)h * 128 * 128;
#pragma unroll
    for (int k = 0; k < 32; ++k) S1[(rg * 32 + k) * 128 + v] = S[k];
    bf16_t* HALO = (bf16_t*)(c.ws + WS_HALO);
    for (int it = c.tid; it < BATCH * 3 * 3 * 16; it += NTHR) { const int cg2 = it & 15, which = (it >> 4) % 3, i = (it / 48) % 3, b = it / 144; const int ch0 = which * 1024 + h * 128 + 8 * cg2;
        const float* mp = PM + (size_t)(NMETA - 3 + i) * CIN + ch0; const f32x4 m0 = *(const f32x4*)mp, m1 = *(const f32x4*)(mp + 4);
        *(u32x4*)(HALO + ((size_t)(BATCH + b) * 3 + i) * 3072 + ch0) = pack8(m0, m1); }
    __syncthreads();
}


__device__ __forceinline__ float red16(float v) { v += sx<1>(v); v += sx<2>(v); v += sx<4>(v); v += sx<8>(v); return v; }
__device__ __forceinline__ void quad_load(const float* row, int sub, f32x4 (&y)[16]) { const f32x4* xr = (const f32x4*)row + sub;
#pragma unroll
    for (int j = 0; j < 16; ++j) y[j] = xr[16 * j]; }
__device__ __forceinline__ void quad_load_bf16(const bf16_t* row, int sub, f32x4 (&y)[16]) { const u32x2* xr = (const u32x2*)row + sub;
#pragma unroll
    for (int j = 0; j < 16; ++j) { const u32x2 w = xr[16 * j]; y[j] = (f32x4){bflo(w.x), bfhi(w.x), bflo(w.y), bfhi(w.y)}; } }
__device__ __forceinline__ void stage_gb(const Ctx& c, const float* g, const float* b, LAS float* dst) {
    if (c.tid < 256) *(LAS f32x4*)(dst + 4 * c.tid) = *(const f32x4*)(g + 4 * c.tid); else *(LAS f32x4*)(dst + 1024 + 4 * (c.tid - 256)) = *(const f32x4*)(b + 4 * (c.tid - 256));
}
__device__ __forceinline__ void quad_norm(f32x4 (&y)[16], const LAS float* gam, const LAS float* bet, int sub) {
    float s = 0.f;
#pragma unroll
    for (int j = 0; j < 16; ++j) s += (y[j].x + y[j].y) + (y[j].z + y[j].w);
    const float mean = red16(s) * (1.f / D); float s2 = 0.f;
#pragma unroll
    for (int j = 0; j < 16; ++j) { y[j] = y[j] - mean; s2 += (y[j].x * y[j].x + y[j].y * y[j].y) + (y[j].z * y[j].z + y[j].w * y[j].w); }
    const float rstd = frsq(red16(s2) * (1.f / D) + LN_EPS);
#pragma unroll
    for (int j = 0; j < 16; ++j) { const f32x4 gv = ((const LAS f32x4*)gam)[16 * j + sub], bv = ((const LAS f32x4*)bet)[16 * j + sub]; y[j] = y[j] * rstd * gv + bv;
        if ((j & 3) == 3) __builtin_amdgcn_sched_barrier(0); }
}
__device__ __forceinline__ void quad_store_bf16(bf16_t* orow, int sub, const f32x4 (&y)[16]) { u32x2* o8 = (u32x2*)orow + sub;
#pragma unroll
    for (int j = 0; j < 16; ++j) { u32x2 w; w.x = pg8::cvt_pk_bf16(y[j].x, y[j].y); w.y = pg8::cvt_pk_bf16(y[j].z, y[j].w); o8[16 * j] = w; } }

__device__ __forceinline__ void quad_store_fp8(unsigned char* orow, int sub, const f32x4 (&y)[16]) { unsigned* o4 = (unsigned*)orow + sub;
#pragma unroll
    for (int j = 0; j < 16; ++j) o4[16 * j] = pack4_fp8(y[j].x, y[j].y, y[j].z, y[j].w); }
constexpr int GB_LN2 = 0, GB_EMB = 8192, GB_LN1 = 98304;
constexpr int GB_EMB2 = 106496;
__device__ __forceinline__ void phase_ln0(const P& p, const Ctx& c, int g, int wid, int nw, int gboff) {
    bf16_t* H0 = (bf16_t*)(c.ws + WS_H0); const int sub = c.lane & 15, rs = c.lane >> 4; const LAS float* gL = (const LAS float*)(c.lds + gboff); const LAS float* bL = gL + 1024;
    for (int q0 = wid; q0 < TOK / 4; q0 += 2 * nw) { const int q1 = q0 + nw; const bool has1 = q1 < TOK / 4;
        const int r0 = 4 * q0 + rs, r1 = 4 * (has1 ? q1 : q0) + rs;
        f32x4 y0[16], y1[16];
        quad_load(p.in[I_X] + ((size_t)(r0 >> 9) * SEQ + g * TSL + (r0 & (TSL - 1))) * D, sub, y0);
        quad_load(p.in[I_X] + ((size_t)(r1 >> 9) * SEQ + g * TSL + (r1 & (TSL - 1))) * D, sub, y1);
        quad_norm(y0, gL, bL, sub); quad_store_bf16(H0 + (size_t)r0 * D, sub, y0); quad_store_fp8(c.ws + WS_H0Q + (size_t)r0 * D, sub, y0);
        if (has1) { quad_norm(y1, gL, bL, sub); quad_store_bf16(H0 + (size_t)r1 * D, sub, y1); quad_store_fp8(c.ws + WS_H0Q + (size_t)r1 * D, sub, y1); }
    }
}

__device__ __forceinline__ void ln1_norm(const P& p, const Ctx& c, int r, int sub, f32x4 (&y)[16]) {
    bf16_t* H1 = (bf16_t*)(c.ws + WS_H1);
    quad_norm(y, (const LAS float*)(c.lds + GB_LN1), (const LAS float*)(c.lds + GB_LN1) + 1024, sub);
    quad_store_bf16(H1 + (size_t)r * D, sub, y);
    int r2 = r, sub2 = sub; asm volatile("" : "+v"(r2), "+v"(sub2));
    unsigned* h8 = (unsigned*)(c.ws + WS_H1Q + (size_t)r2 * D) + sub2;
#pragma unroll
    for (int j = 0; j < 16; ++j) h8[16 * j] = pack4_fp8(y[j].x, y[j].y, y[j].z, y[j].w);
}
constexpr int RT_WS = 1032;
__device__ __forceinline__ void phase_ln1_router(const P& p, const Ctx& c, int g, int ln0_next) {
    LAS bf16_t* wrb = (LAS bf16_t*)c.lds;
    LAS float* lgs = (LAS float*)(c.lds + 32 * RT_WS * 2);
    { const u32x4* wrt = (const u32x4*)(c.ws + WS_WRT); u32x4 wv[8];
#pragma unroll
      for (int i = 0; i < 8; ++i) wv[i] = wrt[c.tid + NTHR * i];
#pragma unroll
      for (int i = 0; i < 8; ++i) { const int ch = c.tid + NTHR * i, e = ch >> 7, k8 = ch & 127; *(LAS u32x4*)(wrb + e * RT_WS + 8 * k8) = wv[i]; } }
    stage_gb(c, p.in[I_L1G], p.in[I_L1B], (LAS float*)(c.lds + GB_LN1));
    if (ln0_next >= 0) stage_gb(c, p.in[I_ELG], p.in[I_ELB], (LAS float*)(c.lds + GB_EMB2));
    if (c.tid < NEXP) c.MISC[MI_LCNT + c.tid] = 0u;
    __syncthreads();
    const bf16_t* PRE1 = (const bf16_t*)(c.ws + WS_PRE1); const int sub = c.lane & 15, rs = c.lane >> 4;
    const int rloc = 64 * blockIdx.x, rbase = (g % NP) * TOK + rloc;
    { const int r0 = rbase + 8 * c.wave + rs, r1 = r0 + 4, l0 = rloc + 8 * c.wave + rs, l1 = l0 + 4; f32x4 y0[16], y1[16]; u32x2 w0[16], w1[16];
      { const u32x2* x0 = (const u32x2*)(PRE1 + (size_t)l0 * D) + sub; const u32x2* x1 = (const u32x2*)(PRE1 + (size_t)l1 * D) + sub;
#pragma unroll
        for (int j = 0; j < 16; ++j) { w0[j] = x0[16 * j]; w1[j] = x1[16 * j]; } }
      __builtin_amdgcn_sched_barrier(0);
#pragma unroll
      for (int j = 0; j < 16; ++j) { y0[j] = (f32x4){bflo(w0[j].x), bfhi(w0[j].x), bflo(w0[j].y), bfhi(w0[j].y)}; y1[j] = (f32x4){bflo(w1[j].x), bfhi(w1[j].x), bflo(w1[j].y), bfhi(w1[j].y)}; }
      ln1_norm(p, c, r0, sub, y0); ln1_norm(p, c, r1, sub, y1); }
    asm volatile("s_waitcnt vmcnt(0)" ::: "memory");
    __syncthreads();
    int* TOPI = (int*)(c.ws + WS_TOPI); float* TOPW = (float*)(c.ws + WS_TOPW); int* RANK = (int*)(c.ws + WS_RANK);
    if (c.wave < 4) {
        const int i15 = c.lane & 15, kq = c.lane >> 4, R0 = rbase + 16 * c.wave; const bf16_t* H1 = (const bf16_t*)(c.ws + WS_H1);
        const bf16_t* hrow = H1 + (size_t)(R0 + i15) * D + 8 * kq;
        f32x4 a0 = *(const f32x4*)(p.in[I_BR] + 4 * kq), a1 = *(const f32x4*)(p.in[I_BR] + 16 + 4 * kq);
        pg8::bf16x8 bf[32];
#pragma unroll
        for (int j = 0; j < 32; ++j) bf[j] = *(const pg8::bf16x8*)(hrow + 32 * j);
        __builtin_amdgcn_sched_barrier(0);
#pragma unroll
        for (int j = 0; j < 32; ++j) { const int ko = 32 * j + 8 * kq;
            const pg8::bf16x8 w0 = *(const LAS pg8::bf16x8*)(wrb + i15 * RT_WS + ko), w1 = *(const LAS pg8::bf16x8*)(wrb + (16 + i15) * RT_WS + ko);
            a0 = __builtin_amdgcn_mfma_f32_16x16x32_bf16(w0, bf[j], a0, 0, 0, 0); a1 = __builtin_amdgcn_mfma_f32_16x16x32_bf16(w1, bf[j], a1, 0, 0, 0); }
        LAS float* lg = lgs + c.wave * 16 * 33;
#pragma unroll
        for (int r = 0; r < 4; ++r) { lg[i15 * 33 + 4 * kq + r] = a0[r]; lg[i15 * 33 + 16 + 4 * kq + r] = a1[r]; }
        asm volatile("s_waitcnt lgkmcnt(0)" ::: "memory");
        if (c.lane < 16) { const int r = R0 + c.lane; float v[32];
#pragma unroll
            for (int e = 0; e < 32; ++e) v[e] = lg[c.lane * 33 + e];
            int sel[4]; float val[4];
#pragma unroll
            for (int k = 0; k < 4; ++k) { float best = -3.0e38f; int bi = 0;
#pragma unroll
                for (int e = 0; e < 32; ++e) if (v[e] > best) { best = v[e]; bi = e; }
                sel[k] = bi; val[k] = best;
#pragma unroll
                for (int e = 0; e < 32; ++e) v[e] = (e == bi) ? -3.0e38f : v[e]; }
            const float e1 = fexp(val[1] - val[0]), e2 = fexp(val[2] - val[0]), e3 = fexp(val[3] - val[0]); const float inv = frcp(1.0f + e1 + e2 + e3);
            const float ww[4] = {inv, e1 * inv, e2 * inv, e3 * inv};
#pragma unroll
            for (int k = 0; k < 4; ++k) { const unsigned rk = __hip_atomic_fetch_add((LAS unsigned*)(c.MISC + MI_LCNT + sel[k]), 1u, __ATOMIC_RELAXED, __HIP_MEMORY_SCOPE_WORKGROUP);
                TOPI[(size_t)r * 4 + k] = sel[k]; TOPW[(size_t)r * 4 + k] = ww[k]; RANK[(size_t)r * 4 + k] = (int)rk; } }
    } else if (ln0_next >= 0) {
        phase_ln0(p, c, ln0_next, (int)blockIdx.x * 4 + (c.wave - 4), (int)gridDim.x * 4, GB_EMB2);
    }
    asm volatile("s_waitcnt vmcnt(0)" ::: "memory");
    __syncthreads();
    int lane2 = lane_fresh(); const int tid2 = c.wave * 64 + lane2;
    if (tid2 < NEXP) { unsigned* gc = (unsigned*)(c.ws + WS_CTL) + CW_CNT + ((g / NP) * NEXP + tid2) * 32; c.MISC[MI_LBASE + tid2] = atomicAdd(gc, (unsigned)c.MISC[MI_LCNT + tid2]); }
    __syncthreads();
    if (tid2 < 256) { const size_t i = (size_t)rbase * 4 + tid2; const int e = __hip_atomic_load(TOPI + i, __ATOMIC_RELAXED, __HIP_MEMORY_SCOPE_AGENT); const int pos = RANK[i] + (int)c.MISC[MI_LBASE + e]; RANK[i] = pos;
        ((int*)(c.ws + WS_RTOK))[(size_t)e * TOKP + pos] = (int)(i >> 2); ((float*)(c.ws + WS_RWW))[(size_t)e * TOKP + pos] = TOPW[i]; }
}
__device__ __forceinline__ int moe_tables(const Ctx& c, int pr) {
    const unsigned* cnt = (const unsigned*)(c.ws + WS_CTL) + CW_CNT + pr * NEXP * 32;
    if (c.wave == 0) { const int e = c.lane & 31; const unsigned cv = __hip_atomic_load(cnt + e * 32, __ATOMIC_RELAXED, __HIP_MEMORY_SCOPE_AGENT), pd = (cv + 255u) & ~255u; unsigned inc = pd;
#pragma unroll
        for (int o = 1; o < 32; o <<= 1) { const unsigned t = shfl_up_u(inc, o, c.lane); if (e >= o) inc += t; }
        if (c.lane < 32) { c.MISC[MI_OFF + e] = inc - pd; c.MISC[MI_CNT + e] = cv; if (e == 31) c.MISC[MI_OFF + NEXP] = inc; } }
    __syncthreads();
    const int ntiles = (int)(c.MISC[MI_OFF + NEXP] >> 8);
    for (int t = c.tid; t < ntiles; t += NTHR) { int e = 0; for (int k = 1; k < NEXP; ++k) if ((unsigned)(t * 256) >= c.MISC[MI_OFF + k]) e = k; ((volatile LAS unsigned char*)(c.MISC + MI_TE))[t] = (unsigned char)e; }
    __syncthreads();
    return ntiles;
}
__device__ __forceinline__ void phase_combine(const P& p, const Ctx& c, int pr) {
    const bf16_t* H1 = (const bf16_t*)(c.ws + WS_H1); const unsigned char* YS = c.ws + WS_YS; const int* TOPI = (const int*)(c.ws + WS_TOPI); const int* RANK = (const int*)(c.ws + WS_RANK);
    const int sub = c.lane & 15, rs = c.lane >> 4;
    for (int q = c.gw; q < TOKP / 4; q += c.NGW) { const int r = 4 * q + rs;
        int sl[4];
#pragma unroll
        for (int k = 0; k < 4; ++k) sl[k] = (int)c.MISC[MI_OFF + TOPI[(size_t)r * 4 + k]] + RANK[(size_t)r * 4 + k];
        f32x4 v[16];
        u32x4 hw[8]; u32x2 yw[4][8];
#pragma unroll
        for (int j = 0; j < 8; ++j) { hw[j] = ((const u32x4*)(H1 + (size_t)r * D))[16 * j + sub];
#pragma unroll
            for (int k = 0; k < 4; ++k) yw[k][j] = ((const u32x2*)(YS + (size_t)sl[k] * D))[16 * j + sub]; }
#pragma unroll
        for (int j = 0; j < 8; ++j) { f32x4 a0, a1; unpack8(hw[j], a0, a1); a0 = a0 * DN_ALPHA; a1 = a1 * DN_ALPHA; f32x4 y0 = {0.f, 0.f, 0.f, 0.f}, y1 = {0.f, 0.f, 0.f, 0.f};
#pragma unroll
            for (int k = 0; k < 4; ++k) { const f32x2 p0 = __builtin_amdgcn_cvt_pk_f32_fp8((int)yw[k][j].x, false), p1 = __builtin_amdgcn_cvt_pk_f32_fp8((int)yw[k][j].x, true), p2 = __builtin_amdgcn_cvt_pk_f32_fp8((int)yw[k][j].y, false), p3 = __builtin_amdgcn_cvt_pk_f32_fp8((int)yw[k][j].y, true);
                y0 = y0 + (f32x4){p0.x, p0.y, p1.x, p1.y}; y1 = y1 + (f32x4){p2.x, p2.y, p3.x, p3.y}; }
            v[2 * j] = a0 + y0 * YS_INV; v[2 * j + 1] = a1 + y1 * YS_INV; }
        float s = 0.f;
#pragma unroll
        for (int j = 0; j < 16; ++j) s += (v[j].x + v[j].y) + (v[j].z + v[j].w);
        const float mean = red16(s) * (1.f / D); float s2 = 0.f;
#pragma unroll
        for (int j = 0; j < 16; ++j) { v[j] = v[j] - mean; s2 += (v[j].x * v[j].x + v[j].y * v[j].y) + (v[j].z * v[j].z + v[j].w * v[j].w); }
        const float rstd = frsq(red16(s2) * (1.f / D) + LN_EPS);
        const int rl = r & (TOK - 1), gs = NP * pr + r / TOK;
        float* orow = p.out + ((size_t)(rl >> 9) * SEQ + gs * TSL + (rl & (TSL - 1))) * D;
#pragma unroll
        for (int j = 0; j < 8; ++j) { const int k0 = 128 * j + 8 * sub;
            const LAS float* gL = (const LAS float*)(c.lds + GB_LN2); const f32x4 g0 = *(const LAS f32x4*)(gL + k0), g1 = *(const LAS f32x4*)(gL + k0 + 4), b0 = *(const LAS f32x4*)(gL + 1024 + k0), b1 = *(const LAS f32x4*)(gL + 1024 + k0 + 4);
            *(f32x4*)(orow + k0) = v[2 * j] * rstd * g0 + b0; *(f32x4*)(orow + k0 + 4) = v[2 * j + 1] * rstd * g1 + b1;
            if (j & 1) __builtin_amdgcn_sched_barrier(0); }
    }
}

typedef short bf16x8 __attribute__((ext_vector_type(8)));
typedef float f32x16 __attribute__((ext_vector_type(16)));
typedef short bf16x4 __attribute__((ext_vector_type(4)));
constexpr int SW_K = 0, SW_KT = 9216, SW_VT = 36864, SW_VTT = 8704, SW_KM = 71680, SW_VTM = 76288;
constexpr float L2E = 1.4426950408889634f;
__device__ __forceinline__ bf16x8 mk8(bf16x4 a, bf16x4 b) { return (bf16x8){a[0], a[1], a[2], a[3], b[0], b[1], b[2], b[3]}; }
template <int MODE>
__device__ __forceinline__ void swa_tile(LAS unsigned char* lds, int kt, int jt, int iq, int lane, float slope2, const bf16x8 (&qf)[4], float& m, float& l, f32x16& ot0, f32x16& ot1) {
    const int r31 = lane & 31, h = lane >> 5;
    const int dq = iq - jt - 4 * h;
    const float cl = -slope2 * (float)dq; const int dmax = iq < 127 ? iq : 127;
    f32x16 s0, s1;
#pragma unroll
    for (int r = 0; r < 16; ++r) { const int ko = 8 * (r >> 2) + (r & 3);
        float t0 = fmaf(slope2, (float)ko, cl), t1 = fmaf(slope2, (float)(ko + 32), cl);
        if (MODE == 1) { const int d0 = dq - ko, d1 = dq - ko - 32; t0 = ((unsigned)d0 <= (unsigned)dmax) ? t0 : -3.0e38f; t1 = ((unsigned)d1 <= (unsigned)dmax) ? t1 : -3.0e38f; }
        s0[r] = t0; s1[r] = t1; }
    const LAS unsigned char* kb0 = lds + SW_K + kt * SW_KT + r31 * 144 + h * 16;
#pragma unroll
    for (int ks = 0; ks < 4; ++ks) { const bf16x8 a0 = *(const LAS bf16x8*)(kb0 + ks * 32), a1 = *(const LAS bf16x8*)(kb0 + 32 * 144 + ks * 32);
        s0 = __builtin_amdgcn_mfma_f32_32x32x16_bf16(a0, qf[ks], s0, 0, 0, 0); s1 = __builtin_amdgcn_mfma_f32_32x32x16_bf16(a1, qf[ks], s1, 0, 0, 0); }
    __builtin_amdgcn_sched_barrier(0);
    float mx = -3.0e38f;
#pragma unroll
    for (int r = 0; r < 16; ++r) mx = fmaxf(mx, fmaxf(s0[r], s1[r]));
    mx = fmaxf(mx, sx<32>(mx));
    const float mn = fmaxf(m, mx), sc = __builtin_amdgcn_exp2f(m - mn); m = mn;
    float ls = 0.f;
#pragma unroll
    for (int r = 0; r < 16; ++r) { s0[r] = __builtin_amdgcn_exp2f(s0[r] - mn); s1[r] = __builtin_amdgcn_exp2f(s1[r] - mn); ls += s0[r] + s1[r]; }
    l = l * sc + ls;
#pragma unroll
    for (int r = 0; r < 16; ++r) { ot0[r] *= sc; ot1[r] *= sc; }
    bf16x8 pf[2][2];
#pragma unroll
    for (int s = 0; s < 2; ++s) {
        u32x4 w0, w1;
        w0.x = pg8::cvt_pk_bf16(s0[8 * s + 0], s0[8 * s + 1]); w0.y = pg8::cvt_pk_bf16(s0[8 * s + 2], s0[8 * s + 3]); w0.z = pg8::cvt_pk_bf16(s0[8 * s + 4], s0[8 * s + 5]); w0.w = pg8::cvt_pk_bf16(s0[8 * s + 6], s0[8 * s + 7]);
        w1.x = pg8::cvt_pk_bf16(s1[8 * s + 0], s1[8 * s + 1]); w1.y = pg8::cvt_pk_bf16(s1[8 * s + 2], s1[8 * s + 3]); w1.z = pg8::cvt_pk_bf16(s1[8 * s + 4], s1[8 * s + 5]); w1.w = pg8::cvt_pk_bf16(s1[8 * s + 6], s1[8 * s + 7]);
        pf[0][s] = __builtin_bit_cast(bf16x8, w0); pf[1][s] = __builtin_bit_cast(bf16x8, w1); }
    __builtin_amdgcn_sched_barrier(0);
    const LAS unsigned char* vb0 = lds + SW_VT + kt * SW_VTT + r31 * 136 + h * 8; const int swz = (r31 >> 3) & 3;
#pragma unroll
    for (int kb = 0; kb < 2; ++kb)
#pragma unroll
        for (int s = 0; s < 2; ++s) { const int g0 = 4 * kb + 2 * s;
            const bf16x8 a0 = mk8(*(const LAS bf16x4*)(vb0 + ((g0 ^ swz) << 4)), *(const LAS bf16x4*)(vb0 + (((g0 + 1) ^ swz) << 4))),
                         a1 = mk8(*(const LAS bf16x4*)(vb0 + 32 * 136 + ((g0 ^ (swz + 4)) << 4)), *(const LAS bf16x4*)(vb0 + 32 * 136 + (((g0 + 1) ^ (swz + 4)) << 4)));
            ot0 = __builtin_amdgcn_mfma_f32_32x32x16_bf16(a0, pf[kb][s], ot0, 0, 0, 0); ot1 = __builtin_amdgcn_mfma_f32_32x32x16_bf16(a1, pf[kb][s], ot1, 0, 0, 0); }
    __builtin_amdgcn_sched_barrier(0);
}
__device__ __forceinline__ void swa_meta(LAS unsigned char* lds, int iq, int lane, float slope2, const bf16x8 (&qf)[4], float& m, float& l, f32x16& ot0, f32x16& ot1) {
    const int r31 = lane & 31, h = lane >> 5;
    const float cl = -slope2 * (float)(NMETA + iq - 4 * h);
    f32x16 s0;
#pragma unroll
    for (int r = 0; r < 16; ++r) { const int ko = 8 * (r >> 2) + (r & 3); s0[r] = r < 8 ? fmaf(slope2, (float)ko, cl) : 0.f; }
    const LAS unsigned char* kb0 = lds + SW_KM + r31 * 144 + h * 16;
#pragma unroll
    for (int ks = 0; ks < 4; ++ks) { const bf16x8 a0 = *(const LAS bf16x8*)(kb0 + ks * 32); s0 = __builtin_amdgcn_mfma_f32_32x32x16_bf16(a0, qf[ks], s0, 0, 0, 0); }
    float mx = -3.0e38f;
#pragma unroll
    for (int r = 0; r < 8; ++r) mx = fmaxf(mx, s0[r]);
    mx = fmaxf(mx, sx<32>(mx));
    const float mn = fmaxf(m, mx), sc = __builtin_amdgcn_exp2f(m - mn); m = mn;
    float ls = 0.f;
#pragma unroll
    for (int r = 0; r < 8; ++r) { s0[r] = __builtin_amdgcn_exp2f(s0[r] - mn); ls += s0[r]; }
    l = l * sc + ls;
#pragma unroll
    for (int r = 0; r < 16; ++r) { ot0[r] *= sc; ot1[r] *= sc; }
    u32x4 w0; w0.x = pg8::cvt_pk_bf16(s0[0], s0[1]); w0.y = pg8::cvt_pk_bf16(s0[2], s0[3]); w0.z = pg8::cvt_pk_bf16(s0[4], s0[5]); w0.w = pg8::cvt_pk_bf16(s0[6], s0[7]);
    const bf16x8 pf = __builtin_bit_cast(bf16x8, w0);
    const LAS unsigned char* vb0 = lds + SW_VTM + r31 * 72 + h * 8;
    const bf16x8 a0 = mk8(*(const LAS bf16x4*)(vb0), *(const LAS bf16x4*)(vb0 + 16)), a1 = mk8(*(const LAS bf16x4*)(vb0 + 32 * 72), *(const LAS bf16x4*)(vb0 + 32 * 72 + 16));
    ot0 = __builtin_amdgcn_mfma_f32_32x32x16_bf16(a0, pf, ot0, 0, 0, 0); ot1 = __builtin_amdgcn_mfma_f32_32x32x16_bf16(a1, pf, ot1, 0, 0, 0);
    __builtin_amdgcn_sched_barrier(0);
}
__device__ __forceinline__ void swa_unit(const P& p, const Ctx& c, int g, int u) {
    const int b = u >> 4, hk = (u >> 2) & 3, qt = u & 3, i0 = g * TSL + qt * 128;
    const bf16_t* KSF = (const bf16_t*)(c.ws + WS_KSF); const bf16_t* VSF = (const bf16_t*)(c.ws + WS_VSF); const float* PM = (const float*)(c.ws + WS_PM);
    const bf16_t* QS = (const bf16_t*)(c.ws + WS_QS); bf16_t* OS = (bf16_t*)(c.ws + WS_OSW);
    LAS unsigned char* lds = c.lds;
    { const int kk = c.tid >> 3, ch = c.tid & 7;
      u32x4 kv[4], vv[4]; f32x4 mk0 = {0.f, 0.f, 0.f, 0.f}, mk1 = {0.f, 0.f, 0.f, 0.f}; float mv[4] = {0.f, 0.f, 0.f, 0.f};
#pragma unroll
      for (int kt = 0; kt < 4; ++kt) { const int j = i0 - 128 + 64 * kt + kk, jc = j < 0 ? 0 : j; const size_t off = ((size_t)b * SEQ + jc) * 256 + hk * 64 + ch * 8;
          kv[kt] = *(const u32x4*)(KSF + off); vv[kt] = *(const u32x4*)(VSF + off); }
      const int mrow = c.tid >> 3, md = c.tid >> 3, m4 = (c.tid & 7) * 4;
      if (c.tid < 256 && mrow < NMETA) { const float* kp = PM + (size_t)mrow * CIN + C_KS + hk * 64 + ch * 8; mk0 = *(const f32x4*)kp; mk1 = *(const f32x4*)(kp + 4); }
      if (m4 < NMETA) { const float* vp = PM + (size_t)m4 * CIN + C_VS + hk * 64 + md; mv[0] = vp[0]; mv[1] = vp[CIN]; mv[2] = vp[2 * CIN]; mv[3] = vp[3 * CIN]; }
#pragma unroll
      for (int kt = 0; kt < 4; ++kt) {
          *(LAS u32x4*)(lds + SW_K + kt * SW_KT + kk * 144 + ch * 16) = kv[kt];
          LAS unsigned char* vt = lds + SW_VT + kt * SW_VTT + (ch * 8) * 136 + ((((kk >> 3) ^ ch) << 3) + (kk & 7)) * 2;
          *(LAS bf16_t*)(vt + 0 * 136) = (bf16_t)(vv[kt].x & 0xffffu); *(LAS bf16_t*)(vt + 1 * 136) = (bf16_t)(vv[kt].x >> 16); *(LAS bf16_t*)(vt + 2 * 136) = (bf16_t)(vv[kt].y & 0xffffu); *(LAS bf16_t*)(vt + 3 * 136) = (bf16_t)(vv[kt].y >> 16);
          *(LAS bf16_t*)(vt + 4 * 136) = (bf16_t)(vv[kt].z & 0xffffu); *(LAS bf16_t*)(vt + 5 * 136) = (bf16_t)(vv[kt].z >> 16); *(LAS bf16_t*)(vt + 6 * 136) = (bf16_t)(vv[kt].w & 0xffffu); *(LAS bf16_t*)(vt + 7 * 136) = (bf16_t)(vv[kt].w >> 16); }
      if (c.tid < 256) *(LAS u32x4*)(lds + SW_KM + mrow * 144 + ch * 16) = pack8(mk0, mk1);
      { u32x2 w; w.x = pg8::cvt_pk_bf16(mv[0], mv[1]); w.y = pg8::cvt_pk_bf16(mv[2], mv[3]); *(LAS u32x2*)(lds + SW_VTM + md * 72 + m4 * 2) = w; } }
    bf16x8 qf[4];
    { const int hq_ = 4 * hk + (c.wave & 3), r31_ = c.lane & 31, h_ = c.lane >> 5; const size_t row_ = (size_t)b * TSL + qt * 128 + (c.wave >> 2) * 64 + r31_;
#pragma unroll
      for (int ks = 0; ks < 4; ++ks) qf[ks] = *(const bf16x8*)(QS + row_ * D + hq_ * 64 + 16 * ks + 8 * h_); }
    __syncthreads();
    { const int gh = c.wave & 3, half = c.wave >> 2, hq = 4 * hk + gh, lane = c.lane, r31 = lane & 31, h = lane >> 5;
      const float slope2 = __builtin_amdgcn_exp2f(-0.5f * (float)(hq + 1)) * L2E, sink2 = p.in[I_SINK][hq] * L2E;
#pragma unroll 1
      for (int qb = 0; qb < 2; ++qb) {
          const int tl = qt * 128 + half * 64 + qb * 32 + r31, iq = g * TSL + tl; const size_t row = (size_t)b * TSL + tl;
          if (qb) {
#pragma unroll
              for (int ks = 0; ks < 4; ++ks) qf[ks] = *(const bf16x8*)(QS + row * D + hq * 64 + 16 * ks + 8 * h); }
          float m = sink2, l = h == 0 ? 1.0f : 0.0f; f32x16 ot0, ot1;
#pragma unroll
          for (int r = 0; r < 16; ++r) { ot0[r] = 0.f; ot1[r] = 0.f; }
          swa_meta(lds, iq, lane, slope2, qf, m, l, ot0, ot1);
          const int jt0 = i0 - 128 + 64 * half;
          swa_tile<1>(lds, half, jt0, iq, lane, slope2, qf, m, l, ot0, ot1);
          if (jt0 + 64 < 0) swa_tile<1>(lds, half + 1, jt0 + 64, iq, lane, slope2, qf, m, l, ot0, ot1); else swa_tile<0>(lds, half + 1, jt0 + 64, iq, lane, slope2, qf, m, l, ot0, ot1);
          swa_tile<1>(lds, half + 2, jt0 + 128, iq, lane, slope2, qf, m, l, ot0, ot1);
          const float inv = frcp(l + sx<32>(l));
          bf16_t* op = OS + row * D + hq * 64 + 4 * h;
#pragma unroll
          for (int gq = 0; gq < 4; ++gq) { u32x2 w0, w1;
              w0.x = pg8::cvt_pk_bf16(ot0[4 * gq] * inv, ot0[4 * gq + 1] * inv); w0.y = pg8::cvt_pk_bf16(ot0[4 * gq + 2] * inv, ot0[4 * gq + 3] * inv);
              w1.x = pg8::cvt_pk_bf16(ot1[4 * gq] * inv, ot1[4 * gq + 1] * inv); w1.y = pg8::cvt_pk_bf16(ot1[4 * gq + 2] * inv, ot1[4 * gq + 3] * inv);
              *(u32x2*)(op + 8 * gq) = w0; *(u32x2*)(op + 32 + 8 * gq) = w1; }
      } }
    __syncthreads();
}

constexpr int IM_W = 0, IM_QD = 16384, IM_QK = 32768, IM_KDT = 40960, IM_UV = 57344, UNIT_BYTES = 73728;
constexpr size_t WS_IMG = WS_IMG_BASE, WS_GT = 251 * MiB;
constexpr int GA_A = 0, GA_T = 16896, GA_GAM = 26112, GA_K = 27136, GA_Q = 44544, GA_KBT = 61952, GA_VBT = 80384;
__device__ __forceinline__ u32x4 pack8r(const f32x16& v, int s, float sc) {
    u32x4 w; w.x = pg8::cvt_pk_bf16(v[8 * s + 0] * sc, v[8 * s + 1] * sc); w.y = pg8::cvt_pk_bf16(v[8 * s + 2] * sc, v[8 * s + 3] * sc); w.z = pg8::cvt_pk_bf16(v[8 * s + 4] * sc, v[8 * s + 5] * sc); w.w = pg8::cvt_pk_bf16(v[8 * s + 6] * sc, v[8 * s + 7] * sc); return w; }
struct GdnRaw { u32x4 r[3][5]; float lg, be; };
__device__ __forceinline__ void gdn_a_prefetch(const Ctx& c, int g, int u, GdnRaw& R) {
    const int n = u & 7, h = (u >> 3) & 7, b = u >> 6, cg = c.tid & 15;
    const bf16_t* QKVG = (const bf16_t*)(c.ws + WS_QKVG); const bf16_t* HALO = (const bf16_t*)(c.ws + WS_HALO);
    const int tok0 = n * 64 + 2 * (c.tid >> 4);
#pragma unroll
    for (int i = 0; i < 5; ++i) { const int tt = tok0 - 3 + i;
        const bf16_t* mid = (tt >= 0 ? QKVG + ((size_t)b * TSL + tt) * 3072 : HALO + ((size_t)(((g + 1) & 1) * BATCH + b) * 3 + (3 + tt)) * 3072) + 1024 + h * 128 + 8 * cg;
        R.r[0][i] = *(const u32x4*)(mid - 1024); R.r[1][i] = *(const u32x4*)(mid); R.r[2][i] = *(const u32x4*)(mid + 1024); }
    const size_t row = (size_t)b * TSL + n * 64 + (c.lane);
    R.lg = ((const float*)(c.ws + WS_LOGG))[row * 8 + h]; R.be = ((const float*)(c.ws + WS_BETA))[row * 8 + h];
}
template <int R0>
__device__ __forceinline__ void gdn_conv8(const LAS float* cw, const u32x4 (&rawr)[5], f32x2 (&y)[4]) {
    f32x2 acc[4];
#pragma unroll
    for (int i = 0; i < 4; ++i) { const f32x4 w0 = *(const LAS f32x4*)(cw + i * 128), w1 = *(const LAS f32x4*)(cw + i * 128 + 4); const u32x4 rw = rawr[R0 + i];
        const f32x2 x0 = {bflo(rw.x), bfhi(rw.x)}, x1 = {bflo(rw.y), bfhi(rw.y)}, x2 = {bflo(rw.z), bfhi(rw.z)}, x3 = {bflo(rw.w), bfhi(rw.w)};
        const f32x2 wa = {w0.x, w0.y}, wb = {w0.z, w0.w}, wc = {w1.x, w1.y}, wd = {w1.z, w1.w};
        if (i == 0) { acc[0] = wa * x0; acc[1] = wb * x1; acc[2] = wc * x2; acc[3] = wd * x3; }
        else { acc[0] = acc[0] + wa * x0; acc[1] = acc[1] + wb * x1; acc[2] = acc[2] + wc * x2; acc[3] = acc[3] + wd * x3; } }
#pragma unroll
    for (int p = 0; p < 4; ++p) { f32x2 t = acc[p] * (-1.4426950408889634f);
        t.x = __builtin_amdgcn_exp2f(t.x); t.y = __builtin_amdgcn_exp2f(t.y); t = t + 1.0f; t.x = __builtin_amdgcn_rcpf(t.x); t.y = __builtin_amdgcn_rcpf(t.y);
        y[p] = acc[p] * t; }
}
constexpr int GA_CW = 98816, GA_TF = 104960, GA_XS = 121856;
constexpr int GA_LD = 66;
#define LDS_BAR() do { asm volatile("s_waitcnt lgkmcnt(0)" ::: "memory"); __builtin_amdgcn_s_barrier(); asm volatile("" ::: "memory"); } while (0)
__device__ __forceinline__ void gdn_a_unit(const P& p, const Ctx& c, int g, int u, GdnRaw& R, int unext) {
    const int n = u & 7, h = (u >> 3) & 7, b = u >> 6;
    LAS unsigned char* lds = c.lds;
    LAS float* gam = (LAS float*)(lds + GA_GAM); LAS float* bet = gam + 64; LAS float* egam = gam + 128; LAS float* ekd = gam + 192;
    LAS float* Amat = (LAS float*)(lds + GA_A); LAS float* TF = (LAS float*)(lds + GA_TF);
    const bf16_t* QKVG = (const bf16_t*)(c.ws + WS_QKVG); bf16_t* HALO = (bf16_t*)(c.ws + WS_HALO);
    unsigned char* img = c.ws + WS_IMG + (size_t)u * UNIT_BYTES;
    const int lane = c.lane, l31 = lane & 31, hh = lane >> 5;
    { AMP_BEGIN(16)
    if (c.wave == 0) { float ps = R.lg;
#pragma unroll
        for (int o = 1; o < 64; o <<= 1) { const float t = shfl_up_f(ps, o, lane); if (lane >= o) ps += t; }
        const float last = __builtin_bit_cast(float, __builtin_amdgcn_readlane(__builtin_bit_cast(int, ps), 63));
        gam[lane] = ps; bet[lane] = R.be; egam[lane] = fexp(ps); ekd[lane] = fexp(last - ps);
        if (lane == 63) ((float*)(c.ws + WS_GT))[u] = fexp(ps); }
    if (n == 7 && c.tid >= 64 && c.tid < 64 + 144) { const int t2 = c.tid - 64, i = t2 / 48, which = (t2 / 16) % 3, cg2 = t2 & 15;
        *(u32x4*)(HALO + ((size_t)((g & 1) * BATCH + b) * 3 + i) * 3072 + which * 1024 + h * 128 + 8 * cg2) = *(const u32x4*)(QKVG + ((size_t)b * TSL + (TSL - 3 + i)) * 3072 + which * 1024 + h * 128 + 8 * cg2); }
    LDS_BAR(); AMP_END(16) }
    { AMP_BEGIN(17)
    const LAS float* cwb = (const LAS float*)(lds + GA_CW) + 8 * (c.tid & 15);
    { const int cg = c.tid & 15, cl0 = 2 * (c.tid >> 4); f32x2 kbp[2][4], vbp[2][4];
#pragma unroll
      for (int pass = 0; pass < 2; ++pass) { const int cl = cl0 + pass; f32x2 yq[4], yk[4], yv[4];
        if (pass == 0) { gdn_conv8<0>(cwb, R.r[0], yq); gdn_conv8<0>(cwb + 512, R.r[1], yk); gdn_conv8<0>(cwb + 1024, R.r[2], yv); }
        else           { gdn_conv8<1>(cwb, R.r[0], yq); gdn_conv8<1>(cwb + 512, R.r[1], yk); gdn_conv8<1>(cwb + 1024, R.r[2], yv); }
        f32x2 sq2 = yq[0] * yq[0], sk2 = yk[0] * yk[0];
#pragma unroll
        for (int p = 1; p < 4; ++p) { sq2 = sq2 + yq[p] * yq[p]; sk2 = sk2 + yk[p] * yk[p]; }
        float sq = sq2.x + sq2.y, sk = sk2.x + sk2.y;
        sq += sx<1>(sq); sk += sx<1>(sk); sq += sx<2>(sq); sk += sx<2>(sk); sq += sx<4>(sq); sk += sx<4>(sk); sq += sx<8>(sq); sk += sx<8>(sk);
        const float rq_ = 0.08838834764831845f * frsq(sq + RMS_EPS), rk_ = frsq(sk + RMS_EPS), be = bet[cl] * egam[cl], bv = bet[cl];
        u32x4 qw, kw;
#pragma unroll
        for (int p = 0; p < 4; ++p) { const f32x2 qs = yq[p] * rq_, ks = yk[p] * rk_; qw[p] = pg8::cvt_pk_bf16(qs.x, qs.y); kw[p] = pg8::cvt_pk_bf16(ks.x, ks.y); kbp[pass][p] = ks * be; vbp[pass][p] = yv[p] * bv; }
        *(LAS u32x4*)(lds + GA_Q + cl * 272 + cg * 16) = qw; *(LAS u32x4*)(lds + GA_K + cl * 272 + cg * 16) = kw; }
#pragma unroll
      for (int j = 0; j < 8; ++j) { const float k0v = (j & 1) ? kbp[0][j >> 1].y : kbp[0][j >> 1].x, k1v = (j & 1) ? kbp[1][j >> 1].y : kbp[1][j >> 1].x, v0v = (j & 1) ? vbp[0][j >> 1].y : vbp[0][j >> 1].x, v1v = (j & 1) ? vbp[1][j >> 1].y : vbp[1][j >> 1].x;
          const int so = (8 * cg + j) * 144 + ((((cl0 >> 3) ^ (cg & 7)) << 3) + (cl0 & 7)) * 2;
          *(LAS unsigned*)(lds + GA_KBT + so) = pg8::cvt_pk_bf16(k0v, k1v); *(LAS unsigned*)(lds + GA_VBT + so) = pg8::cvt_pk_bf16(v0v, v1v); } }
    if (unext >= 0) gdn_a_prefetch(c, g, unext, R);
    LDS_BAR(); AMP_END(17) }
    { AMP_BEGIN(18)
    { const int w = c.wave & 3, rb = w >> 1, cb = w & 1; const bool isqk = c.wave >= 4;
      f32x16 acc;
#pragma unroll
      for (int r = 0; r < 16; ++r) acc[r] = 0.f;
      const bool zero = isqk ? (rb == 1 && cb == 0) : (rb == 0 && cb == 1);
      if (!zero) { const LAS unsigned char* ap = lds + GA_K + (32 * rb + l31) * 272 + hh * 16; const LAS unsigned char* bp = lds + (isqk ? GA_Q : GA_K) + (32 * cb + l31) * 272 + hh * 16;
#pragma unroll
          for (int ks = 0; ks < 8; ++ks) acc = __builtin_amdgcn_mfma_f32_32x32x16_bf16(*(const LAS bf16x8*)(ap + ks * 32), *(const LAS bf16x8*)(bp + ks * 32), acc, 0, 0, 0); }
      const int colx = 32 * cb + l31; const float gcol = gam[colx];
      if (!isqk) {
#pragma unroll
          for (int r = 0; r < 16; ++r) { const int cc = 32 * rb + 8 * (r >> 2) + 4 * hh + (r & 3); Amat[cc * GA_LD + colx] = (cc > colx) ? bet[cc] * acc[r] * fexp(gam[cc] - gcol) : 0.f; } }
      else {
#pragma unroll
          for (int r = 0; r < 16; ++r) { const int sp = 32 * rb + 8 * (r >> 2) + 4 * hh + (r & 3); acc[r] = (sp <= colx) ? acc[r] * fexp(gcol - gam[sp]) : 0.f; }
#pragma unroll
          for (int s = 0; s < 2; ++s) *(u32x4*)(img + IM_QK + ((((cb * 2 + rb) * 2 + s) * 64 + lane) * 16)) = pack8r(acc, s, 1.0f); } }
    LDS_BAR(); AMP_END(18) }
    { AMP_BEGIN(19)
    if (c.wave == 0) {
        const int blk = lane >> 4, cc = lane & 15; const LAS float* Ab = Amat + (16 * blk) * GA_LD + 16 * blk; float t[16]; const float lf = (float)cc;
#pragma unroll
        for (int i = 0; i < 16; ++i) { float s = fmaxf(1.0f - fabsf(lf - (float)i), 0.0f);
#pragma unroll
            for (int j = 0; j < i; ++j) s -= Ab[i * GA_LD + j] * t[j];
            t[i] = s; }
#pragma unroll
        for (int i = 0; i < 16; ++i) TF[(16 * blk + i) * GA_LD + 16 * blk + cc] = t[i];
    } else {
        for (int pid = c.tid - 64; pid < 2048; pid += NTHR - 64) { const int which = pid >> 10, f = (pid >> 6) & 15, ln = pid & 63, pl = ln & 31, ph = ln >> 5;
            if (which == 0) { const int ct = f >> 3, kt = (f >> 1) & 3, s = f & 1, cc = 32 * ct + pl; const float e = egam[cc];
                const LAS unsigned char* qp = lds + GA_Q + cc * 272 + (32 * kt + 16 * s + 4 * ph) * 2; const u32x2 a = *(const LAS u32x2*)qp, d = *(const LAS u32x2*)(qp + 16);
                u32x4 w; w.x = pg8::cvt_pk_bf16(bflo(a.x) * e, bfhi(a.x) * e); w.y = pg8::cvt_pk_bf16(bflo(a.y) * e, bfhi(a.y) * e); w.z = pg8::cvt_pk_bf16(bflo(d.x) * e, bfhi(d.x) * e); w.w = pg8::cvt_pk_bf16(bflo(d.y) * e, bfhi(d.y) * e);
                *(u32x4*)(img + IM_QD + (f * 64 + ln) * 16) = w; }
            else { const int kt = f >> 2, ctp = (f >> 1) & 1, s = f & 1, dk = 32 * kt + pl, c0 = 32 * ctp + 16 * s + 4 * ph; float v[8];
#pragma unroll
                for (int j = 0; j < 8; ++j) { const int cc = c0 + 8 * (j >> 2) + (j & 3); v[j] = bf1(*(const LAS bf16_t*)(lds + GA_K + cc * 272 + dk * 2)) * ekd[cc]; }
                u32x4 w; w.x = pg8::cvt_pk_bf16(v[0], v[1]); w.y = pg8::cvt_pk_bf16(v[2], v[3]); w.z = pg8::cvt_pk_bf16(v[4], v[5]); w.w = pg8::cvt_pk_bf16(v[6], v[7]);
                *(u32x4*)(img + IM_KDT + (f * 64 + ln) * 16) = w; } }
    }
    LDS_BAR(); AMP_END(19) }
    { AMP_BEGIN(20)
    { const int i15 = lane & 15, kq = lane >> 4; LAS float* XS = (LAS float*)(lds + GA_XS) + (c.wave < 3 ? c.wave : 0) * 16 * 17;
#pragma unroll 1
      for (int bi = 1; bi < 4; ++bi) {
          if (c.wave < bi) { const int cb = c.wave; f32x4 x = {0.f, 0.f, 0.f, 0.f};
#pragma unroll 1
              for (int bj = cb; bj < bi; ++bj)
#pragma unroll
                  for (int kk = 0; kk < 4; ++kk) x = __builtin_amdgcn_mfma_f32_16x16x4f32(Amat[(16 * bi + i15) * GA_LD + 16 * bj + 4 * kk + kq], TF[(16 * bj + 4 * kk + kq) * GA_LD + 16 * cb + i15], x, 0, 0, 0);
#pragma unroll
              for (int r = 0; r < 4; ++r) XS[(4 * kq + r) * 17 + i15] = x[r];
              asm volatile("s_waitcnt lgkmcnt(0)" ::: "memory");
              f32x4 t = {0.f, 0.f, 0.f, 0.f};
#pragma unroll
              for (int kk = 0; kk < 4; ++kk) t = __builtin_amdgcn_mfma_f32_16x16x4f32(TF[(16 * bi + i15) * GA_LD + 16 * bi + 4 * kk + kq], XS[(4 * kk + kq) * 17 + i15], t, 0, 0, 0);
#pragma unroll
              for (int r = 0; r < 4; ++r) TF[(16 * bi + 4 * kq + r) * GA_LD + 16 * cb + i15] = -t[r]; }
          LDS_BAR(); } }
    AMP_END(20) }
    { AMP_BEGIN(21)
    { const int row = c.tid >> 3, c8 = (c.tid & 7) * 8; f32x4 a, d;
#pragma unroll
      for (int j = 0; j < 4; ++j) { a[j] = (c8 <= (row | 15)) ? TF[row * GA_LD + c8 + j] : 0.f; d[j] = (c8 <= (row | 15)) ? TF[row * GA_LD + c8 + 4 + j] : 0.f; }
      *(LAS u32x4*)(lds + GA_T + row * 144 + c8 * 2) = pack8(a, d); }
    LDS_BAR();
    { const int kt = c.wave >> 1, ct = c.wave & 1; f32x16 acc;
#pragma unroll
      for (int r = 0; r < 16; ++r) acc[r] = 0.f;
      const LAS unsigned char* ap = lds + GA_KBT + (32 * kt + l31) * 144; const LAS unsigned char* bp = lds + GA_T + (32 * ct + l31) * 144 + hh * 16; const int swz = (4 * kt + (l31 >> 3)) & 7;
#pragma unroll
      for (int ks = 0; ks < 4; ++ks) acc = __builtin_amdgcn_mfma_f32_32x32x16_bf16(*(const LAS bf16x8*)(ap + (((hh + 2 * ks) ^ swz) << 4)), *(const LAS bf16x8*)(bp + ks * 32), acc, 0, 0, 0);
#pragma unroll
      for (int s = 0; s < 2; ++s) *(u32x4*)(img + IM_W + ((((ct * 4 + kt) * 2 + s) * 64 + lane) * 16)) = pack8r(acc, s, -1.0f); }
    { const int ct = c.wave >> 2, vt = c.wave & 3; f32x16 acc;
#pragma unroll
      for (int r = 0; r < 16; ++r) acc[r] = 0.f;
      const LAS unsigned char* ap = lds + GA_T + (32 * ct + l31) * 144 + hh * 16; const LAS unsigned char* bp = lds + GA_VBT + (32 * vt + l31) * 144; const int swz = (4 * vt + (l31 >> 3)) & 7;
#pragma unroll
      for (int ks = 0; ks < 4; ++ks) acc = __builtin_amdgcn_mfma_f32_32x32x16_bf16(*(const LAS bf16x8*)(ap + ks * 32), *(const LAS bf16x8*)(bp + (((hh + 2 * ks) ^ swz) << 4)), acc, 0, 0, 0);
#pragma unroll
      for (int s = 0; s < 2; ++s) *(u32x4*)(img + IM_UV + (((ct * 4 + vt) * 64 + lane) * 32 + s * 16)) = pack8r(acc, s, 1.0f); }
    LDS_BAR(); AMP_END(21) }
}
__device__ __forceinline__ void gdn_a_units(const P& p, Ctx& c, int g, int bh) {
    { const int h = bh & 7; const float* cw = p.in[I_CONVW]; LAS float* cwl = (LAS float*)(c.lds + GA_CW);
      for (int i = c.tid; i < 3 * 128; i += NTHR) { const int which = i >> 7, ch = i & 127; const f32x4 w4 = *(const f32x4*)(cw + (size_t)(which * 1024 + h * 128 + ch) * 4); LAS float* o = cwl + which * 512 + ch; o[0] = w4.x; o[128] = w4.y; o[256] = w4.z; o[384] = w4.w; } }
    GdnRaw R; gdn_a_prefetch(c, g, bh * 8, R);
    LDS_BAR();
    c.lane = lane_fresh(); c.tid = c.wave * 64 + c.lane;
    gdn_a_unit(p, c, g, bh * 8, R, bh * 8 + 1);
#pragma unroll 1
    for (int n = 1; n < 8; ++n) { const int u = bh * 8 + n, un = n < 7 ? u + 1 : -1;
        c.lane = lane_fresh(); c.tid = c.wave * 64 + c.lane;
        gdn_a_unit(p, c, g, u, R, un); }
}

constexpr int GS_S = 0, GS_U = 32768, GS_O = 49152, GS_WQ = 66560, GS_KK = 99328;
__device__ __forceinline__ void gdn_scan_unit(const P& p, const Ctx& c, int g, int bh) {
    const int b = bh >> 3, h = bh & 7, ct = c.wave >> 2, vt = c.wave & 3, lane = c.lane, l31 = lane & 31, hh = lane >> 5;
    LAS unsigned char* lds = c.lds;
    const bf16_t* ZS = (const bf16_t*)(c.ws + WS_ZS); bf16_t* OG = (bf16_t*)(c.ws + WS_OG); const float* GT = (const float*)(c.ws + WS_GT);
    float* SC = (float*)(c.ws + WS_SC) + (size_t)bh * 128 * 128; const float* Sin = g == 0 ? (const float*)(c.ws + WS_S1) + (size_t)h * 128 * 128 : SC;
    f32x16 S0, S1;
#pragma unroll
    for (int r = 0; r < 16; ++r) { const int dk = 8 * (r >> 2) + 4 * hh + (r & 3); S0[r] = Sin[(size_t)(64 * ct + dk) * 128 + 32 * vt + l31]; S1[r] = Sin[(size_t)(64 * ct + 32 + dk) * 128 + 32 * vt + l31]; }
#pragma unroll
    for (int s = 0; s < 2; ++s) { *(LAS u32x4*)(lds + GS_S + ((((2 * ct) * 4 + vt) * 2 + s) * 64 + lane) * 16) = pack8r(S0, s, 1.0f); *(LAS u32x4*)(lds + GS_S + ((((2 * ct + 1) * 4 + vt) * 2 + s) * 64 + lane) * 16) = pack8r(S1, s, 1.0f); }
    const unsigned char* img0 = c.ws + WS_IMG + (size_t)(bh * 8) * UNIT_BYTES;
    u32x4 t0[4], t1[3], uv0, uv1; float gtn;
    { const unsigned char* img = img0;
#pragma unroll
      for (int i = 0; i < 4; ++i) t0[i] = *(const u32x4*)(img + IM_W + (size_t)(i * NTHR + c.tid) * 16);
#pragma unroll
      for (int i = 0; i < 3; ++i) t1[i] = *(const u32x4*)(img + IM_QK + (size_t)(i * NTHR + c.tid) * 16);
      uv0 = *(const u32x4*)(img + IM_UV + ((ct * 4 + vt) * 64 + lane) * 32); uv1 = *(const u32x4*)(img + IM_UV + ((ct * 4 + vt) * 64 + lane) * 32 + 16);
      gtn = __hip_atomic_load(GT + bh * 8, __ATOMIC_RELAXED, __HIP_MEMORY_SCOPE_AGENT); }
    auto chunk = [&](const int n) __attribute__((always_inline)) {
#pragma unroll
        for (int i = 0; i < 4; ++i) *(LAS u32x4*)(lds + GS_WQ + (i * NTHR + c.tid) * 16) = t0[i];
#pragma unroll
        for (int i = 0; i < 3; ++i) *(LAS u32x4*)(lds + GS_KK + (i * NTHR + c.tid) * 16) = t1[i];
        f32x16 U, O;
        U[0] = bflo(uv0.x); U[1] = bfhi(uv0.x); U[2] = bflo(uv0.y); U[3] = bfhi(uv0.y); U[4] = bflo(uv0.z); U[5] = bfhi(uv0.z); U[6] = bflo(uv0.w); U[7] = bfhi(uv0.w);
        U[8] = bflo(uv1.x); U[9] = bfhi(uv1.x); U[10] = bflo(uv1.y); U[11] = bfhi(uv1.y); U[12] = bflo(uv1.z); U[13] = bfhi(uv1.z); U[14] = bflo(uv1.w); U[15] = bfhi(uv1.w);
        const float gt = gtn;
#pragma unroll
        for (int r = 0; r < 16; ++r) O[r] = 0.f;
        LDS_BAR();
        { const unsigned char* img = img0 + (size_t)(n < 7 ? n + 1 : 7) * UNIT_BYTES;
#pragma unroll
          for (int i = 0; i < 4; ++i) t0[i] = *(const u32x4*)(img + IM_W + (size_t)(i * NTHR + c.tid) * 16);
#pragma unroll
          for (int i = 0; i < 3; ++i) t1[i] = *(const u32x4*)(img + IM_QK + (size_t)(i * NTHR + c.tid) * 16);
          uv0 = *(const u32x4*)(img + IM_UV + ((ct * 4 + vt) * 64 + lane) * 32); uv1 = *(const u32x4*)(img + IM_UV + ((ct * 4 + vt) * 64 + lane) * 32 + 16);
          gtn = __hip_atomic_load(GT + bh * 8 + (n < 7 ? n + 1 : 7), __ATOMIC_RELAXED, __HIP_MEMORY_SCOPE_AGENT); }
        const int zc = c.tid >> 3, zseg = c.tid & 7; const size_t zrow = (size_t)b * TSL + n * 64 + zc;
        const u32x4 z0 = *(const u32x4*)(ZS + zrow * D + h * 128 + zseg * 16), z1 = *(const u32x4*)(ZS + zrow * D + h * 128 + zseg * 16 + 8);
        f32x4 nwv[4];
#pragma unroll
        for (int j = 0; j < 4; ++j) nwv[j] = *(const f32x4*)(p.in[I_GNW] + zseg * 16 + 4 * j);
#pragma unroll
        for (int kt = 0; kt < 4; ++kt)
#pragma unroll
            for (int s = 0; s < 2; ++s) { const bf16x8 sb = *(const LAS bf16x8*)(lds + GS_S + (((kt * 4 + vt) * 2 + s) * 64 + lane) * 16);
                const bf16x8 aw = *(const LAS bf16x8*)(lds + GS_WQ + (((ct * 4 + kt) * 2 + s) * 64 + lane) * 16), aq = *(const LAS bf16x8*)(lds + GS_WQ + 16384 + (((ct * 4 + kt) * 2 + s) * 64 + lane) * 16);
                U = __builtin_amdgcn_mfma_f32_32x32x16_bf16(aw, sb, U, 0, 0, 0); O = __builtin_amdgcn_mfma_f32_32x32x16_bf16(aq, sb, O, 0, 0, 0); }
#pragma unroll
        for (int s = 0; s < 2; ++s) *(LAS u32x4*)(lds + GS_U + (((ct * 4 + vt) * 2 + s) * 64 + lane) * 16) = pack8r(U, s, 1.0f);
        LDS_BAR();
#pragma unroll
        for (int r = 0; r < 16; ++r) { S0[r] *= gt; S1[r] *= gt; }
#pragma unroll
        for (int cp = 0; cp < 2; ++cp)
#pragma unroll
            for (int s = 0; s < 2; ++s) { const bf16x8 ub = *(const LAS bf16x8*)(lds + GS_U + (((cp * 4 + vt) * 2 + s) * 64 + lane) * 16);
                const bf16x8 aqk = *(const LAS bf16x8*)(lds + GS_KK + (((ct * 2 + cp) * 2 + s) * 64 + lane) * 16);
                const bf16x8 ak0 = *(const LAS bf16x8*)(lds + GS_KK + 8192 + ((((2 * ct) * 2 + cp) * 2 + s) * 64 + lane) * 16), ak1 = *(const LAS bf16x8*)(lds + GS_KK + 8192 + ((((2 * ct + 1) * 2 + cp) * 2 + s) * 64 + lane) * 16);
                O = __builtin_amdgcn_mfma_f32_32x32x16_bf16(aqk, ub, O, 0, 0, 0); S0 = __builtin_amdgcn_mfma_f32_32x32x16_bf16(ak0, ub, S0, 0, 0, 0); S1 = __builtin_amdgcn_mfma_f32_32x32x16_bf16(ak1, ub, S1, 0, 0, 0); }
#pragma unroll
        for (int r = 0; r < 16; ++r) { const int cc = 32 * ct + 8 * (r >> 2) + 4 * hh + (r & 3); *(LAS bf16_t*)(lds + GS_O + cc * 272 + (32 * vt + l31) * 2) = (bf16_t)f2bf(O[r]); }
#pragma unroll
        for (int s = 0; s < 2; ++s) { *(LAS u32x4*)(lds + GS_S + ((((2 * ct) * 4 + vt) * 2 + s) * 64 + lane) * 16) = pack8r(S0, s, 1.0f); *(LAS u32x4*)(lds + GS_S + ((((2 * ct + 1) * 4 + vt) * 2 + s) * 64 + lane) * 16) = pack8r(S1, s, 1.0f); }
        LDS_BAR();
        { f32x4 o[4]; float ss = 0.f;
          const u32x4 w0 = *(const LAS u32x4*)(lds + GS_O + zc * 272 + zseg * 32), w1 = *(const LAS u32x4*)(lds + GS_O + zc * 272 + zseg * 32 + 16);
          unpack8(w0, o[0], o[1]); unpack8(w1, o[2], o[3]);
#pragma unroll
          for (int j = 0; j < 4; ++j) ss += (o[j].x * o[j].x + o[j].y * o[j].y) + (o[j].z * o[j].z + o[j].w * o[j].w);
          ss += sx<1>(ss); ss += sx<2>(ss); ss += sx<4>(ss);
          const float rn = frsq(ss * (1.f / 128.f) + RMS_EPS);
          f32x4 z[4]; unpack8(z0, z[0], z[1]); unpack8(z1, z[2], z[3]);
#pragma unroll
          for (int j = 0; j < 4; ++j) o[j] = o[j] * rn * nwv[j] * z[j];
          *(u32x4*)(OG + zrow * D + h * 128 + zseg * 16) = pack8(o[0], o[1]); *(u32x4*)(OG + zrow * D + h * 128 + zseg * 16 + 8) = pack8(o[2], o[3]); }
    };
    chunk(0);
#pragma unroll 1
    for (int n = 1; n < 8; ++n) chunk(n);
    { int l2 = l31, h2 = hh; asm volatile("" : "+v"(l2), "+v"(h2));
#pragma unroll
      for (int r = 0; r < 16; ++r) { const int dk = 8 * (r >> 2) + 4 * h2 + (r & 3); SC[(size_t)(64 * ct + dk) * 128 + 32 * vt + l2] = S0[r]; SC[(size_t)(64 * ct + 32 + dk) * 128 + 32 * vt + l2] = S1[r]; } }
    __syncthreads();
}


constexpr int NPH_G = 11, NPHASES = 1 + NG * NPH_G;
__global__ void __launch_bounds__(NTHR, 2) fwd(P p) {
    extern __shared__ __attribute__((aligned(16))) unsigned char lds_raw[];
    Ctx c; c.lds = (LAS unsigned char*)lds_raw; c.MISC = (volatile LAS unsigned*)(c.lds + MISC_OFF);
    c.tid = threadIdx.x; c.lane = c.tid & 63; c.wave = __builtin_amdgcn_readfirstlane(c.tid >> 6); c.G = gridDim.x; c.ws = p.ws;
    { const int bx = blockIdx.x; const int vcu = (c.G % 8 == 0) ? (bx % 8) * (c.G / 8) + bx / 8 : bx; c.gw = vcu * NWAVES + c.wave; c.NGW = c.G * NWAVES; }
    unsigned* ctl = (unsigned*)(p.ws + WS_CTL);
    if (c.tid < 16) c.MISC[c.tid] = 0u;
    __syncthreads();
#if MK_SINGLE
    XcdBarrier bar = xcd_barrier_post(ctl + CW_BAR, c.MISC, c.tid == 0);
#define SEAM(k) do { if (IN(k) && IN((k) + 1)) { FRESH(); xcd_barrier(bar, c.tid == 0); } } while (0)
#else
#define SEAM(k) do { } while (0)
#endif
#ifndef PHASE_MASK
#define PHASE_MASK 0xFFFF
#endif
#define IN(k) (p.ph_lo <= (k) && (k) < p.ph_hi)
#define ON(j) (((PHASE_MASK) >> (j)) & 1)
    const int bx = blockIdx.x;
#if defined(__HIP_DEVICE_COMPILE__)
    typedef const P __attribute__((address_space(4)))* KP;
    KP kp0 = (KP)__builtin_amdgcn_kernarg_segment_ptr();
#define PLOAD() KP kp_ = kp0; asm volatile("" : "+s"(kp_)); const P q = *kp_;
#else
#define PLOAD() const P q = p;
#endif
#define FRESH() do { c.lane = lane_fresh(); c.tid = c.wave * 64 + c.lane; } while (0)
    { AMP_BEGIN(11) if (ON(11) && IN(0)) { FRESH(); PLOAD(); phase_prep(q, c); __syncthreads(); FRESH(); stage_gb(c, q.in[I_ELG], q.in[I_ELB], (LAS float*)(c.lds + GB_EMB)); __syncthreads(); phase_ln0(q, c, 0, c.gw, c.NGW, GB_EMB); }
    SEAM(0); AMP_END(11) }
    for (int g = 0; g < NG; ++g) {
        const int pb = 1 + g * NPH_G;
        { AMP_BEGIN(1)
        if (ON(1) && IN(pb + 1)) { FRESH(); PLOAD();
#if G1_FP8
            SchedStd S; S.init(TOK, N1, D, c.G, bx, q.ws + WS_H0Q, q.ws + WS_WIN);
#else
            SchedStd S; S.init(TOK, N1, 2 * D, c.G, bx, q.ws + WS_H0, q.ws + WS_WIN);
#endif
            if (g == 0 && bx >= 256 - NHG) { meta_state(q, c, bx - (256 - NHG), c.lds); FRESH(); }
            EpiG1 E{(bf16_t*)(q.ws + WS_QKVG), (bf16_t*)(q.ws + WS_ZS), (bf16_t*)(q.ws + WS_QS), (bf16_t*)(q.ws + WS_KSF), (bf16_t*)(q.ws + WS_VSF), (bf16_t*)(q.ws + WS_SG), (bf16_t*)(q.ws + WS_SS), g, G1_FP8 ? W8_INV : 1.0f,
                    (float*)(q.ws + WS_BETA), (float*)(q.ws + WS_LOGG), q.in[I_ALOG], q.in[I_DTB]};
#if G1_FP8
            pg8::gemm_phase<EpiG1, SchedStd, true, true, true>(c.lds, D, S, E, c.wave);
#else
            pg8::gemm_phase<EpiG1, SchedStd, true, true>(c.lds, 2 * D, S, E, c.wave);
#endif
            if (bx >= 192) { FRESH(); const int base = MW_PRO + g * MW_TAIL; moe_convert(q, c, base + (bx - 192) * NWAVES + c.wave, 64 * NWAVES, base + MW_TAIL); }
        }
        SEAM(pb + 1); AMP_END(1) }
        { AMP_BEGIN(2)
        if (ON(2) && IN(pb + 2)) { FRESH(); PLOAD();
            { AMP_BEGIN(12) for (int bh = bx; bh < BATCH * NHG; bh += c.G) { { AMP_BEGIN(14) gdn_a_units(q, c, g, bh); AMP_END(14) }
                asm volatile("s_waitcnt vmcnt(0)" ::: "memory"); __syncthreads();
                FRESH(); gdn_scan_unit(q, c, g, bh); } AMP_END(12) }
            { AMP_BEGIN(13) for (int u = bx; u < BATCH * NHK * 4; u += c.G) { FRESH(); swa_unit(q, c, g, u); } AMP_END(13) }
        }
        SEAM(pb + 2); AMP_END(2) }
        { AMP_BEGIN(4)
        if (ON(4) && IN(pb + 4)) { FRESH(); PLOAD();
            SchedPair S; S.init(TOK, D, 2 * D, c.G, bx, q.ws + WS_OG, q.ws + WS_WBG, q.ws + WS_OSW, q.ws + WS_WBS);
            EpiBr E{(const bf16_t*)(q.ws + WS_SG), (const bf16_t*)(q.ws + WS_SS), (bf16_t*)(q.ws + WS_Y)};
            pg8::gemm_phase<EpiBr, SchedPair, true, true>(c.lds, 2 * D, S, E, c.wave);
        }
        SEAM(pb + 4); AMP_END(4) }
        { AMP_BEGIN(5)
        if (ON(5) && IN(pb + 5)) { FRESH(); PLOAD();
            SchedStd S; S.init(TOK, D, 2 * D, c.G, bx, q.ws + WS_Y, q.ws + WS_WOUT);
            EpiOut E{(const bf16_t*)(q.ws + WS_H0), (bf16_t*)(q.ws + WS_PRE1)};
            pg8::gemm_phase<EpiOut, SchedStd, true, true>(c.lds, 2 * D, S, E, c.wave);
        }
        SEAM(pb + 5); AMP_END(5) }
        { AMP_BEGIN(6)
        if (ON(6) && IN(pb + 6)) { FRESH(); PLOAD(); phase_ln1_router(q, c, g, g + 1 < NG ? g + 1 : -1); }
        SEAM(pb + 6); AMP_END(6) }
        if ((g % NP) == NP - 1) {
        const int pr = g / NP;
        { AMP_BEGIN(8)
        if (ON(8) && IN(pb + 8)) { FRESH(); PLOAD();
            const int ntiles = moe_tables(c, pr);
            LAS unsigned short* tokt = (LAS unsigned short*)(c.lds + RING_BYTES);
            const int* RTOK = (const int*)(q.ws + WS_RTOK); const int nwg_ = ntiles * 8;
#pragma unroll 1
            for (int win = 0; win < 2; ++win) {
                { int tv[9];
#pragma unroll
                  for (int k = 0; k < 9; ++k) { const int it = c.tid + NTHR * k, i = it >> 8, R = it & 255, L = (i + 17 * win) * c.G + bx; tv[k] = 0;
                      if (i < 17 && L < nwg_) { const int rt = xcd_chunk(L, nwg_) >> 3, e = (int)((volatile LAS unsigned char*)(c.MISC + MI_TE))[rt]; const unsigned pos = (unsigned)(rt * 256 + R) - c.MISC[MI_OFF + e];
                          if (pos < c.MISC[MI_CNT + e]) tv[k] = RTOK[(size_t)e * TOKP + pos]; } }
#pragma unroll
                  for (int k = 0; k < 9; ++k) { const int it = c.tid + NTHR * k, i = it >> 8, L = (i + 17 * win) * c.G + bx; if (i < 17 && L < nwg_) tokt[it] = (unsigned short)tv[k]; } }
                __syncthreads();
                SchedMoeG S; S.init(ntiles, 2 * DFF, D, c.G, bx, q.ws + WS_H1Q, q.ws + WS_W1, c.MISC + MI_TE); S.tokt = tokt; S.i0 = 17 * win; S.ni = 17;
                EpiMoe1 E{q.in[I_B1], q.ws + WS_HID};
                pg8::gemm_phase<EpiMoe1, SchedMoeG, true, true, true, true>(c.lds, D, S, E, c.wave);
                FRESH(); __syncthreads(); }
        }
        SEAM(pb + 8); AMP_END(8) }
        { AMP_BEGIN(9)
        if (ON(9) && IN(pb + 9)) { FRESH(); PLOAD();
            const int ntiles = (int)(c.MISC[MI_OFF + NEXP] >> 8);
            SchedMoe S; S.init(ntiles, D, DFF, c.G, bx, q.ws + WS_HID, q.ws + WS_W2, c.MISC + MI_TE);
            EpiMoe2 E{q.in[I_B2], (const float*)(q.ws + WS_RWW), q.ws + WS_YS, c.MISC};
            pg8::gemm_phase<EpiMoe2, SchedMoe, true, true, true>(c.lds, DFF, S, E, c.wave);
        }
        SEAM(pb + 9); AMP_END(9) }
        { AMP_BEGIN(10)
        if (ON(10) && IN(pb + 10)) { FRESH(); PLOAD(); stage_gb(c, q.in[I_L2G], q.in[I_L2B], (LAS float*)(c.lds + GB_LN2)); __syncthreads();
            phase_combine(q, c, pr); }
        SEAM(pb + 10); AMP_END(10) }
        }
    }
#if defined(EXTRA_BARRIERS) && MK_SINGLE
    for (int xb = 0; xb < EXTRA_BARRIERS; ++xb) { FRESH(); xcd_barrier(bar, c.tid == 0); }
#endif
#undef IN
#undef PLOAD
#undef FRESH
#undef SEAM
}

extern "C" void kernel_launch(void* const* d_in, const int* in_sizes, int n_in, void* d_out, int out_size, void* d_ws, size_t ws_size, hipStream_t stream) {
    static int grid = 0;
    if (grid == 0) {
        if (n_in != 23 || in_sizes[0] != BATCH * SEQ * D || out_size != BATCH * SEQ * D || ws_size < WS_END) {
            fprintf(stderr, "kernel_launch: unexpected shapes (n_in %d, in0 %d, out %d, ws %zu, need %zu); nothing launched\n", n_in, n_in > 0 ? in_sizes[0] : -1, out_size, ws_size, (size_t)WS_END); grid = -1; return; }
        int dev = 0, cus = 0;
        if (hipGetDevice(&dev) != hipSuccess || hipDeviceGetAttribute(&cus, hipDeviceAttributeMultiprocessorCount, dev) != hipSuccess) { grid = -1; return; }
        if (hipFuncSetAttribute((const void*)fwd, hipFuncAttributeMaxDynamicSharedMemorySize, LDS_BYTES) != hipSuccess) { fprintf(stderr, "kernel_launch: hipFuncSetAttribute failed\n"); grid = -1; return; }
        int per_cu = 0; (void)hipOccupancyMaxActiveBlocksPerMultiprocessor(&per_cu, (const void*)fwd, NTHR, LDS_BYTES); (void)hipGetLastError();
        if (cus != 256) { fprintf(stderr, "kernel_launch: built for a 256-CU device (one workgroup per CU, 64 token rows of a slice per workgroup in the router phase); found %d CUs; nothing launched\n", cus); grid = -1; return; }
        grid = cus;
    }
    if (grid < 0) return;
    if (hipMemsetAsync((char*)d_ws + WS_CTL, 0, CTL_ZERO_BYTES, stream) != hipSuccess) return;
    P a{};
    for (int i = 0; i < 23; ++i) a.in[i] = (const float*)d_in[i];
    a.out = (float*)d_out; a.ws = (unsigned char*)d_ws;
#if MK_SINGLE
    a.ph_lo = 0; a.ph_hi = NPHASES;
    hipLaunchKernelGGL(fwd, dim3(grid), dim3(NTHR), LDS_BYTES, stream, a);
#else
    for (int ph = 0; ph < NPHASES; ++ph) { a.ph_lo = ph; a.ph_hi = ph + 1; hipLaunchKernelGGL(fwd, dim3(grid), dim3(NTHR), LDS_BYTES, stream, a); }
#endif
}
```

```cpp
#include <hip/hip_runtime.h>
#include <cstdio>
#include <cstdint>
#ifndef MK_SINGLE
#define MK_SINGLE 1
#endif
__device__ __forceinline__ int lane_fresh() { int l; asm volatile("v_mbcnt_lo_u32_b32 %0, -1, 0\n\tv_mbcnt_hi_u32_b32 %0, -1, %0" : "=v"(l)); return l; }
template <int M> __device__ __forceinline__ float sx(float v) {
    if constexpr (M < 32) return __builtin_bit_cast(float, __builtin_amdgcn_ds_swizzle(__builtin_bit_cast(int, v), 0x1F | (M << 10)));
    else return __builtin_bit_cast(float, __builtin_amdgcn_ds_bpermute((lane_fresh() ^ M) << 2, __builtin_bit_cast(int, v))); }
__device__ __forceinline__ float shfl_up_f(float v, int o, int lane) { return __builtin_bit_cast(float, __builtin_amdgcn_ds_bpermute((lane - o) << 2, __builtin_bit_cast(int, v))); }
__device__ __forceinline__ unsigned shfl_up_u(unsigned v, int o, int lane) { return (unsigned)__builtin_amdgcn_ds_bpermute((lane - o) << 2, (int)v); }
namespace pg8 {
#define PG8_LAS __attribute__((address_space(3)))
typedef unsigned short bf16_t;
typedef short bf16x8 __attribute__((ext_vector_type(8)));
typedef float f32x4 __attribute__((ext_vector_type(4)));
typedef unsigned u32x4 __attribute__((ext_vector_type(4)));
typedef unsigned u32x2 __attribute__((ext_vector_type(2)));
constexpr int BM = 256, BK = 64, HALF = 128, HTB = HALF * BK * 2  , STAGE_BYTES = 8 * HTB, NXCD = 8, WGM = 8;
__host__ __device__ __forceinline__ int lds_byte(int r, int c) { const int st = (r >> 4) * 2 + (c >> 5), rr = r & 15, cc = c & 31, ob = rr * 64 + cc * 2; return st * 1024 + (ob ^ (((ob >> 9) & 1) << 5)); }
__host__ __device__ __forceinline__ void stage_rc(int b, int& R, int& C) { const int st = b / 1024, sb = b % 1024, swz = sb ^ (((sb >> 9) & 1) << 5); R = (st >> 1) * 16 + swz / 64; C = (st & 1) * 32 + (swz % 64) / 2; }
__host__ __device__ __forceinline__ int perm32(int rho) { const int n = rho >> 4, i = rho & 15; return 8 * (i >> 2) + 4 * n + (i & 3); }
struct Unit { int pm, pn, e, kind; const char* A; const char* B; };
typedef __bf16 bf16x2n __attribute__((ext_vector_type(2))); typedef float f32x2n __attribute__((ext_vector_type(2)));
typedef int i32x8 __attribute__((ext_vector_type(8))); typedef int i32x4 __attribute__((ext_vector_type(4)));
__device__ __forceinline__ i32x8 cat8(bf16x8 a, bf16x8 b) { const i32x4 x = __builtin_bit_cast(i32x4, a), y = __builtin_bit_cast(i32x4, b); return (i32x8){x[0], x[1], x[2], x[3], y[0], y[1], y[2], y[3]}; }
__device__ __forceinline__ unsigned cvt_pk_bf16(float lo, float hi) { return __builtin_bit_cast(unsigned, __builtin_convertvector((f32x2n){lo, hi}, bf16x2n)); }
template <class Epi, class Sched, bool ALIGN_EPI = false, bool SP2 = false, bool FP8 = false, bool GATHER = false>
__device__ __forceinline__ void gemm_phase(PG8_LAS unsigned char* lds, const int KB  , const Sched& S, const Epi& E, const int wid_in) {
    int lane_ = lane_fresh();
    const int wid = wid_in, lane = lane_, tid = wid * 64 + lane, wr = wid >> 2, wc = wid & 3, fr = lane & 15, fq = lane >> 4;
    const int nt = KB / (BK * 2);
    unsigned voffA[2], voffB[2];
#pragma unroll
    for (int i = 0; i < 2; ++i) { int R, C; stage_rc(tid * 16 + i * 8192, R, C); const int Rb = Epi::PERM ? ((R & ~31) + perm32(R & 31)) : R;
        voffA[i] = (unsigned)(R * KB + C * 2); voffB[i] = (unsigned)(Rb * KB + C * 2); }
    const size_t kstep = (size_t)(BK * 2);
    const size_t hstep = (size_t)HALF * KB;
    const size_t tstep = 2 * hstep;
    const unsigned ldsw = (unsigned)wid * 1024u;
    const int aoff = lds_byte(wr * 64 + fr, fq * 8), boff = lds_byte(wc * 32 + fr, fq * 8);
#define PG8_SA(b, h) (((b) * 2 + (h)) * HTB)
#define PG8_SB(b, h) ((4 + (b) * 2 + (h)) * HTB)
#define PG8_STAGE(bufoff, gbase, voff) do { _Pragma("unroll") for (int _i = 0; _i < 2; ++_i) \
        __builtin_amdgcn_global_load_lds((const unsigned*)((const char*)(gbase) + (voff)[_i]), (PG8_LAS unsigned*)(lds + (bufoff) + ldsw + _i * 8192), 16, 0, 0); } while (0)
#define PG8_STAGEV(bufoff, gbase, pair) PG8_STAGEV2(bufoff, gbase, pair)
#define PG8_STAGEV2(bufoff, gbase, v0, v1) do { \
        __builtin_amdgcn_global_load_lds((const unsigned*)((const char*)(gbase) + (v0)), (PG8_LAS unsigned*)(lds + (bufoff) + ldsw), 16, 0, 0); \
        __builtin_amdgcn_global_load_lds((const unsigned*)((const char*)(gbase) + (v1)), (PG8_LAS unsigned*)(lds + (bufoff) + ldsw + 8192), 16, 0, 0); } while (0)
#define PG8_CV(h) cvo[h][0], cvo[h][1]
#define PG8_XV(h) (last ? nvo[h][0] : cvo[h][0]), (last ? nvo[h][1] : cvo[h][1])
#define PG8_LD2(p0) __builtin_shufflevector(*(const PG8_LAS i32x4*)(p0), *(const PG8_LAS i32x4*)((p0) + 1024), 0, 1, 2, 3, 4, 5, 6, 7)
#define PG8_LO(v) __builtin_bit_cast(bf16x8, __builtin_shufflevector(v, v, 0, 1, 2, 3))
#define PG8_HI(v) __builtin_bit_cast(bf16x8, __builtin_shufflevector(v, v, 4, 5, 6, 7))
#define PG8_LDA(dst, b, h) do { _Pragma("unroll") for (int m = 0; m < 4; ++m) dst[m] = PG8_LD2(lds + PG8_SA(b, h) + aoff + m * 2048); } while (0)
#define PG8_LDB(dst, b, h) do { _Pragma("unroll") for (int n = 0; n < 2; ++n) dst[n] = PG8_LD2(lds + PG8_SB(b, h) + boff + n * 2048); } while (0)
#if defined(FP8_NONSCALED)
#define PG8_FP8MMA(C, Bv, Av) do { typedef long l4 __attribute__((ext_vector_type(4))); const l4 bq = __builtin_bit_cast(l4, Bv), aq = __builtin_bit_cast(l4, Av); _Pragma("unroll") for (int qq = 0; qq < 4; ++qq) C = __builtin_amdgcn_mfma_f32_16x16x32_fp8_fp8(bq[qq], aq[qq], C, 0, 0, 0); } while (0)
#else
#define PG8_FP8MMA(C, Bv, Av) asm volatile("v_mfma_scale_f32_16x16x128_f8f6f4 %0, %1, %2, %0, %3, %3 op_sel_hi:[0,0,0]" : "+v"(C) : "v"(Bv), "v"(Av), "v"(sc127))
#endif
#define PG8_MMA(ai, bj, At, Bt) do { __builtin_amdgcn_s_setprio(1); \
        if constexpr (FP8) { _Pragma("unroll") for (int m = 0; m < 4; ++m) _Pragma("unroll") for (int n = 0; n < 2; ++n) \
            PG8_FP8MMA(acc[ai][bj][m][n], Bt[n], At[m]); } \
        else { _Pragma("unroll") for (int m = 0; m < 4; ++m) _Pragma("unroll") for (int n = 0; n < 2; ++n) { \
            acc[ai][bj][m][n] = __builtin_amdgcn_mfma_f32_16x16x32_bf16(PG8_LO(Bt[n]), PG8_LO(At[m]), acc[ai][bj][m][n], 0, 0, 0); \
            acc[ai][bj][m][n] = __builtin_amdgcn_mfma_f32_16x16x32_bf16(PG8_HI(Bt[n]), PG8_HI(At[m]), acc[ai][bj][m][n], 0, 0, 0); } } \
        __builtin_amdgcn_s_setprio(0); } while (0)
#define PG8_WAIT_V(n) asm volatile("s_waitcnt vmcnt(" #n ")" ::: "memory")
#define PG8_WAIT_L(n) asm volatile("s_waitcnt lgkmcnt(" #n ")" ::: "memory")
#define PG8_BAR __builtin_amdgcn_s_barrier()
#define PG8_SCHED __builtin_amdgcn_sched_barrier(0)
    Unit cur, nxt; int ui = 0;
    if (!S.next(0, cur)) return;
    unsigned cvo[2][2], nvo[2][2];
#pragma unroll
    for (int h2 = 0; h2 < 2; ++h2)
#pragma unroll
        for (int i = 0; i < 2; ++i) { if constexpr (GATHER) { int R, C; stage_rc(tid * 16 + i * 8192, R, C); cvo[h2][i] = S.rowoff(0, h2 * HALF + R) + (unsigned)(C * 2); } else cvo[h2][i] = voffA[i] + (unsigned)(h2 * HALF * KB); nvo[h2][i] = cvo[h2][i]; }
    f32x4 acc[2][2][4][2];
#pragma unroll
    for (int a = 0; a < 2; ++a)
#pragma unroll
        for (int b = 0; b < 2; ++b)
#pragma unroll
            for (int m = 0; m < 4; ++m)
#pragma unroll
                for (int n = 0; n < 2; ++n) acc[a][b][m][n] = (f32x4){0.f, 0.f, 0.f, 0.f};
    int sc127 = 127; asm volatile("" : "+v"(sc127));
    i32x8 At[4], B0[2], B1[2];
    const char* cA = cur.A; const char* cB = cur.B;
    S.a_ready(cur);
    if constexpr (SP2) {
        PG8_STAGE(PG8_SB(0, 0), cB, voffB); PG8_STAGE(PG8_SB(0, 1), cB + hstep, voffB); PG8_STAGEV(PG8_SA(0, 0), cA, PG8_CV(0)); PG8_STAGEV(PG8_SA(0, 1), cA, PG8_CV(1));
        if (wr == 1) PG8_BAR;
        PG8_WAIT_V(2); PG8_BAR;
        PG8_STAGE(PG8_SB(1, 0), cB + kstep, voffB); PG8_STAGEV(PG8_SA(1, 0), cA + kstep, PG8_CV(0)); PG8_STAGE(PG8_SB(1, 1), cB + hstep + kstep, voffB);
        PG8_WAIT_V(6); PG8_BAR;
    } else {
        PG8_STAGE(PG8_SB(0, 0), cB, voffB); PG8_STAGEV(PG8_SA(0, 0), cA, PG8_CV(0)); PG8_STAGE(PG8_SB(0, 1), cB + hstep, voffB); PG8_STAGEV(PG8_SA(0, 1), cA, PG8_CV(1));
        if (wr == 1) PG8_BAR;
        PG8_WAIT_V(4); PG8_BAR;
        PG8_STAGE(PG8_SB(1, 0), cB + kstep, voffB); PG8_STAGEV(PG8_SA(1, 0), cA + kstep, PG8_CV(0)); PG8_STAGE(PG8_SB(1, 1), cB + hstep + kstep, voffB);
        PG8_WAIT_V(6); PG8_BAR;
    }
    for (;;) {
        const bool has_next = S.next(ui + 1, nxt);
        if constexpr (GATHER) { if (has_next) {
#pragma unroll
            for (int h2 = 0; h2 < 2; ++h2)
#pragma unroll
                for (int i = 0; i < 2; ++i) { int R, C; stage_rc(tid * 16 + i * 8192, R, C); nvo[h2][i] = S.rowoff(ui + 1, h2 * HALF + R) + (unsigned)(C * 2); } } }
        const char* nA = has_next ? nxt.A : cA; const char* nB = has_next ? nxt.B : cB;
#pragma unroll 1
        for (int t = 0; t < nt; t += 2) {
            const bool last = (t == nt - 2);
            const char* a1 = cA + (size_t)(t + 1) * kstep;
            const char* a2 = last ? nA : cA + (size_t)(t + 2) * kstep; const char* b2 = last ? nB : cB + (size_t)(t + 2) * kstep;
            const char* a3 = a2 + kstep; const char* b3 = b2 + kstep;
            if (last && has_next) S.a_ready(nxt);
            if constexpr (SP2) {
            PG8_LDB(B0, 0, 0); PG8_LDB(B1, 0, 1); PG8_SCHED; PG8_LDA(At, 0, 0); PG8_STAGEV(PG8_SA(1, 1), a1, PG8_CV(1));
            PG8_WAIT_V(8); PG8_WAIT_L(0); PG8_BAR; PG8_MMA(0, 0, At, B0); PG8_MMA(0, 1, At, B1); PG8_BAR; PG8_SCHED;
            PG8_LDA(At, 0, 1); PG8_STAGE(PG8_SB(0, 0), b2, voffB); PG8_STAGE(PG8_SB(0, 1), b2 + hstep, voffB); PG8_STAGEV(PG8_SA(0, 0), a2, PG8_XV(0));
            PG8_WAIT_V(8); PG8_WAIT_L(0); PG8_BAR; PG8_MMA(1, 0, At, B0); PG8_MMA(1, 1, At, B1); PG8_BAR; PG8_SCHED;
            PG8_LDB(B0, 1, 0); PG8_LDB(B1, 1, 1); PG8_SCHED; PG8_LDA(At, 1, 0); PG8_STAGEV(PG8_SA(0, 1), a2, PG8_XV(1));
            PG8_WAIT_V(8); PG8_WAIT_L(0); PG8_BAR; PG8_MMA(0, 0, At, B0); PG8_MMA(0, 1, At, B1); PG8_BAR; PG8_SCHED;
            PG8_LDA(At, 1, 1); PG8_STAGE(PG8_SB(1, 0), b3, voffB); PG8_STAGE(PG8_SB(1, 1), b3 + hstep, voffB); PG8_STAGEV(PG8_SA(1, 0), a3, PG8_XV(0));
            PG8_WAIT_V(8); PG8_WAIT_L(0); PG8_BAR; PG8_MMA(1, 0, At, B0); PG8_MMA(1, 1, At, B1); PG8_BAR; PG8_SCHED;
            } else {
            PG8_LDB(B0, 0, 0); PG8_SCHED; PG8_LDA(At, 0, 0); PG8_STAGEV(PG8_SA(1, 1), a1, PG8_CV(1));
            PG8_WAIT_L(8); PG8_BAR; PG8_WAIT_L(0); PG8_MMA(0, 0, At, B0); PG8_BAR; PG8_SCHED;
            PG8_LDB(B1, 0, 1); PG8_STAGE(PG8_SB(0, 0), b2, voffB);
            PG8_BAR; PG8_WAIT_L(0); PG8_MMA(0, 1, At, B1); PG8_BAR;
            PG8_LDA(At, 0, 1); PG8_STAGEV(PG8_SA(0, 0), a2, PG8_XV(0));
            PG8_BAR; PG8_WAIT_L(0); PG8_MMA(1, 0, At, B0); PG8_BAR; PG8_SCHED;
            PG8_STAGE(PG8_SB(0, 1), b2 + hstep, voffB);
            PG8_WAIT_V(6); PG8_BAR; PG8_MMA(1, 1, At, B1); PG8_BAR;
            PG8_LDB(B0, 1, 0); PG8_SCHED; PG8_LDA(At, 1, 0); PG8_STAGEV(PG8_SA(0, 1), a2, PG8_XV(1));
            PG8_WAIT_L(8); PG8_BAR; PG8_WAIT_L(0); PG8_MMA(0, 0, At, B0); PG8_BAR; PG8_SCHED;
            PG8_LDB(B1, 1, 1); PG8_STAGE(PG8_SB(1, 0), b3, voffB);
            PG8_BAR; PG8_WAIT_L(0); PG8_MMA(0, 1, At, B1); PG8_BAR;
            PG8_LDA(At, 1, 1); PG8_STAGEV(PG8_SA(1, 0), a3, PG8_XV(0));
            PG8_BAR; PG8_WAIT_L(0); PG8_MMA(1, 0, At, B0); PG8_BAR; PG8_SCHED;
            PG8_STAGE(PG8_SB(1, 1), b3 + hstep, voffB);
            PG8_WAIT_V(6); PG8_BAR; PG8_MMA(1, 1, At, B1); PG8_BAR;
            }
        }
        if constexpr (ALIGN_EPI) { if (wr == 0) PG8_BAR; }
        if constexpr (FP8) asm volatile("s_nop 15\n\ts_nop 15" ::: "memory");
        if constexpr (!Epi::AFTER_DRAIN) { int le_ = lane_fresh();
            E(acc, cur, wr, wc, le_ & 15, le_ >> 4); S.done(cur); }
        if (!has_next) break;
#pragma unroll
        for (int a = 0; a < 2; ++a)
#pragma unroll
            for (int b = 0; b < 2; ++b)
#pragma unroll
                for (int m = 0; m < 4; ++m)
#pragma unroll
                    for (int n = 0; n < 2; ++n) acc[a][b][m][n] = (f32x4){0.f, 0.f, 0.f, 0.f};
        cur = nxt; cA = nA; cB = nB; ++ui;
#pragma unroll
        for (int h2 = 0; h2 < 2; ++h2)
#pragma unroll
            for (int i = 0; i < 2; ++i) cvo[h2][i] = nvo[h2][i];
        if constexpr (ALIGN_EPI) { if (wr == 1) PG8_BAR; }
    }
    PG8_WAIT_V(0);
    if constexpr (!ALIGN_EPI) { if (wr == 0) PG8_BAR; }
    PG8_BAR;
    if constexpr (Epi::AFTER_DRAIN) { E.fused(acc, cur, wr, wc, fr, fq, lds, wid, lane); S.done(cur); }
#undef PG8_SA
#undef PG8_SB
#undef PG8_STAGE
#undef PG8_LDA
#undef PG8_LDB
#undef PG8_MMA
#undef PG8_WAIT_V
#undef PG8_WAIT_L
#undef PG8_BAR
#undef PG8_SCHED
}
}


#ifndef SWA_FAST
#define SWA_FAST 1
#endif
#ifndef G1_FP8
#define G1_FP8 1
#endif
#ifndef GDN_FAST
#define GDN_FAST 1
#endif
constexpr int D = 1024, BATCH = 32, SEQ = 2048, NMETA = 16, CIN = 7696;
constexpr int NG = 4, TSL = SEQ / NG, TOK = BATCH * TSL;
constexpr int C_QG = 0, C_KG = 1024, C_VG = 2048, C_ZG = 3072, C_BG = 4096, C_AG = 4104, C_QS = 4112, C_KS = 5136, C_VS = 5392, C_GG = 5648, C_GS = 6672;
constexpr int N1 = 7936;
constexpr int NEXP = 32, TOPK = 4, DFF = 1024, NHG = 8, NHQ = 16, NHK = 4;
constexpr int NP = 4, TOKP = NP * TOK;
constexpr int NASG = TOKP * TOPK, MAXROWS = NASG + NEXP * 256, MAXTILES = MAXROWS / 256;
constexpr float LN_EPS = 1e-5f, RMS_EPS = 1e-6f;
constexpr float DN_ALPHA = 1.189207115002721f;
constexpr int NWAVES = 8, NTHR = 512;
constexpr size_t MiB = 1u << 20;
constexpr size_t WS_CTL = 0, CTL_ZERO_BYTES = 64 * 1024;
constexpr size_t WS_PM = 1 * MiB, WS_WRT = 1 * MiB + 512 * 1024  , WS_S1 = 2 * MiB, WS_WIN = 3 * MiB, WS_WBG = 19 * MiB, WS_WBS = 21 * MiB, WS_WOUT = 23 * MiB, WS_W1 = 26 * MiB, WS_W2 = 152 * MiB;
static_assert(WS_WIN + (size_t)N1 * D * 2 <= WS_WBG && WS_WOUT + 2 * MiB <= WS_W1 && WS_W1 + 64 * MiB <= WS_W2, "weight copies overlap");
constexpr size_t WS_H0Q = 216 * MiB;
constexpr size_t WS_TOPI = 232 * MiB, WS_TOPW = 233 * MiB, WS_RANK = 234 * MiB;
constexpr size_t WS_ROWW = 249 * MiB, WS_BETA = 250 * MiB, WS_LOGG = WS_BETA + 512 * 1024;
constexpr size_t GR = 252 * MiB;
constexpr size_t WS_H0 = GR, WS_QKVG = GR + 32 * MiB, WS_ZS = GR + 128 * MiB, WS_QS = GR + 160 * MiB;
constexpr size_t WS_SG = GR + 192 * MiB, WS_SS = GR + 224 * MiB, WS_OG = GR + 256 * MiB, WS_OSW = GR + 288 * MiB, WS_Y = WS_ZS, WS_PRE1 = WS_QKVG;
constexpr size_t WS_IMG_BASE = GR + 320 * MiB;
constexpr size_t WS_KSF = GR + 464 * MiB, WS_VSF = GR + 496 * MiB, WS_SC = GR + 528 * MiB, WS_HALO = GR + 544 * MiB;
constexpr size_t WS_H1 = GR + 546 * MiB;
constexpr size_t WS_H1Q = GR + 674 * MiB;
constexpr size_t WS_RTOK = GR + 738 * MiB, WS_RWW = GR + 746 * MiB;
constexpr size_t WS_Y8 = GR + 754 * MiB;
constexpr size_t WS_END = GR + 770 * MiB;
constexpr size_t WS_XS = GR, WS_HID = GR, WS_YS = GR + 264 * MiB;
static_assert(WS_HID + (size_t)MAXROWS * DFF <= WS_YS && WS_YS + (size_t)MAXROWS * D <= WS_H1 && WS_HALO + 2 * MiB <= WS_H1, "moe row buffers overlay only dead buffers");
static_assert((size_t)TOKP * TOPK * 4 <= MiB && (size_t)NEXP * TOKP * 4 <= 8 * MiB && (size_t)TOKP * D * 2 <= 128 * MiB, "routing tables");
constexpr int CW_TMO = 0, CW_BAR = 4096, CW_CNT = 8192;
constexpr int RING_BYTES = 131072, MISC_OFF = 143360, LDS_BYTES = 147456;
constexpr int MI_OFF = 16, MI_CNT = 64, MI_LCNT = 96, MI_LBASE = 128, MI_TE = 160, MI_TE_CAP = (LDS_BYTES - MISC_OFF) / 4 - MI_TE;
static_assert((size_t)NMETA * CIN * 4 <= 512 * 1024 && MAXTILES * 8 <= 2 * 17 * 256 && MI_TE_CAP * 4 >= MAXTILES && TOKP <= 65536, "proj_meta fits below the router weight copy; at most 2 x 17 MoE up-projection units per workgroup; byte tile table fits the LDS MISC words; token rows fit 16 bits");

#define GAS __attribute__((address_space(1)))
#define LAS __attribute__((address_space(3)))
typedef unsigned short bf16_t;
typedef float f32x4 __attribute__((ext_vector_type(4)));
typedef float f32x2 __attribute__((ext_vector_type(2)));
typedef unsigned u32x4 __attribute__((ext_vector_type(4)));
typedef unsigned u32x2 __attribute__((ext_vector_type(2)));
#define LDS_WAIT() asm volatile("s_waitcnt lgkmcnt(0)" ::: "memory")
#define VM_WAIT() asm volatile("s_waitcnt vmcnt(0)" ::: "memory")
__device__ __forceinline__ unsigned f2bf(float f) { unsigned u = __builtin_bit_cast(unsigned, f); return (u + 0x7fffu + ((u >> 16) & 1u)) >> 16; }
__device__ __forceinline__ unsigned pk2(float lo, float hi) { return f2bf(lo) | (f2bf(hi) << 16); }
__device__ __forceinline__ float bflo(unsigned w) { return __builtin_bit_cast(float, w << 16); }
__device__ __forceinline__ float bfhi(unsigned w) { return __builtin_bit_cast(float, w & 0xffff0000u); }
__device__ __forceinline__ float bf1(bf16_t h) { return __builtin_bit_cast(float, (unsigned)h << 16); }
__device__ __forceinline__ float fexp(float x) { return __builtin_amdgcn_exp2f(x * 1.4426950408889634f); }
__device__ __forceinline__ float frcp(float x) { return __builtin_amdgcn_rcpf(x); }
__device__ __forceinline__ float frsq(float x) { return __builtin_amdgcn_rsqf(x); }
__device__ __forceinline__ float sigmoidf_(float x) { return frcp(1.0f + fexp(-x)); }
__device__ __forceinline__ float siluf_(float x) { return x * frcp(1.0f + fexp(-x)); }
__device__ __forceinline__ float softplusf_(float x) { const float e = fexp(-fabsf(x)); const float l = e < 1e-3f ? e * (1.0f - 0.5f * e) : __builtin_amdgcn_logf(1.0f + e) * 0.6931471805599453f; return fmaxf(x, 0.f) + l; }
__device__ __forceinline__ float wave_sum(float v) { v += sx<1>(v); v += sx<2>(v); v += sx<4>(v); v += sx<8>(v); v += sx<16>(v); v += sx<32>(v); return v; }

#define XB_TMO      128
#define XB_XCNT(j)  (256  + 64 * (j))
#define XB_XSUB(j)  (1280 + 64 * (j))
#define XB_XGEN(j)  (2304 + 64 * (j))
#define XB_TOP      3328
#define XB_TOPGEN   3392
#define XCD_BAR_WORDS 3456
#define XB_SPIN_CAP (1u << 18)
__device__ __forceinline__ unsigned xb_ld(unsigned* p)              { return __hip_atomic_load(p, __ATOMIC_RELAXED, __HIP_MEMORY_SCOPE_AGENT); }
__device__ __forceinline__ unsigned xb_add(unsigned* p, unsigned v) { return __hip_atomic_fetch_add(p, v, __ATOMIC_RELAXED, __HIP_MEMORY_SCOPE_AGENT); }
__device__ __forceinline__ unsigned xb_xcc_id() { return (unsigned)__builtin_amdgcn_s_getreg((3 << 11) | 20) & 0xFu; }
#define XB_SPIN(cond, bar) do { unsigned _sp = 0; while (cond) { __builtin_amdgcn_s_sleep(1); \
    if ((++_sp & 255u) == 0u) { if (xb_ld(&(bar)[XB_TMO])) break; if (_sp > XB_SPIN_CAP) { atomicAdd(&(bar)[XB_TMO], 1u); break; } } } } while (0)
struct XcdBarrier { unsigned* bar; unsigned x; volatile LAS unsigned* st; };
__device__ __forceinline__ XcdBarrier xcd_barrier_post(unsigned* bar, volatile LAS unsigned* st, bool leader) {
    XcdBarrier b; b.bar = bar; b.x = xb_xcc_id(); b.st = st;
    if (leader) (void)xb_add(&bar[XB_XCNT(b.x)], 1u);
    return b;
}
__device__ __forceinline__ void xcd_barrier_complete(unsigned* bar, unsigned x, unsigned& nloc, unsigned& nx) {
    const unsigned G = gridDim.x * gridDim.y * gridDim.z;
    unsigned sum, cnt, mine, sp = 0u;
    for (;;) {
        sum = 0u; cnt = 0u; mine = 0u;
#pragma unroll
        for (unsigned j = 0; j < 16; ++j) { const unsigned c = xb_ld(&bar[XB_XCNT(j)]); sum += c; cnt += (c > 0u) ? 1u : 0u; mine = (j == x) ? c : mine; }
        if (sum == G) break;
        __builtin_amdgcn_s_sleep(1);
        if ((++sp & 255u) == 0u) { if (xb_ld(&bar[XB_TMO])) break; if (sp > XB_SPIN_CAP) { atomicAdd(&bar[XB_TMO], 1u); break; } }
    }
    nloc = mine > 0u ? mine : 1u; nx = cnt > 0u ? cnt : 1u;
}
__device__ __forceinline__ void xcd_barrier(const XcdBarrier& b, bool leader) {
    asm volatile("s_waitcnt vmcnt(0)" ::: "memory");
    __syncthreads();
    if (leader) {
        unsigned* bar = b.bar;
        __builtin_amdgcn_s_waitcnt(0);
        unsigned nloc = b.st[0], nx = b.st[1];
        if (nloc == 0u) { xcd_barrier_complete(bar, b.x, nloc, nx); b.st[0] = nloc; b.st[1] = nx; }
        const unsigned old = xb_add(&bar[XB_XSUB(b.x)], 1u);
        const unsigned gen = old / nloc;
        if (old + 1u == (gen + 1u) * nloc) {
            __builtin_amdgcn_fence(__ATOMIC_RELEASE, "agent");
            asm volatile("s_waitcnt vmcnt(0)" ::: "memory");
            const unsigned og = xb_add(&bar[XB_TOP], 1u);
            const unsigned tg = og / nx;
            if (og + 1u == (tg + 1u) * nx) xb_add(&bar[XB_TOPGEN], 1u);
            else XB_SPIN(xb_ld(&bar[XB_TOPGEN]) == tg, bar);
            __builtin_amdgcn_fence(__ATOMIC_ACQUIRE, "agent");
            xb_add(&bar[XB_XGEN(b.x)], 1u);
            asm volatile("s_waitcnt vmcnt(0)" ::: "memory");
        } else {
            XB_SPIN(xb_ld(&bar[XB_XGEN(b.x)]) == gen, bar);
            __builtin_amdgcn_fence(__ATOMIC_ACQUIRE, "agent");
            asm volatile("s_waitcnt vmcnt(0)" ::: "memory");
        }
    }
    __syncthreads();
}

struct P { const float* in[23]; float* out; unsigned char* ws; int ph_lo, ph_hi; };
enum { I_X = 0, I_META, I_ELG, I_ELB, I_WIN, I_CONVW, I_ALOG, I_DTB, I_GNW, I_SINK, I_WBG, I_WBS, I_WOUT, I_L1G, I_L1B, I_WR, I_BR, I_W1, I_B1, I_W2, I_B2, I_L2G, I_L2B };
#ifndef AMP_MASK
#define AMP_MASK 0
#endif
#ifndef AMP_F
#define AMP_F 4
#endif
#define AMP_BEGIN(j) unsigned long long amp_t0 = 0; if ((AMP_MASK >> (j)) & 1) amp_t0 = __builtin_amdgcn_s_memrealtime();
#define AMP_END(j) if ((AMP_MASK >> (j)) & 1) { const unsigned long long amp_t1 = __builtin_amdgcn_s_memrealtime(); const unsigned long long amp_d = (amp_t1 - amp_t0) * AMP_F; while (__builtin_amdgcn_s_memrealtime() - amp_t1 < amp_d) __builtin_amdgcn_s_sleep(16); }

__device__ __forceinline__ void std_tile(int L, int nwg, int nM, int nN, int& pm, int& pn) {
    int wgid = L; { const int q = nwg / pg8::NXCD, r = nwg % pg8::NXCD, xcd = wgid % pg8::NXCD, off = wgid / pg8::NXCD; wgid = (xcd < r ? xcd * (q + 1) : r * (q + 1) + (xcd - r) * q) + off; }
    const int nig = pg8::WGM * nN, gid = wgid / nig, fm = gid * pg8::WGM, gsz = (nM - fm) < pg8::WGM ? (nM - fm) : pg8::WGM;
    pm = fm + ((wgid % nig) % gsz); pn = (wgid % nig) / gsz;
}
__device__ __forceinline__ int xcd_chunk(int L, int nwg) {
    const int q = nwg / pg8::NXCD, r = nwg % pg8::NXCD, xcd = L % pg8::NXCD, off = L / pg8::NXCD; return (xcd < r ? xcd * (q + 1) : r * (q + 1) + (xcd - r) * q) + off;
}
struct SchedStd {
    int nM, nN, nwg, G, c; const char* A; const char* B; size_t tstep;
    __device__ __forceinline__ void init(int M, int N, int KB, int G_, int c_, const void* A_, const void* B_) { nM = M / 256; nN = N / 256; nwg = nM * nN; G = G_; c = c_; A = (const char*)A_; B = (const char*)B_; tstep = (size_t)256 * KB; }
    __device__ __forceinline__ bool next(int i, pg8::Unit& u) const {
        const int L = i * G + c; if (L >= nwg) return false;
        int pm, pn; std_tile(L, nwg, nM, nN, pm, pn);
        u.pm = pm; u.pn = pn; u.e = 0; u.kind = 0; u.A = A + (size_t)pm * tstep; u.B = B + (size_t)pn * tstep; return true;
    }
    __device__ __forceinline__ void a_ready(const pg8::Unit&) const {}
    __device__ __forceinline__ void done(const pg8::Unit&) const {}
    __device__ __forceinline__ unsigned rowoff(int, int) const { return 0u; }
};
struct SchedPair {
    int nM, nN, nwg, G, c; const char *A0, *B0, *A1, *B1; size_t tstep;
    __device__ __forceinline__ void init(int M, int N, int KB, int G_, int c_, const void* A0_, const void* B0_, const void* A1_, const void* B1_) { nM = M / 256; nN = N / 256; nwg = nM * nN; G = G_; c = c_;
        A0 = (const char*)A0_; B0 = (const char*)B0_; A1 = (const char*)A1_; B1 = (const char*)B1_; tstep = (size_t)256 * KB; }
    __device__ __forceinline__ bool next(int i, pg8::Unit& u) const {
        const int L = (i >> 1) * G + c, kind = i & 1; if (L >= nwg) return false;
        int pm, pn; std_tile(L, nwg, nM, nN, pm, pn);
        u.pm = pm; u.pn = pn; u.e = 0; u.kind = kind; u.A = (kind ? A1 : A0) + (size_t)pm * tstep; u.B = (kind ? B1 : B0) + (size_t)pn * tstep; return true;
    }
    __device__ __forceinline__ void a_ready(const pg8::Unit&) const {}
    __device__ __forceinline__ void done(const pg8::Unit&) const {}
    __device__ __forceinline__ unsigned rowoff(int, int) const { return 0u; }
};
struct SchedMoe {
    int nN, nwg, G, c, i0, ni; const char* A; const char* W; size_t tstep, wexp; const volatile LAS unsigned char* te;
    __device__ __forceinline__ void init(int ntiles, int N, int KB, int G_, int c_, const void* A_, const void* W_, const volatile LAS unsigned* te_) { nN = N / 256; nwg = ntiles * nN; G = G_; c = c_; i0 = 0; ni = 1 << 20;
        A = (const char*)A_; W = (const char*)W_; tstep = (size_t)256 * KB; wexp = (size_t)N * KB; te = (const volatile LAS unsigned char*)te_; }
    __device__ __forceinline__ bool next(int i, pg8::Unit& u) const {
        const int L = (i + i0) * G + c; if (i >= ni || L >= nwg) return false;
        const int w = xcd_chunk(L, nwg), rt = w / nN, pn = w - rt * nN; const int e = __builtin_amdgcn_readfirstlane((int)te[rt]);
        u.pm = rt; u.pn = pn; u.e = e; u.kind = 0; u.A = A + (size_t)rt * tstep; u.B = W + (size_t)e * wexp + (size_t)pn * tstep; return true;
    }
    __device__ __forceinline__ void a_ready(const pg8::Unit&) const {}
    __device__ __forceinline__ void done(const pg8::Unit&) const {}
    __device__ __forceinline__ unsigned rowoff(int, int) const { return 0u; }
};

struct SchedMoeG : SchedMoe {
    const volatile LAS unsigned short* tokt;
    __device__ __forceinline__ bool next(int i, pg8::Unit& u) const { const bool ok = SchedMoe::next(i, u); if (ok) u.A = A; return ok; }
    __device__ __forceinline__ unsigned rowoff(int i, int Rg) const { return (unsigned)tokt[i * 256 + Rg] * (unsigned)D; }
};
using pg8::Unit;
typedef pg8::f32x4 (AccT)[2][2][4][2];
__device__ __forceinline__ u32x4 pack8(f32x4 v0, f32x4 v1) { u32x4 w; w.x = pg8::cvt_pk_bf16(v0[0], v0[1]); w.y = pg8::cvt_pk_bf16(v0[2], v0[3]); w.z = pg8::cvt_pk_bf16(v1[0], v1[1]); w.w = pg8::cvt_pk_bf16(v1[2], v1[3]); return w; }
__device__ __forceinline__ void unpack8(u32x4 w, f32x4& v0, f32x4& v1) { v0 = (f32x4){bflo(w.x), bfhi(w.x), bflo(w.y), bfhi(w.y)}; v1 = (f32x4){bflo(w.z), bfhi(w.z), bflo(w.w), bfhi(w.w)}; }
__device__ __forceinline__ unsigned pack4_fp8(float a, float b, float c2, float d) { int w = __builtin_amdgcn_cvt_pk_fp8_f32(a, b, 0, false); w = __builtin_amdgcn_cvt_pk_fp8_f32(c2, d, w, true); return (unsigned)w; }
constexpr float W8_SCALE = 64.0f, W8_INV = 1.0f / 64.0f, YS_SCALE = 64.0f, YS_INV = 1.0f / 64.0f;
struct EpiG1 {
    static constexpr bool PERM = true, AFTER_DRAIN = false;
    bf16_t *qkvg, *zs, *qs, *ks, *vs, *sg, *ss; int g;
    float asc;
    float *beta, *logg; const float *alog, *dtb;
    __device__ __forceinline__ void operator()(const AccT& acc, const Unit& u, int wr, int wc, int fr, int fq) const {
        if (u.pn == 30) {
            if (wc == 0 && fq < 2) {
                float ea[8], db[8];
#pragma unroll
                for (int h = 0; h < 8; ++h) { ea[h] = alog[h]; db[h] = dtb[h]; }
#pragma unroll
                for (int h = 0; h < 8; ++h) ea[h] = -fexp(ea[h]);
#pragma unroll
                for (int ai = 0; ai < 2; ++ai)
#pragma unroll
                    for (int m = 0; m < 4; ++m) { const size_t r = (size_t)(u.pm * 256 + ai * 128 + wr * 64 + m * 16 + fr);
#pragma unroll
                        for (int n = 0; n < 2; ++n) { f32x4 o;
#pragma unroll
                            for (int i = 0; i < 4; ++i) { const int h = 4 * n + i; const float x = acc[ai][0][m][n][i] * asc; o[i] = fq == 0 ? sigmoidf_(x) : ea[h] * softplusf_(x + db[h]); }
                            *(f32x4*)((fq == 0 ? beta : logg) + r * 8 + 4 * n) = o; } } }
            return; }
        const int pn = u.pn; bf16_t* base; int ldc, colt, act = 0; float sc = 1.f; const bool kv = (pn == 20 || pn == 21);
        if (pn < 12) { base = qkvg; ldc = 3072; colt = pn * 256; }
        else if (pn < 16) { base = zs; ldc = 1024; colt = (pn - 12) * 256; act = 1; }
        else if (pn < 20) { base = qs; ldc = 1024; colt = (pn - 16) * 256; sc = 0.125f * 1.4426950408889634f; }
        else if (pn == 20) { base = ks; ldc = 256; colt = 0; }
        else if (pn == 21) { base = vs; ldc = 256; colt = 0; }
        else if (pn < 26) { base = sg; ldc = 1024; colt = (pn - 22) * 256; act = 2; }
        else { base = ss; ldc = 1024; colt = (pn - 26) * 256; act = 2; }
        const int row0 = u.pm * 256 + wr * 64 + fr, col0 = colt + wc * 32 + 8 * fq; const float asc_sc = asc * sc, nl2e_asc = -1.4426950408889634f * asc;
#pragma unroll
        for (int ai = 0; ai < 2; ++ai)
#pragma unroll
            for (int m = 0; m < 4; ++m) { const int r = row0 + ai * 128 + m * 16, rr = kv ? ((r >> 9) * SEQ + g * TSL + (r & (TSL - 1))) : r; bf16_t* rowp = base + (size_t)rr * ldc + col0;
#pragma unroll
                for (int bj = 0; bj < 2; ++bj) { f32x4 v0, v1;
                    if (act == 0) { v0 = acc[ai][bj][m][0] * asc_sc; v1 = acc[ai][bj][m][1] * asc_sc; }
                    else {
#pragma unroll
                        for (int n = 0; n < 2; ++n)
#pragma unroll
                            for (int hh = 0; hh < 2; ++hh) { const f32x2 a = {acc[ai][bj][m][n][2 * hh], acc[ai][bj][m][n][2 * hh + 1]};
                                f32x2 t = a * nl2e_asc; t.x = __builtin_amdgcn_exp2f(t.x); t.y = __builtin_amdgcn_exp2f(t.y); t = t + 1.0f; t.x = __builtin_amdgcn_rcpf(t.x); t.y = __builtin_amdgcn_rcpf(t.y);
                                if (act == 1) t = t * (a * asc);
                                if (n == 0) { v0[2 * hh] = t.x; v0[2 * hh + 1] = t.y; } else { v1[2 * hh] = t.x; v1[2 * hh + 1] = t.y; } } }
                    *(u32x4*)(rowp + bj * 128) = pack8(v0, v1); } }
    }
};
struct EpiBr {
    static constexpr bool PERM = true, AFTER_DRAIN = false;
    const bf16_t *sg, *ss; bf16_t* y; unsigned char* y8;
    template <bool K1>
    __device__ __forceinline__ void body(const AccT& acc, const bf16_t* __restrict__ gate, const bf16_t* yin, bf16_t* yout, const int row0, const int col0) const {
#pragma unroll
        for (int ai = 0; ai < 2; ++ai) { u32x4 gv[4][2], yv[4][2];
#pragma unroll
            for (int m = 0; m < 4; ++m) { const size_t off = (size_t)(row0 + ai * 128 + m * 16) * D + col0;
#pragma unroll
                for (int bj = 0; bj < 2; ++bj) { gv[m][bj] = *(const u32x4*)(gate + off + bj * 128); if constexpr (K1) yv[m][bj] = *(const u32x4*)(yin + off + bj * 128); } }
#pragma unroll
            for (int m = 0; m < 4; ++m) { const size_t off = (size_t)(row0 + ai * 128 + m * 16) * D + col0;
#pragma unroll
                for (int bj = 0; bj < 2; ++bj) { f32x4 g0, g1; unpack8(gv[m][bj], g0, g1);
                    f32x4 v0 = acc[ai][bj][m][0] * g0, v1 = acc[ai][bj][m][1] * g1;
                    if constexpr (K1) { f32x4 y0, y1; unpack8(yv[m][bj], y0, y1); v0 = v0 + y0; v1 = v1 + y1;
                        u32x2 w8; w8.x = pack4_fp8(v0[0] * 16.f, v0[1] * 16.f, v0[2] * 16.f, v0[3] * 16.f); w8.y = pack4_fp8(v1[0] * 16.f, v1[1] * 16.f, v1[2] * 16.f, v1[3] * 16.f); *(u32x2*)(y8 + off + bj * 128) = w8; }
                    else *(u32x4*)(yout + off + bj * 128) = pack8(v0, v1); } } }
    }
    __device__ __forceinline__ void operator()(const AccT& acc, const Unit& u, int wr, int wc, int fr, int fq) const {
        const int row0 = u.pm * 256 + wr * 64 + fr, col0 = u.pn * 256 + wc * 32 + 8 * fq;
        if (u.kind) body<true>(acc, ss, y, y, row0, col0); else body<false>(acc, sg, y, y, row0, col0);
    }
};
struct EpiBr0 { static constexpr bool PERM = true, AFTER_DRAIN = false; EpiBr b; float asc;
    __device__ __forceinline__ void operator()(const AccT& acc, const Unit& u, int wr, int wc, int fr, int fq) const {
        AccT a2;
#pragma unroll
        for (int ai = 0; ai < 2; ++ai)
#pragma unroll
            for (int bj = 0; bj < 2; ++bj)
#pragma unroll
                for (int m = 0; m < 4; ++m)
#pragma unroll
                    for (int n = 0; n < 2; ++n) a2[ai][bj][m][n] = acc[ai][bj][m][n] * asc;
        b.body<false>(a2, b.sg, b.y, b.y, u.pm * 256 + wr * 64 + fr, u.pn * 256 + wc * 32 + 8 * fq); } };
struct EpiBr1 { static constexpr bool PERM = true, AFTER_DRAIN = false; EpiBr b; float asc;
    __device__ __forceinline__ void operator()(const AccT& acc, const Unit& u, int wr, int wc, int fr, int fq) const {
        AccT a2;
#pragma unroll
        for (int ai = 0; ai < 2; ++ai)
#pragma unroll
            for (int bj = 0; bj < 2; ++bj)
#pragma unroll
                for (int m = 0; m < 4; ++m)
#pragma unroll
                    for (int n = 0; n < 2; ++n) a2[ai][bj][m][n] = acc[ai][bj][m][n] * asc;
        b.body<true>(a2, b.ss, b.y, b.y, u.pm * 256 + wr * 64 + fr, u.pn * 256 + wc * 32 + 8 * fq); } };
struct EpiOut {
    static constexpr bool PERM = true, AFTER_DRAIN = false;
    const bf16_t* h0; bf16_t* pre1; float asc;
    __device__ __forceinline__ void operator()(const AccT& acc, const Unit& u, int wr, int wc, int fr, int fq) const {
        const int row0 = u.pm * 256 + wr * 64 + fr, col0 = u.pn * 256 + wc * 32 + 8 * fq;
#pragma unroll
        for (int ai = 0; ai < 2; ++ai) { u32x4 hv[4][2];
#pragma unroll
            for (int m = 0; m < 4; ++m) { const size_t off = (size_t)(row0 + ai * 128 + m * 16) * D + col0;
#pragma unroll
                for (int bj = 0; bj < 2; ++bj) hv[m][bj] = *(const u32x4*)(h0 + off + bj * 128); }
#pragma unroll
            for (int m = 0; m < 4; ++m) { const size_t off = (size_t)(row0 + ai * 128 + m * 16) * D + col0;
#pragma unroll
                for (int bj = 0; bj < 2; ++bj) { f32x4 h0a, h0b; unpack8(hv[m][bj], h0a, h0b);
                    *(u32x4*)(pre1 + off + bj * 128) = pack8(h0a * DN_ALPHA + acc[ai][bj][m][0] * asc, h0b * DN_ALPHA + acc[ai][bj][m][1] * asc); } } }
    }
};
struct EpiMoe1 {
    static constexpr bool PERM = true, AFTER_DRAIN = false;
    const float* b1; unsigned char* hid;
    __device__ __forceinline__ void operator()(const AccT& acc, const Unit& u, int wr, int wc, int fr, int fq) const {
        const int row0 = u.pm * 256 + wr * 64 + fr, j0 = u.pn * 128 + wc * 32 + 8 * fq; const float* bb = b1 + (size_t)u.e * 2048 + j0;
        f32x2 bg[4], bu[4];
#pragma unroll
        for (int k = 0; k < 4; ++k) { bg[k] = *(const f32x2*)(bb + 2 * k); bu[k] = *(const f32x2*)(bb + 1024 + 2 * k) + 1.0f; }
#pragma unroll
        for (int ai = 0; ai < 2; ++ai)
#pragma unroll
            for (int m = 0; m < 4; ++m) { f32x2 o[4];
#pragma unroll
                for (int k = 0; k < 4; ++k) { const int n = k >> 1, j = (k & 1) * 2;
                    const f32x2 ga = {acc[ai][0][m][n][j], acc[ai][0][m][n][j + 1]}, ua = {acc[ai][1][m][n][j], acc[ai][1][m][n][j + 1]};
                    f32x2 g = ga * W8_INV + bg[k], up = ua * W8_INV + bu[k];
                    g.x = fminf(g.x, 7.0f); g.y = fminf(g.y, 7.0f);
                    up.x = __builtin_amdgcn_fmed3f(up.x, -6.0f, 8.0f); up.y = __builtin_amdgcn_fmed3f(up.y, -6.0f, 8.0f);
                    f32x2 t = g * (-1.702f * 1.4426950408889634f);
                    t.x = __builtin_amdgcn_exp2f(t.x); t.y = __builtin_amdgcn_exp2f(t.y);
                    t = t + 1.0f;
                    t.x = __builtin_amdgcn_rcpf(t.x); t.y = __builtin_amdgcn_rcpf(t.y);
                    o[k] = (g * t) * up; }
                u32x2 w8; w8.x = pack4_fp8(o[0].x, o[0].y, o[1].x, o[1].y); w8.y = pack4_fp8(o[2].x, o[2].y, o[3].x, o[3].y);
                *(u32x2*)(hid + (size_t)(row0 + ai * 128 + m * 16) * DFF + j0) = w8; }
    }
};
struct EpiMoe2 {
    static constexpr bool PERM = true, AFTER_DRAIN = false;
    const float* b2; const float* rww; unsigned char* ys; const volatile LAS unsigned* misc;
    __device__ __forceinline__ void operator()(const AccT& acc, const Unit& u, int wr, int wc, int fr, int fq) const {
        const int row0 = u.pm * 256 + wr * 64 + fr, col0 = u.pn * 256 + wc * 32 + 8 * fq; const float* bb = b2 + (size_t)u.e * D + col0;
        f32x4 bv[2][2];
#pragma unroll
        for (int bj = 0; bj < 2; ++bj)
#pragma unroll
            for (int n = 0; n < 2; ++n) bv[bj][n] = *(const f32x4*)(bb + bj * 128 + 4 * n);
        const unsigned eoff = misc[MI_OFF + u.e], ecnt = misc[MI_CNT + u.e]; const float* rwe = rww + (size_t)u.e * TOKP;
        float wv[2][4];
#pragma unroll
        for (int ai = 0; ai < 2; ++ai)
#pragma unroll
            for (int m = 0; m < 4; ++m) { const unsigned pos = (unsigned)(row0 + ai * 128 + m * 16) - eoff; wv[ai][m] = rwe[pos < ecnt ? pos : 0u]; }
#pragma unroll
        for (int ai = 0; ai < 2; ++ai)
#pragma unroll
            for (int m = 0; m < 4; ++m) { const int row = row0 + ai * 128 + m * 16; const unsigned pos = (unsigned)row - eoff;
                const float w64 = pos < ecnt ? wv[ai][m] * YS_SCALE : 0.f;
#pragma unroll
                for (int bj = 0; bj < 2; ++bj) { const f32x4 v0 = (acc[ai][bj][m][0] * W8_INV + bv[bj][0]) * w64, v1 = (acc[ai][bj][m][1] * W8_INV + bv[bj][1]) * w64;
                    u32x2 o8; o8.x = pack4_fp8(v0[0], v0[1], v0[2], v0[3]); o8.y = pack4_fp8(v1[0], v1[1], v1[2], v1[3]); *(u32x2*)(ys + (size_t)row * D + col0 + bj * 128) = o8; } }
    }
};

struct Ctx { LAS unsigned char* lds; volatile LAS unsigned* MISC; int tid, lane, wave, G, gw, NGW; unsigned char* ws; };

__device__ __forceinline__ void transpose_item(const float* W, int ldw, int k0, int srccol, bf16_t* WT, int ldt, int dstrow, LAS float* scr, int lane) {
    float wv_[32];
#pragma unroll
    for (int i = 0; i < 32; ++i) { const int kk = 2 * i + (lane >> 5); wv_[i] = W[(size_t)(k0 + kk) * ldw + srccol + (lane & 31)]; }
#pragma unroll
    for (int i = 0; i < 32; ++i) { const int kk = 2 * i + (lane >> 5); scr[kk * 33 + (lane & 31)] = wv_[i]; }
    LDS_WAIT(); asm volatile("" ::: "memory");
    const int c = lane & 7;
#pragma unroll
    for (int j = 0; j < 4; ++j) { const int n = (lane >> 3) + 8 * j; const LAS float* s = scr + (8 * c) * 33 + n;
        u32x4 o; o.x = pk2(s[0 * 33], s[1 * 33]); o.y = pk2(s[2 * 33], s[3 * 33]); o.z = pk2(s[4 * 33], s[5 * 33]); o.w = pk2(s[6 * 33], s[7 * 33]);
        *(u32x4*)(WT + (size_t)(dstrow + n) * ldt + k0 + 8 * c) = o; }
    LDS_WAIT(); asm volatile("" ::: "memory");
}
__device__ __forceinline__ void transpose_item8(const float* W, int ldw, int k0, int srccol, unsigned char* WT, int ldt, int dstrow, LAS float* scr, int lane) {
    float wv_[32];
#pragma unroll
    for (int i = 0; i < 32; ++i) { const int kk = 2 * i + (lane >> 5); wv_[i] = W[(size_t)(k0 + kk) * ldw + srccol + (lane & 31)]; }
#pragma unroll
    for (int i = 0; i < 32; ++i) { const int kk = 2 * i + (lane >> 5); scr[kk * 33 + (lane & 31)] = wv_[i]; }
    LDS_WAIT(); asm volatile("" ::: "memory");
    const int c = lane & 7;
#pragma unroll
    for (int j = 0; j < 4; ++j) { const int n = (lane >> 3) + 8 * j; const LAS float* s = scr + (8 * c) * 33 + n;
        u32x2 o; o.x = pack4_fp8(s[0 * 33] * W8_SCALE, s[1 * 33] * W8_SCALE, s[2 * 33] * W8_SCALE, s[3 * 33] * W8_SCALE); o.y = pack4_fp8(s[4 * 33] * W8_SCALE, s[5 * 33] * W8_SCALE, s[6 * 33] * W8_SCALE, s[7 * 33] * W8_SCALE);
        *(u32x2*)(WT + (size_t)(dstrow + n) * ldt + k0 + 8 * c) = o; }
    LDS_WAIT(); asm volatile("" ::: "memory");
}
__device__ __forceinline__ void ln_row(const float* xrow, const float* gam, const float* bet, int lane, f32x4 (&y)[4]) {
    const f32x4* xr = (const f32x4*)xrow + lane; float s = 0.f;
#pragma unroll
    for (int j = 0; j < 4; ++j) { y[j] = xr[64 * j]; s += (y[j].x + y[j].y) + (y[j].z + y[j].w); }
    const float mean = wave_sum(s) * (1.f / D); float s2 = 0.f;
#pragma unroll
    for (int j = 0; j < 4; ++j) { y[j] = y[j] - mean; s2 += (y[j].x * y[j].x + y[j].y * y[j].y) + (y[j].z * y[j].z + y[j].w * y[j].w); }
    const float rstd = frsq(wave_sum(s2) * (1.f / D) + LN_EPS);
#pragma unroll
    for (int j = 0; j < 4; ++j) { const f32x4 gv = ((const f32x4*)gam)[lane + 64 * j], bv = ((const f32x4*)bet)[lane + 64 * j]; y[j] = y[j] * rstd * gv + bv; }
}
__device__ __forceinline__ void store_row_bf16(bf16_t* orow, int lane, const f32x4 (&y)[4]) {
    u32x2* o8 = (u32x2*)orow + lane;
#pragma unroll
    for (int j = 0; j < 4; ++j) { u32x2 w; w.x = pk2(y[j].x, y[j].y); w.y = pk2(y[j].z, y[j].w); o8[64 * j] = w; }
}
constexpr int MW_I1 = 32 * 1024, MW_I2 = 32 * 512, MW_NI = MW_I1 + MW_I2;
constexpr int MW_PRO = MW_NI * 3 / 4, MW_TAIL = (MW_NI - MW_PRO) / NG;
static_assert(MW_PRO % 2 == 0 && MW_TAIL * NG == MW_NI - MW_PRO && MW_TAIL % (64 * NWAVES * 2) == 0, "item split");
__device__ __forceinline__ void moe_convert(const P& p, const Ctx& c, int first, int stride, int last) {
    LAS float* scr = (LAS float*)(c.lds + c.wave * 17408);
    { const int kr = c.lane >> 3, n4 = (c.lane & 7) * 4;
      auto decode = [&](int r, const float*& src, int& ldw, unsigned char*& dst) {
          if (r < MW_I1) { const int e = r / 1024, q = r % 1024, nb = q % 64, kb = q / 64, dr = 32 * nb; const int sc = ((dr >> 7) & 1) * 1024 + (dr >> 8) * 128 + (dr & 127);
              ldw = 2048; src = p.in[I_W1] + (size_t)e * D * 2048 + (size_t)(64 * kb) * 2048 + sc; dst = c.ws + WS_W1 + (size_t)e * 2048 * D + (size_t)dr * D + 64 * kb; }
          else { r -= MW_I1; const int e = r / 512, q = r % 512, nb = q % 32, kb = q / 32;
              ldw = D; src = p.in[I_W2] + (size_t)e * DFF * D + (size_t)(64 * kb) * D + 32 * nb; dst = c.ws + WS_W2 + (size_t)e * D * DFF + (size_t)(32 * nb) * DFF + 64 * kb; } };
      f32x4 va[8], vb[8]; const float* src; unsigned char *dsta, *dstb; int ldw;
      LAS float* scrb = scr + 64 * 33;
      int it = first;
      auto loadp = [&](int i0) {
          decode(i0, src, ldw, dsta);
#pragma unroll
          for (int j = 0; j < 8; ++j) va[j] = *(const f32x4*)(src + (size_t)(8 * j + kr) * ldw + n4);
          if (i0 + stride < last) { decode(i0 + stride, src, ldw, dstb);
#pragma unroll
              for (int j = 0; j < 8; ++j) vb[j] = *(const f32x4*)(src + (size_t)(8 * j + kr) * ldw + n4); } };
      if (it < last) loadp(it);
#pragma unroll 1
      for (; it < last; it += 2 * stride) { const bool hasb = it + stride < last;
#pragma unroll
          for (int j = 0; j < 8; ++j) { LAS float* sp = scr + (8 * j + kr) * 33 + n4; sp[0] = va[j].x; sp[1] = va[j].y; sp[2] = va[j].z; sp[3] = va[j].w;
              LAS float* sq2 = scrb + (8 * j + kr) * 33 + n4; sq2[0] = vb[j].x; sq2[1] = vb[j].y; sq2[2] = vb[j].z; sq2[3] = vb[j].w; }
          unsigned char* da = dsta; unsigned char* db = dstb;
          if (it + 2 * stride < last) loadp(it + 2 * stride);
          LDS_WAIT(); asm volatile("" ::: "memory");
          const int cc = c.lane & 7;
#pragma unroll
          for (int j = 0; j < 4; ++j) { const int n = (c.lane >> 3) + 8 * j; const LAS float* sq = scr + (8 * cc) * 33 + n;
              u32x2 o; o.x = pack4_fp8(sq[0 * 33] * W8_SCALE, sq[1 * 33] * W8_SCALE, sq[2 * 33] * W8_SCALE, sq[3 * 33] * W8_SCALE); o.y = pack4_fp8(sq[4 * 33] * W8_SCALE, sq[5 * 33] * W8_SCALE, sq[6 * 33] * W8_SCALE, sq[7 * 33] * W8_SCALE);
              *(u32x2*)(da + (size_t)n * D + 8 * cc) = o;
              if (hasb) { const LAS float* sr = scrb + (8 * cc) * 33 + n;
                  u32x2 o2; o2.x = pack4_fp8(sr[0 * 33] * W8_SCALE, sr[1 * 33] * W8_SCALE, sr[2 * 33] * W8_SCALE, sr[3 * 33] * W8_SCALE); o2.y = pack4_fp8(sr[4 * 33] * W8_SCALE, sr[5 * 33] * W8_SCALE, sr[6 * 33] * W8_SCALE, sr[7 * 33] * W8_SCALE);
                  *(u32x2*)(db + (size_t)n * D + 8 * cc) = o2; } }
          LDS_WAIT(); asm volatile("" ::: "memory");
      } }
}
__device__ __forceinline__ void phase_prep(const P& p, const Ctx& c) {
    const float* w_in = p.in[I_WIN];
    if ((int)blockIdx.x * 32 < CIN) {
        LAS float* h0m = (LAS float*)c.lds; LAS float* red = (LAS float*)(c.lds + 65536);
#pragma unroll
        for (int rr = 0; rr < 2; ++rr) { const int m = 2 * c.wave + rr; f32x4 y[4]; ln_row(p.in[I_META] + (size_t)m * D, p.in[I_ELG], p.in[I_ELB], c.lane, y);
#pragma unroll
            for (int j = 0; j < 4; ++j) *(LAS f32x4*)(h0m + m * D + 4 * c.lane + 256 * j) = y[j]; }
        __syncthreads();
        const int cc = c.tid & 31, ks = c.tid >> 5, col = blockIdx.x * 32 + cc; float acc[16];
#pragma unroll
        for (int m = 0; m < 16; ++m) acc[m] = 0.f;
        if (col < CIN) {
#pragma unroll 1
            for (int k0 = ks * 64; k0 < ks * 64 + 64; k0 += 32) { float wv[32];
#pragma unroll
                for (int i = 0; i < 32; ++i) wv[i] = w_in[(size_t)(k0 + i) * CIN + col];
                __builtin_amdgcn_sched_barrier(0);
#pragma unroll
                for (int i = 0; i < 32; ++i) {
#pragma unroll
                    for (int m = 0; m < 16; ++m) acc[m] += h0m[m * D + k0 + i] * wv[i];
                    if (i & 1) __builtin_amdgcn_sched_barrier(0); } } }
#pragma unroll
        for (int m = 0; m < 16; ++m) red[(ks * 16 + m) * 32 + cc] = acc[m];
        __syncthreads();
        { const int m = c.tid >> 5; float s = 0.f;
#pragma unroll
          for (int k2 = 0; k2 < 16; ++k2) s += red[(k2 * 16 + m) * 32 + cc];
          if (col < CIN) ((float*)(c.ws + WS_PM))[(size_t)m * CIN + col] = s; }
        __syncthreads();
    }
    { const int gid = (int)blockIdx.x * NTHR + c.tid; if (gid < NEXP * D) { const int k = gid >> 5, e = gid & 31; ((bf16_t*)(c.ws + WS_WRT))[e * D + k] = (bf16_t)f2bf(p.in[I_WR][gid]); } }
    for (int i = c.gw * 64 + c.lane; i < 224 * 128; i += c.NGW * 64) { const u32x4 z = {0u, 0u, 0u, 0u}; ((u32x4*)(c.ws + WS_WIN + (size_t)7712 * D * (G1_FP8 ? 1 : 2)))[i] = z; }
    LAS float* scr = (LAS float*)(c.lds + c.wave * 17408);
    constexpr int I_IN = 241 * 16, I_SQ = 512, I_1 = 32 * 1024, I_2 = 32 * 512, NITEMS = I_IN + 3 * I_SQ + I_1 + I_2;
    bf16_t* WIN = (bf16_t*)(c.ws + WS_WIN);
    for (int it = c.gw; it < I_IN + 3 * I_SQ; it += c.NGW) {
        int r = it;
#if G1_FP8
        if (r < I_IN) { const int nb = r % 241, kb = r / 241, dr = 32 * nb; transpose_item8(w_in, CIN, 64 * kb, nb == 240 ? C_BG : (dr < 4096 ? dr : dr + 16), c.ws + WS_WIN, D, dr, scr, c.lane); continue; } r -= I_IN;
#else
        if (r < I_IN) { const int nb = r % 241, kb = r / 241, dr = 32 * nb; transpose_item(w_in, CIN, 64 * kb, nb == 240 ? C_BG : (dr < 4096 ? dr : dr + 16), WIN, D, dr, scr, c.lane); continue; } r -= I_IN;
#endif
        if (r < I_SQ) { const int nb = r % 32, kb = r / 32; transpose_item8(p.in[I_WBG], D, 64 * kb, 32 * nb, c.ws + WS_WBG, D, 32 * nb, scr, c.lane); continue; } r -= I_SQ;
        if (r < I_SQ) { const int nb = r % 32, kb = r / 32; transpose_item8(p.in[I_WBS], D, 64 * kb, 32 * nb, c.ws + WS_WBS, D, 32 * nb, scr, c.lane); continue; } r -= I_SQ;
        if (r < I_SQ) { const int nb = r % 32, kb = r / 32; transpose_item8(p.in[I_WOUT], D, 64 * kb, 32 * nb, c.ws + WS_WOUT, D, 32 * nb, scr, c.lane); continue; } r -= I_SQ;
        (void)r; }
    moe_convert(p, c, c.gw, c.NGW, MW_PRO);
}

__device__ __forceinline__ void meta_state(const P& p, const Ctx& c, int h, LAS unsigned char* lb) {
    LAS float* kf = (LAS float*)lb; LAS float* vf = kf + 16 * 128; LAS float* red = vf + 16 * 128; LAS float* bet = red + 2 * 4 * 128; LAS float* gg = bet + 16;
    const float* PM = (const float*)(c.ws + WS_PM); const float* cw = p.in[I_CONVW];
    { const int tl = c.tid >> 5, cg = c.tid & 31; float kk[4], vv[4]; float ss = 0.f;
#pragma unroll
      for (int j = 0; j < 4; ++j) { const int ch = h * 128 + 4 * cg + j; float ak = 0.f, av = 0.f;
#pragma unroll
          for (int i = 0; i < 4; ++i) { const int tt = tl - 3 + i; if (tt >= 0) { ak += cw[(size_t)(1024 + ch) * 4 + i] * PM[(size_t)tt * CIN + C_KG + ch]; av += cw[(size_t)(2048 + ch) * 4 + i] * PM[(size_t)tt * CIN + C_VG + ch]; } }
          kk[j] = siluf_(ak); vv[j] = siluf_(av); ss += kk[j] * kk[j]; }
      ss += sx<1>(ss); ss += sx<2>(ss); ss += sx<4>(ss); ss += sx<8>(ss); ss += sx<16>(ss);
      const float rn = frsq(ss + RMS_EPS);
#pragma unroll
      for (int j = 0; j < 4; ++j) { kf[tl * 128 + 4 * cg + j] = kk[j] * rn; vf[tl * 128 + 4 * cg + j] = vv[j]; }
      if (cg == 0) { bet[tl] = sigmoidf_(PM[(size_t)tl * CIN + C_BG + h]); gg[tl] = fexp(-fexp(p.in[I_ALOG][h]) * softplusf_(PM[(size_t)tl * CIN + C_AG + h] + p.in[I_DTB][h])); } }
    __syncthreads();
    float S[32];
#pragma unroll
    for (int k = 0; k < 32; ++k) S[k] = 0.f;
    const int v = c.tid & 127, rg = c.tid >> 7;
#pragma unroll 1
    for (int t = 0; t < 16; ++t) { float pk = 0.f;
#pragma unroll
        for (int k = 0; k < 32; ++k) pk += S[k] * kf[t * 128 + rg * 32 + k];
        red[((t & 1) * 4 + rg) * 128 + v] = pk;
        __syncthreads();
        const float sk = (red[((t & 1) * 4 + 0) * 128 + v] + red[((t & 1) * 4 + 1) * 128 + v]) + (red[((t & 1) * 4 + 2) * 128 + v] + red[((t & 1) * 4 + 3) * 128 + v]);
        const float g = gg[t], u = bet[t] * (vf[t * 128 + v] - g * sk);
#pragma unroll
        for (int k = 0; k < 32; ++k) S[k] = g * S[k] + kf[t * 128 + rg * 32 + k] * u; }
    float* S1 = (float*)(c.ws + WS_S1) + (size_t)h * 128 * 128;
#pragma unroll
    for (int k = 0; k < 32; ++k) S1[(rg * 32 + k) * 128 + v] = S[k];
    bf16_t* HALO = (bf16_t*)(c.ws + WS_HALO);
    for (int it = c.tid; it < BATCH * 3 * 3 * 16; it += NTHR) { const int cg2 = it & 15, which = (it >> 4) % 3, i = (it / 48) % 3, b = it / 144; const int ch0 = which * 1024 + h * 128 + 8 * cg2;
        const float* mp = PM + (size_t)(NMETA - 3 + i) * CIN + ch0; const f32x4 m0 = *(const f32x4*)mp, m1 = *(const f32x4*)(mp + 4);
        *(u32x4*)(HALO + ((size_t)(BATCH + b) * 3 + i) * 3072 + ch0) = pack8(m0, m1); }
    __syncthreads();
}


__device__ __forceinline__ float red16(float v) { v += sx<1>(v); v += sx<2>(v); v += sx<4>(v); v += sx<8>(v); return v; }
__device__ __forceinline__ void quad_load(const float* row, int sub, f32x4 (&y)[16]) { const f32x4* xr = (const f32x4*)row + sub;
#pragma unroll
    for (int j = 0; j < 16; ++j) y[j] = xr[16 * j]; }
__device__ __forceinline__ void quad_load_bf16(const bf16_t* row, int sub, f32x4 (&y)[16]) { const u32x2* xr = (const u32x2*)row + sub;
#pragma unroll
    for (int j = 0; j < 16; ++j) { const u32x2 w = xr[16 * j]; y[j] = (f32x4){bflo(w.x), bfhi(w.x), bflo(w.y), bfhi(w.y)}; } }
__device__ __forceinline__ void stage_gb(const Ctx& c, const float* g, const float* b, LAS float* dst) {
    if (c.tid < 256) *(LAS f32x4*)(dst + 4 * c.tid) = *(const f32x4*)(g + 4 * c.tid); else *(LAS f32x4*)(dst + 1024 + 4 * (c.tid - 256)) = *(const f32x4*)(b + 4 * (c.tid - 256));
}
__device__ __forceinline__ void quad_norm(f32x4 (&y)[16], const LAS float* gam, const LAS float* bet, int sub) {
    float s = 0.f;
#pragma unroll
    for (int j = 0; j < 16; ++j) s += (y[j].x + y[j].y) + (y[j].z + y[j].w);
    const float mean = red16(s) * (1.f / D); float s2 = 0.f;
#pragma unroll
    for (int j = 0; j < 16; ++j) { y[j] = y[j] - mean; s2 += (y[j].x * y[j].x + y[j].y * y[j].y) + (y[j].z * y[j].z + y[j].w * y[j].w); }
    const float rstd = frsq(red16(s2) * (1.f / D) + LN_EPS);
#pragma unroll
    for (int j = 0; j < 16; ++j) { const f32x4 gv = ((const LAS f32x4*)gam)[16 * j + sub], bv = ((const LAS f32x4*)bet)[16 * j + sub]; y[j] = y[j] * rstd * gv + bv;
        if ((j & 3) == 3) __builtin_amdgcn_sched_barrier(0); }
}
__device__ __forceinline__ void quad_store_bf16(bf16_t* orow, int sub, const f32x4 (&y)[16]) { u32x2* o8 = (u32x2*)orow + sub;
#pragma unroll
    for (int j = 0; j < 16; ++j) { u32x2 w; w.x = pg8::cvt_pk_bf16(y[j].x, y[j].y); w.y = pg8::cvt_pk_bf16(y[j].z, y[j].w); o8[16 * j] = w; } }

__device__ __forceinline__ void quad_store_fp8(unsigned char* orow, int sub, const f32x4 (&y)[16]) { unsigned* o4 = (unsigned*)orow + sub;
#pragma unroll
    for (int j = 0; j < 16; ++j) o4[16 * j] = pack4_fp8(y[j].x, y[j].y, y[j].z, y[j].w); }
constexpr int GB_LN2 = 0, GB_EMB = 8192, GB_LN1 = 98304;
constexpr int GB_EMB2 = 106496;
__device__ __forceinline__ void phase_ln0(const P& p, const Ctx& c, int g, int wid, int nw, int gboff) {
    bf16_t* H0 = (bf16_t*)(c.ws + WS_H0); const int sub = c.lane & 15, rs = c.lane >> 4; const LAS float* gL = (const LAS float*)(c.lds + gboff); const LAS float* bL = gL + 1024;
    for (int q0 = wid; q0 < TOK / 4; q0 += 2 * nw) { const int q1 = q0 + nw; const bool has1 = q1 < TOK / 4;
        const int r0 = 4 * q0 + rs, r1 = 4 * (has1 ? q1 : q0) + rs;
        f32x4 y0[16], y1[16];
        quad_load(p.in[I_X] + ((size_t)(r0 >> 9) * SEQ + g * TSL + (r0 & (TSL - 1))) * D, sub, y0);
        quad_load(p.in[I_X] + ((size_t)(r1 >> 9) * SEQ + g * TSL + (r1 & (TSL - 1))) * D, sub, y1);
        quad_norm(y0, gL, bL, sub); quad_store_bf16(H0 + (size_t)r0 * D, sub, y0); quad_store_fp8(c.ws + WS_H0Q + (size_t)r0 * D, sub, y0);
        if (has1) { quad_norm(y1, gL, bL, sub); quad_store_bf16(H0 + (size_t)r1 * D, sub, y1); quad_store_fp8(c.ws + WS_H0Q + (size_t)r1 * D, sub, y1); }
    }
}

__device__ __forceinline__ void ln1_norm(const P& p, const Ctx& c, int r, int sub, f32x4 (&y)[16]) {
    bf16_t* H1 = (bf16_t*)(c.ws + WS_H1);
    quad_norm(y, (const LAS float*)(c.lds + GB_LN1), (const LAS float*)(c.lds + GB_LN1) + 1024, sub);
    quad_store_bf16(H1 + (size_t)r * D, sub, y);
    int r2 = r, sub2 = sub; asm volatile("" : "+v"(r2), "+v"(sub2));
    unsigned* h8 = (unsigned*)(c.ws + WS_H1Q + (size_t)r2 * D) + sub2;
#pragma unroll
    for (int j = 0; j < 16; ++j) h8[16 * j] = pack4_fp8(y[j].x, y[j].y, y[j].z, y[j].w);
}
constexpr int RT_WS = 1032;
__device__ __forceinline__ void phase_ln1_router(const P& p, const Ctx& c, int g, int ln0_next) {
    LAS bf16_t* wrb = (LAS bf16_t*)c.lds;
    LAS float* lgs = (LAS float*)(c.lds + 32 * RT_WS * 2);
    { const u32x4* wrt = (const u32x4*)(c.ws + WS_WRT); u32x4 wv[8];
#pragma unroll
      for (int i = 0; i < 8; ++i) wv[i] = wrt[c.tid + NTHR * i];
#pragma unroll
      for (int i = 0; i < 8; ++i) { const int ch = c.tid + NTHR * i, e = ch >> 7, k8 = ch & 127; *(LAS u32x4*)(wrb + e * RT_WS + 8 * k8) = wv[i]; } }
    stage_gb(c, p.in[I_L1G], p.in[I_L1B], (LAS float*)(c.lds + GB_LN1));
    if (ln0_next >= 0) stage_gb(c, p.in[I_ELG], p.in[I_ELB], (LAS float*)(c.lds + GB_EMB2));
    if (c.tid < NEXP) c.MISC[MI_LCNT + c.tid] = 0u;
    __syncthreads();
    const bf16_t* PRE1 = (const bf16_t*)(c.ws + WS_PRE1); const int sub = c.lane & 15, rs = c.lane >> 4;
    const int rloc = 64 * blockIdx.x, rbase = (g % NP) * TOK + rloc;
    { const int r0 = rbase + 8 * c.wave + rs, r1 = r0 + 4, l0 = rloc + 8 * c.wave + rs, l1 = l0 + 4; f32x4 y0[16], y1[16]; u32x2 w0[16], w1[16];
      { const u32x2* x0 = (const u32x2*)(PRE1 + (size_t)l0 * D) + sub; const u32x2* x1 = (const u32x2*)(PRE1 + (size_t)l1 * D) + sub;
#pragma unroll
        for (int j = 0; j < 16; ++j) { w0[j] = x0[16 * j]; w1[j] = x1[16 * j]; } }
      __builtin_amdgcn_sched_barrier(0);
#pragma unroll
      for (int j = 0; j < 16; ++j) { y0[j] = (f32x4){bflo(w0[j].x), bfhi(w0[j].x), bflo(w0[j].y), bfhi(w0[j].y)}; y1[j] = (f32x4){bflo(w1[j].x), bfhi(w1[j].x), bflo(w1[j].y), bfhi(w1[j].y)}; }
      ln1_norm(p, c, r0, sub, y0); ln1_norm(p, c, r1, sub, y1); }
    asm volatile("s_waitcnt vmcnt(0)" ::: "memory");
    __syncthreads();
    int* TOPI = (int*)(c.ws + WS_TOPI); float* TOPW = (float*)(c.ws + WS_TOPW); int* RANK = (int*)(c.ws + WS_RANK);
    if (c.wave < 4) {
        const int i15 = c.lane & 15, kq = c.lane >> 4, R0 = rbase + 16 * c.wave; const bf16_t* H1 = (const bf16_t*)(c.ws + WS_H1);
        const bf16_t* hrow = H1 + (size_t)(R0 + i15) * D + 8 * kq;
        f32x4 a0 = *(const f32x4*)(p.in[I_BR] + 4 * kq), a1 = *(const f32x4*)(p.in[I_BR] + 16 + 4 * kq);
        pg8::bf16x8 bf[32];
#pragma unroll
        for (int j = 0; j < 32; ++j) bf[j] = *(const pg8::bf16x8*)(hrow + 32 * j);
        __builtin_amdgcn_sched_barrier(0);
#pragma unroll
        for (int j = 0; j < 32; ++j) { const int ko = 32 * j + 8 * kq;
            const pg8::bf16x8 w0 = *(const LAS pg8::bf16x8*)(wrb + i15 * RT_WS + ko), w1 = *(const LAS pg8::bf16x8*)(wrb + (16 + i15) * RT_WS + ko);
            a0 = __builtin_amdgcn_mfma_f32_16x16x32_bf16(w0, bf[j], a0, 0, 0, 0); a1 = __builtin_amdgcn_mfma_f32_16x16x32_bf16(w1, bf[j], a1, 0, 0, 0); }
        LAS float* lg = lgs + c.wave * 16 * 33;
#pragma unroll
        for (int r = 0; r < 4; ++r) { lg[i15 * 33 + 4 * kq + r] = a0[r]; lg[i15 * 33 + 16 + 4 * kq + r] = a1[r]; }
        asm volatile("s_waitcnt lgkmcnt(0)" ::: "memory");
        if (c.lane < 16) { const int r = R0 + c.lane; float v[32];
#pragma unroll
            for (int e = 0; e < 32; ++e) v[e] = lg[c.lane * 33 + e];
            int sel[4]; float val[4];
#pragma unroll
            for (int k = 0; k < 4; ++k) { float best = -3.0e38f; int bi = 0;
#pragma unroll
                for (int e = 0; e < 32; ++e) if (v[e] > best) { best = v[e]; bi = e; }
                sel[k] = bi; val[k] = best;
#pragma unroll
                for (int e = 0; e < 32; ++e) v[e] = (e == bi) ? -3.0e38f : v[e]; }
            const float e1 = fexp(val[1] - val[0]), e2 = fexp(val[2] - val[0]), e3 = fexp(val[3] - val[0]); const float inv = frcp(1.0f + e1 + e2 + e3);
            const float ww[4] = {inv, e1 * inv, e2 * inv, e3 * inv};
#pragma unroll
            for (int k = 0; k < 4; ++k) { const unsigned rk = __hip_atomic_fetch_add((LAS unsigned*)(c.MISC + MI_LCNT + sel[k]), 1u, __ATOMIC_RELAXED, __HIP_MEMORY_SCOPE_WORKGROUP);
                TOPI[(size_t)r * 4 + k] = sel[k]; TOPW[(size_t)r * 4 + k] = ww[k]; RANK[(size_t)r * 4 + k] = (int)rk; } }
    } else if (ln0_next >= 0) {
        phase_ln0(p, c, ln0_next, (int)blockIdx.x * 4 + (c.wave - 4), (int)gridDim.x * 4, GB_EMB2);
    }
    asm volatile("s_waitcnt vmcnt(0)" ::: "memory");
    __syncthreads();
    int lane2 = lane_fresh(); const int tid2 = c.wave * 64 + lane2;
    if (tid2 < NEXP) { unsigned* gc = (unsigned*)(c.ws + WS_CTL) + CW_CNT + ((g / NP) * NEXP + tid2) * 32; c.MISC[MI_LBASE + tid2] = atomicAdd(gc, (unsigned)c.MISC[MI_LCNT + tid2]); }
    __syncthreads();
    if (tid2 < 256) { const size_t i = (size_t)rbase * 4 + tid2; const int e = __hip_atomic_load(TOPI + i, __ATOMIC_RELAXED, __HIP_MEMORY_SCOPE_AGENT); const int pos = RANK[i] + (int)c.MISC[MI_LBASE + e]; RANK[i] = pos;
        ((int*)(c.ws + WS_RTOK))[(size_t)e * TOKP + pos] = (int)(i >> 2); ((float*)(c.ws + WS_RWW))[(size_t)e * TOKP + pos] = TOPW[i]; }
}
__device__ __forceinline__ int moe_tables(const Ctx& c, int pr) {
    const unsigned* cnt = (const unsigned*)(c.ws + WS_CTL) + CW_CNT + pr * NEXP * 32;
    if (c.wave == 0) { const int e = c.lane & 31; const unsigned cv = __hip_atomic_load(cnt + e * 32, __ATOMIC_RELAXED, __HIP_MEMORY_SCOPE_AGENT), pd = (cv + 255u) & ~255u; unsigned inc = pd;
#pragma unroll
        for (int o = 1; o < 32; o <<= 1) { const unsigned t = shfl_up_u(inc, o, c.lane); if (e >= o) inc += t; }
        if (c.lane < 32) { c.MISC[MI_OFF + e] = inc - pd; c.MISC[MI_CNT + e] = cv; if (e == 31) c.MISC[MI_OFF + NEXP] = inc; } }
    __syncthreads();
    const int ntiles = (int)(c.MISC[MI_OFF + NEXP] >> 8);
    for (int t = c.tid; t < ntiles; t += NTHR) { int e = 0; for (int k = 1; k < NEXP; ++k) if ((unsigned)(t * 256) >= c.MISC[MI_OFF + k]) e = k; ((volatile LAS unsigned char*)(c.MISC + MI_TE))[t] = (unsigned char)e; }
    __syncthreads();
    return ntiles;
}
__device__ __forceinline__ void phase_combine(const P& p, const Ctx& c, int pr) {
    const bf16_t* H1 = (const bf16_t*)(c.ws + WS_H1); const unsigned char* YS = c.ws + WS_YS; const int* TOPI = (const int*)(c.ws + WS_TOPI); const int* RANK = (const int*)(c.ws + WS_RANK);
    const int sub = c.lane & 15, rs = c.lane >> 4;
    for (int q = c.gw; q < TOKP / 4; q += c.NGW) { const int r = 4 * q + rs;
        int sl[4];
#pragma unroll
        for (int k = 0; k < 4; ++k) sl[k] = (int)c.MISC[MI_OFF + TOPI[(size_t)r * 4 + k]] + RANK[(size_t)r * 4 + k];
        f32x4 v[16];
        u32x4 hw[8]; u32x2 yw[4][8];
#pragma unroll
        for (int j = 0; j < 8; ++j) { hw[j] = ((const u32x4*)(H1 + (size_t)r * D))[16 * j + sub];
#pragma unroll
            for (int k = 0; k < 4; ++k) yw[k][j] = ((const u32x2*)(YS + (size_t)sl[k] * D))[16 * j + sub]; }
#pragma unroll
        for (int j = 0; j < 8; ++j) { f32x4 a0, a1; unpack8(hw[j], a0, a1); a0 = a0 * DN_ALPHA; a1 = a1 * DN_ALPHA; f32x4 y0 = {0.f, 0.f, 0.f, 0.f}, y1 = {0.f, 0.f, 0.f, 0.f};
#pragma unroll
            for (int k = 0; k < 4; ++k) { const f32x2 p0 = __builtin_amdgcn_cvt_pk_f32_fp8((int)yw[k][j].x, false), p1 = __builtin_amdgcn_cvt_pk_f32_fp8((int)yw[k][j].x, true), p2 = __builtin_amdgcn_cvt_pk_f32_fp8((int)yw[k][j].y, false), p3 = __builtin_amdgcn_cvt_pk_f32_fp8((int)yw[k][j].y, true);
                y0 = y0 + (f32x4){p0.x, p0.y, p1.x, p1.y}; y1 = y1 + (f32x4){p2.x, p2.y, p3.x, p3.y}; }
            v[2 * j] = a0 + y0 * YS_INV; v[2 * j + 1] = a1 + y1 * YS_INV; }
        float s = 0.f;
#pragma unroll
        for (int j = 0; j < 16; ++j) s += (v[j].x + v[j].y) + (v[j].z + v[j].w);
        const float mean = red16(s) * (1.f / D); float s2 = 0.f;
#pragma unroll
        for (int j = 0; j < 16; ++j) { v[j] = v[j] - mean; s2 += (v[j].x * v[j].x + v[j].y * v[j].y) + (v[j].z * v[j].z + v[j].w * v[j].w); }
        const float rstd = frsq(red16(s2) * (1.f / D) + LN_EPS);
        const int rl = r & (TOK - 1), gs = NP * pr + r / TOK;
        float* orow = p.out + ((size_t)(rl >> 9) * SEQ + gs * TSL + (rl & (TSL - 1))) * D;
#pragma unroll
        for (int j = 0; j < 8; ++j) { const int k0 = 128 * j + 8 * sub;
            const LAS float* gL = (const LAS float*)(c.lds + GB_LN2); const f32x4 g0 = *(const LAS f32x4*)(gL + k0), g1 = *(const LAS f32x4*)(gL + k0 + 4), b0 = *(const LAS f32x4*)(gL + 1024 + k0), b1 = *(const LAS f32x4*)(gL + 1024 + k0 + 4);
            *(f32x4*)(orow + k0) = v[2 * j] * rstd * g0 + b0; *(f32x4*)(orow + k0 + 4) = v[2 * j + 1] * rstd * g1 + b1;
            if (j & 1) __builtin_amdgcn_sched_barrier(0); }
    }
}

typedef short bf16x8 __attribute__((ext_vector_type(8)));
typedef float f32x16 __attribute__((ext_vector_type(16)));
typedef short bf16x4 __attribute__((ext_vector_type(4)));
constexpr int SW_K = 0, SW_KT = 9216, SW_VT = 36864, SW_VTT = 8704, SW_KM = 71680, SW_VTM = 76288;
constexpr float L2E = 1.4426950408889634f;
__device__ __forceinline__ bf16x8 mk8(bf16x4 a, bf16x4 b) { return (bf16x8){a[0], a[1], a[2], a[3], b[0], b[1], b[2], b[3]}; }
template <int MODE>
__device__ __forceinline__ void swa_tile(LAS unsigned char* lds, int kt, int jt, int iq, int lane, float slope2, const bf16x8 (&qf)[4], float& m, float& l, f32x16& ot0, f32x16& ot1) {
    const int r31 = lane & 31, h = lane >> 5;
    const int dq = iq - jt - 4 * h;
    const float cl = -slope2 * (float)dq; const int dmax = iq < 127 ? iq : 127;
    f32x16 s0, s1;
#pragma unroll
    for (int r = 0; r < 16; ++r) { const int ko = 8 * (r >> 2) + (r & 3);
        float t0 = fmaf(slope2, (float)ko, cl), t1 = fmaf(slope2, (float)(ko + 32), cl);
        if (MODE == 1) { const int d0 = dq - ko, d1 = dq - ko - 32; t0 = ((unsigned)d0 <= (unsigned)dmax) ? t0 : -3.0e38f; t1 = ((unsigned)d1 <= (unsigned)dmax) ? t1 : -3.0e38f; }
        s0[r] = t0; s1[r] = t1; }
    const LAS unsigned char* kb0 = lds + SW_K + kt * SW_KT + r31 * 144 + h * 16;
#pragma unroll
    for (int ks = 0; ks < 4; ++ks) { const bf16x8 a0 = *(const LAS bf16x8*)(kb0 + ks * 32), a1 = *(const LAS bf16x8*)(kb0 + 32 * 144 + ks * 32);
        s0 = __builtin_amdgcn_mfma_f32_32x32x16_bf16(a0, qf[ks], s0, 0, 0, 0); s1 = __builtin_amdgcn_mfma_f32_32x32x16_bf16(a1, qf[ks], s1, 0, 0, 0); }
    __builtin_amdgcn_sched_barrier(0);
    float mx = -3.0e38f;
#pragma unroll
    for (int r = 0; r < 16; ++r) mx = fmaxf(mx, fmaxf(s0[r], s1[r]));
    mx = fmaxf(mx, sx<32>(mx));
    const float mn = fmaxf(m, mx), sc = __builtin_amdgcn_exp2f(m - mn); m = mn;
    float ls = 0.f;
#pragma unroll
    for (int r = 0; r < 16; ++r) { s0[r] = __builtin_amdgcn_exp2f(s0[r] - mn); s1[r] = __builtin_amdgcn_exp2f(s1[r] - mn); ls += s0[r] + s1[r]; }
    l = l * sc + ls;
#pragma unroll
    for (int r = 0; r < 16; ++r) { ot0[r] *= sc; ot1[r] *= sc; }
    bf16x8 pf[2][2];
#pragma unroll
    for (int s = 0; s < 2; ++s) {
        u32x4 w0, w1;
        w0.x = pg8::cvt_pk_bf16(s0[8 * s + 0], s0[8 * s + 1]); w0.y = pg8::cvt_pk_bf16(s0[8 * s + 2], s0[8 * s + 3]); w0.z = pg8::cvt_pk_bf16(s0[8 * s + 4], s0[8 * s + 5]); w0.w = pg8::cvt_pk_bf16(s0[8 * s + 6], s0[8 * s + 7]);
        w1.x = pg8::cvt_pk_bf16(s1[8 * s + 0], s1[8 * s + 1]); w1.y = pg8::cvt_pk_bf16(s1[8 * s + 2], s1[8 * s + 3]); w1.z = pg8::cvt_pk_bf16(s1[8 * s + 4], s1[8 * s + 5]); w1.w = pg8::cvt_pk_bf16(s1[8 * s + 6], s1[8 * s + 7]);
        pf[0][s] = __builtin_bit_cast(bf16x8, w0); pf[1][s] = __builtin_bit_cast(bf16x8, w1); }
    __builtin_amdgcn_sched_barrier(0);
    const LAS unsigned char* vb0 = lds + SW_VT + kt * SW_VTT + r31 * 136 + h * 8; const int swz = (r31 >> 3) & 3;
#pragma unroll
    for (int kb = 0; kb < 2; ++kb)
#pragma unroll
        for (int s = 0; s < 2; ++s) { const int g0 = 4 * kb + 2 * s;
            const bf16x8 a0 = mk8(*(const LAS bf16x4*)(vb0 + ((g0 ^ swz) << 4)), *(const LAS bf16x4*)(vb0 + (((g0 + 1) ^ swz) << 4))),
                         a1 = mk8(*(const LAS bf16x4*)(vb0 + 32 * 136 + ((g0 ^ (swz + 4)) << 4)), *(const LAS bf16x4*)(vb0 + 32 * 136 + (((g0 + 1) ^ (swz + 4)) << 4)));
            ot0 = __builtin_amdgcn_mfma_f32_32x32x16_bf16(a0, pf[kb][s], ot0, 0, 0, 0); ot1 = __builtin_amdgcn_mfma_f32_32x32x16_bf16(a1, pf[kb][s], ot1, 0, 0, 0); }
    __builtin_amdgcn_sched_barrier(0);
}
__device__ __forceinline__ void swa_meta(LAS unsigned char* lds, int iq, int lane, float slope2, const bf16x8 (&qf)[4], float& m, float& l, f32x16& ot0, f32x16& ot1) {
    const int r31 = lane & 31, h = lane >> 5;
    const float cl = -slope2 * (float)(NMETA + iq - 4 * h);
    f32x16 s0;
#pragma unroll
    for (int r = 0; r < 16; ++r) { const int ko = 8 * (r >> 2) + (r & 3); s0[r] = r < 8 ? fmaf(slope2, (float)ko, cl) : 0.f; }
    const LAS unsigned char* kb0 = lds + SW_KM + r31 * 144 + h * 16;
#pragma unroll
    for (int ks = 0; ks < 4; ++ks) { const bf16x8 a0 = *(const LAS bf16x8*)(kb0 + ks * 32); s0 = __builtin_amdgcn_mfma_f32_32x32x16_bf16(a0, qf[ks], s0, 0, 0, 0); }
    float mx = -3.0e38f;
#pragma unroll
    for (int r = 0; r < 8; ++r) mx = fmaxf(mx, s0[r]);
    mx = fmaxf(mx, sx<32>(mx));
    const float mn = fmaxf(m, mx), sc = __builtin_amdgcn_exp2f(m - mn); m = mn;
    float ls = 0.f;
#pragma unroll
    for (int r = 0; r < 8; ++r) { s0[r] = __builtin_amdgcn_exp2f(s0[r] - mn); ls += s0[r]; }
    l = l * sc + ls;
#pragma unroll
    for (int r = 0; r < 16; ++r) { ot0[r] *= sc; ot1[r] *= sc; }
    u32x4 w0; w0.x = pg8::cvt_pk_bf16(s0[0], s0[1]); w0.y = pg8::cvt_pk_bf16(s0[2], s0[3]); w0.z = pg8::cvt_pk_bf16(s0[4], s0[5]); w0.w = pg8::cvt_pk_bf16(s0[6], s0[7]);
    const bf16x8 pf = __builtin_bit_cast(bf16x8, w0);
    const LAS unsigned char* vb0 = lds + SW_VTM + r31 * 72 + h * 8;
    const bf16x8 a0 = mk8(*(const LAS bf16x4*)(vb0), *(const LAS bf16x4*)(vb0 + 16)), a1 = mk8(*(const LAS bf16x4*)(vb0 + 32 * 72), *(const LAS bf16x4*)(vb0 + 32 * 72 + 16));
    ot0 = __builtin_amdgcn_mfma_f32_32x32x16_bf16(a0, pf, ot0, 0, 0, 0); ot1 = __builtin_amdgcn_mfma_f32_32x32x16_bf16(a1, pf, ot1, 0, 0, 0);
    __builtin_amdgcn_sched_barrier(0);
}
__device__ __forceinline__ void swa_unit(const P& p, const Ctx& c, int g, int u) {
    const int b = u >> 4, hk = (u >> 2) & 3, qt = u & 3, i0 = g * TSL + qt * 128;
    const bf16_t* KSF = (const bf16_t*)(c.ws + WS_KSF); const bf16_t* VSF = (const bf16_t*)(c.ws + WS_VSF); const float* PM = (const float*)(c.ws + WS_PM);
    const bf16_t* QS = (const bf16_t*)(c.ws + WS_QS); bf16_t* OS = (bf16_t*)(c.ws + WS_OSW);
    LAS unsigned char* lds = c.lds;
    { const int kk = c.tid >> 3, ch = c.tid & 7;
      u32x4 kv[4], vv[4]; f32x4 mk0 = {0.f, 0.f, 0.f, 0.f}, mk1 = {0.f, 0.f, 0.f, 0.f}; float mv[4] = {0.f, 0.f, 0.f, 0.f};
#pragma unroll
      for (int kt = 0; kt < 4; ++kt) { const int j = i0 - 128 + 64 * kt + kk, jc = j < 0 ? 0 : j; const size_t off = ((size_t)b * SEQ + jc) * 256 + hk * 64 + ch * 8;
          kv[kt] = *(const u32x4*)(KSF + off); vv[kt] = *(const u32x4*)(VSF + off); }
      const int mrow = c.tid >> 3, md = c.tid >> 3, m4 = (c.tid & 7) * 4;
      if (c.tid < 256 && mrow < NMETA) { const float* kp = PM + (size_t)mrow * CIN + C_KS + hk * 64 + ch * 8; mk0 = *(const f32x4*)kp; mk1 = *(const f32x4*)(kp + 4); }
      if (m4 < NMETA) { const float* vp = PM + (size_t)m4 * CIN + C_VS + hk * 64 + md; mv[0] = vp[0]; mv[1] = vp[CIN]; mv[2] = vp[2 * CIN]; mv[3] = vp[3 * CIN]; }
#pragma unroll
      for (int kt = 0; kt < 4; ++kt) {
          *(LAS u32x4*)(lds + SW_K + kt * SW_KT + kk * 144 + ch * 16) = kv[kt];
          LAS unsigned char* vt = lds + SW_VT + kt * SW_VTT + (ch * 8) * 136 + ((((kk >> 3) ^ ch) << 3) + (kk & 7)) * 2;
          *(LAS bf16_t*)(vt + 0 * 136) = (bf16_t)(vv[kt].x & 0xffffu); *(LAS bf16_t*)(vt + 1 * 136) = (bf16_t)(vv[kt].x >> 16); *(LAS bf16_t*)(vt + 2 * 136) = (bf16_t)(vv[kt].y & 0xffffu); *(LAS bf16_t*)(vt + 3 * 136) = (bf16_t)(vv[kt].y >> 16);
          *(LAS bf16_t*)(vt + 4 * 136) = (bf16_t)(vv[kt].z & 0xffffu); *(LAS bf16_t*)(vt + 5 * 136) = (bf16_t)(vv[kt].z >> 16); *(LAS bf16_t*)(vt + 6 * 136) = (bf16_t)(vv[kt].w & 0xffffu); *(LAS bf16_t*)(vt + 7 * 136) = (bf16_t)(vv[kt].w >> 16); }
      if (c.tid < 256) *(LAS u32x4*)(lds + SW_KM + mrow * 144 + ch * 16) = pack8(mk0, mk1);
      { u32x2 w; w.x = pg8::cvt_pk_bf16(mv[0], mv[1]); w.y = pg8::cvt_pk_bf16(mv[2], mv[3]); *(LAS u32x2*)(lds + SW_VTM + md * 72 + m4 * 2) = w; } }
    bf16x8 qf[4];
    { const int hq_ = 4 * hk + (c.wave & 3), r31_ = c.lane & 31, h_ = c.lane >> 5; const size_t row_ = (size_t)b * TSL + qt * 128 + (c.wave >> 2) * 64 + r31_;
#pragma unroll
      for (int ks = 0; ks < 4; ++ks) qf[ks] = *(const bf16x8*)(QS + row_ * D + hq_ * 64 + 16 * ks + 8 * h_); }
    __syncthreads();
    { const int gh = c.wave & 3, half = c.wave >> 2, hq = 4 * hk + gh, lane = c.lane, r31 = lane & 31, h = lane >> 5;
      const float slope2 = __builtin_amdgcn_exp2f(-0.5f * (float)(hq + 1)) * L2E, sink2 = p.in[I_SINK][hq] * L2E;
#pragma unroll 1
      for (int qb = 0; qb < 2; ++qb) {
          const int tl = qt * 128 + half * 64 + qb * 32 + r31, iq = g * TSL + tl; const size_t row = (size_t)b * TSL + tl;
          if (qb) {
#pragma unroll
              for (int ks = 0; ks < 4; ++ks) qf[ks] = *(const bf16x8*)(QS + row * D + hq * 64 + 16 * ks + 8 * h); }
          float m = sink2, l = h == 0 ? 1.0f : 0.0f; f32x16 ot0, ot1;
#pragma unroll
          for (int r = 0; r < 16; ++r) { ot0[r] = 0.f; ot1[r] = 0.f; }
          swa_meta(lds, iq, lane, slope2, qf, m, l, ot0, ot1);
          const int jt0 = i0 - 128 + 64 * half;
          swa_tile<1>(lds, half, jt0, iq, lane, slope2, qf, m, l, ot0, ot1);
          if (jt0 + 64 < 0) swa_tile<1>(lds, half + 1, jt0 + 64, iq, lane, slope2, qf, m, l, ot0, ot1); else swa_tile<0>(lds, half + 1, jt0 + 64, iq, lane, slope2, qf, m, l, ot0, ot1);
          swa_tile<1>(lds, half + 2, jt0 + 128, iq, lane, slope2, qf, m, l, ot0, ot1);
          const float inv = frcp(l + sx<32>(l));
          unsigned char* op = (unsigned char*)OS + row * D + hq * 64 + 4 * h; const float i16 = inv * 16.0f;
#pragma unroll
          for (int gq = 0; gq < 4; ++gq) {
              *(unsigned*)(op + 8 * gq) = pack4_fp8(ot0[4 * gq] * i16, ot0[4 * gq + 1] * i16, ot0[4 * gq + 2] * i16, ot0[4 * gq + 3] * i16);
              *(unsigned*)(op + 32 + 8 * gq) = pack4_fp8(ot1[4 * gq] * i16, ot1[4 * gq + 1] * i16, ot1[4 * gq + 2] * i16, ot1[4 * gq + 3] * i16); }
      } }
    __syncthreads();
}

constexpr int IM_W = 0, IM_QD = 16384, IM_QK = 32768, IM_KDT = 40960, IM_UV = 57344, UNIT_BYTES = 73728;
constexpr size_t WS_IMG = WS_IMG_BASE, WS_GT = 251 * MiB;
constexpr int GA_A = 0, GA_T = 16896, GA_GAM = 26112, GA_K = 27136, GA_Q = 44544, GA_KBT = 61952, GA_VBT = 80384;
__device__ __forceinline__ u32x4 pack8r(const f32x16& v, int s, float sc) {
    u32x4 w; w.x = pg8::cvt_pk_bf16(v[8 * s + 0] * sc, v[8 * s + 1] * sc); w.y = pg8::cvt_pk_bf16(v[8 * s + 2] * sc, v[8 * s + 3] * sc); w.z = pg8::cvt_pk_bf16(v[8 * s + 4] * sc, v[8 * s + 5] * sc); w.w = pg8::cvt_pk_bf16(v[8 * s + 6] * sc, v[8 * s + 7] * sc); return w; }
struct GdnRaw { u32x4 r[3][5]; float lg, be; };
__device__ __forceinline__ void gdn_a_prefetch(const Ctx& c, int g, int u, GdnRaw& R) {
    const int n = u & 7, h = (u >> 3) & 7, b = u >> 6, cg = c.tid & 15;
    const bf16_t* QKVG = (const bf16_t*)(c.ws + WS_QKVG); const bf16_t* HALO = (const bf16_t*)(c.ws + WS_HALO);
    const int tok0 = n * 64 + 2 * (c.tid >> 4);
#pragma unroll
    for (int i = 0; i < 5; ++i) { const int tt = tok0 - 3 + i;
        const bf16_t* mid = (tt >= 0 ? QKVG + ((size_t)b * TSL + tt) * 3072 : HALO + ((size_t)(((g + 1) & 1) * BATCH + b) * 3 + (3 + tt)) * 3072) + 1024 + h * 128 + 8 * cg;
        R.r[0][i] = *(const u32x4*)(mid - 1024); R.r[1][i] = *(const u32x4*)(mid); R.r[2][i] = *(const u32x4*)(mid + 1024); }
    const size_t row = (size_t)b * TSL + n * 64 + (c.lane);
    R.lg = ((const float*)(c.ws + WS_LOGG))[row * 8 + h]; R.be = ((const float*)(c.ws + WS_BETA))[row * 8 + h];
}
template <int R0>
__device__ __forceinline__ void gdn_conv8(const LAS float* cw, const u32x4 (&rawr)[5], f32x2 (&y)[4]) {
    f32x2 acc[4];
#pragma unroll
    for (int i = 0; i < 4; ++i) { const f32x4 w0 = *(const LAS f32x4*)(cw + i * 128), w1 = *(const LAS f32x4*)(cw + i * 128 + 4); const u32x4 rw = rawr[R0 + i];
        const f32x2 x0 = {bflo(rw.x), bfhi(rw.x)}, x1 = {bflo(rw.y), bfhi(rw.y)}, x2 = {bflo(rw.z), bfhi(rw.z)}, x3 = {bflo(rw.w), bfhi(rw.w)};
        const f32x2 wa = {w0.x, w0.y}, wb = {w0.z, w0.w}, wc = {w1.x, w1.y}, wd = {w1.z, w1.w};
        if (i == 0) { acc[0] = wa * x0; acc[1] = wb * x1; acc[2] = wc * x2; acc[3] = wd * x3; }
        else { acc[0] = acc[0] + wa * x0; acc[1] = acc[1] + wb * x1; acc[2] = acc[2] + wc * x2; acc[3] = acc[3] + wd * x3; } }
#pragma unroll
    for (int p = 0; p < 4; ++p) { f32x2 t = acc[p] * (-1.4426950408889634f);
        t.x = __builtin_amdgcn_exp2f(t.x); t.y = __builtin_amdgcn_exp2f(t.y); t = t + 1.0f; t.x = __builtin_amdgcn_rcpf(t.x); t.y = __builtin_amdgcn_rcpf(t.y);
        y[p] = acc[p] * t; }
}
constexpr int GA_CW = 98816, GA_TF = 104960, GA_XS = 121856;
constexpr int GA_LD = 66;
#define LDS_BAR() do { asm volatile("s_waitcnt lgkmcnt(0)" ::: "memory"); __builtin_amdgcn_s_barrier(); asm volatile("" ::: "memory"); } while (0)
__device__ __forceinline__ void gdn_a_unit(const P& p, const Ctx& c, int g, int u, GdnRaw& R, int unext) {
    const int n = u & 7, h = (u >> 3) & 7, b = u >> 6;
    LAS unsigned char* lds = c.lds;
    LAS float* gam = (LAS float*)(lds + GA_GAM); LAS float* bet = gam + 64; LAS float* egam = gam + 128; LAS float* ekd = gam + 192;
    LAS float* Amat = (LAS float*)(lds + GA_A); LAS float* TF = (LAS float*)(lds + GA_TF);
    const bf16_t* QKVG = (const bf16_t*)(c.ws + WS_QKVG); bf16_t* HALO = (bf16_t*)(c.ws + WS_HALO);
    unsigned char* img = c.ws + WS_IMG + (size_t)u * UNIT_BYTES;
    const int lane = c.lane, l31 = lane & 31, hh = lane >> 5;
    { AMP_BEGIN(16)
    if (c.wave == 0) { float ps = R.lg;
#pragma unroll
        for (int o = 1; o < 64; o <<= 1) { const float t = shfl_up_f(ps, o, lane); if (lane >= o) ps += t; }
        const float last = __builtin_bit_cast(float, __builtin_amdgcn_readlane(__builtin_bit_cast(int, ps), 63));
        gam[lane] = ps; bet[lane] = R.be; egam[lane] = fexp(ps); ekd[lane] = fexp(last - ps);
        if (lane == 63) ((float*)(c.ws + WS_GT))[u] = fexp(ps); }
    if (n == 7 && c.tid >= 64 && c.tid < 64 + 144) { const int t2 = c.tid - 64, i = t2 / 48, which = (t2 / 16) % 3, cg2 = t2 & 15;
        *(u32x4*)(HALO + ((size_t)((g & 1) * BATCH + b) * 3 + i) * 3072 + which * 1024 + h * 128 + 8 * cg2) = *(const u32x4*)(QKVG + ((size_t)b * TSL + (TSL - 3 + i)) * 3072 + which * 1024 + h * 128 + 8 * cg2); }
    LDS_BAR(); AMP_END(16) }
    { AMP_BEGIN(17)
    const LAS float* cwb = (const LAS float*)(lds + GA_CW) + 8 * (c.tid & 15);
    { const int cg = c.tid & 15, cl0 = 2 * (c.tid >> 4); f32x2 kbp[2][4], vbp[2][4];
#pragma unroll
      for (int pass = 0; pass < 2; ++pass) { const int cl = cl0 + pass; f32x2 yq[4], yk[4], yv[4];
        if (pass == 0) { gdn_conv8<0>(cwb, R.r[0], yq); gdn_conv8<0>(cwb + 512, R.r[1], yk); gdn_conv8<0>(cwb + 1024, R.r[2], yv); }
        else           { gdn_conv8<1>(cwb, R.r[0], yq); gdn_conv8<1>(cwb + 512, R.r[1], yk); gdn_conv8<1>(cwb + 1024, R.r[2], yv); }
        f32x2 sq2 = yq[0] * yq[0], sk2 = yk[0] * yk[0];
#pragma unroll
        for (int p = 1; p < 4; ++p) { sq2 = sq2 + yq[p] * yq[p]; sk2 = sk2 + yk[p] * yk[p]; }
        float sq = sq2.x + sq2.y, sk = sk2.x + sk2.y;
        sq += sx<1>(sq); sk += sx<1>(sk); sq += sx<2>(sq); sk += sx<2>(sk); sq += sx<4>(sq); sk += sx<4>(sk); sq += sx<8>(sq); sk += sx<8>(sk);
        const float rq_ = 0.08838834764831845f * frsq(sq + RMS_EPS), rk_ = frsq(sk + RMS_EPS), be = bet[cl] * egam[cl], bv = bet[cl];
        u32x4 qw, kw;
#pragma unroll
        for (int p = 0; p < 4; ++p) { const f32x2 qs = yq[p] * rq_, ks = yk[p] * rk_; qw[p] = pg8::cvt_pk_bf16(qs.x, qs.y); kw[p] = pg8::cvt_pk_bf16(ks.x, ks.y); kbp[pass][p] = ks * be; vbp[pass][p] = yv[p] * bv; }
        *(LAS u32x4*)(lds + GA_Q + cl * 272 + cg * 16) = qw; *(LAS u32x4*)(lds + GA_K + cl * 272 + cg * 16) = kw; }
#pragma unroll
      for (int j = 0; j < 8; ++j) { const float k0v = (j & 1) ? kbp[0][j >> 1].y : kbp[0][j >> 1].x, k1v = (j & 1) ? kbp[1][j >> 1].y : kbp[1][j >> 1].x, v0v = (j & 1) ? vbp[0][j >> 1].y : vbp[0][j >> 1].x, v1v = (j & 1) ? vbp[1][j >> 1].y : vbp[1][j >> 1].x;
          const int so = (8 * cg + j) * 144 + ((((cl0 >> 3) ^ (cg & 7)) << 3) + (cl0 & 7)) * 2;
          *(LAS unsigned*)(lds + GA_KBT + so) = pg8::cvt_pk_bf16(k0v, k1v); *(LAS unsigned*)(lds + GA_VBT + so) = pg8::cvt_pk_bf16(v0v, v1v); } }
    if (unext >= 0) gdn_a_prefetch(c, g, unext, R);
    LDS_BAR(); AMP_END(17) }
    { AMP_BEGIN(18)
    { const int w = c.wave & 3, rb = w >> 1, cb = w & 1; const bool isqk = c.wave >= 4;
      f32x16 acc;
#pragma unroll
      for (int r = 0; r < 16; ++r) acc[r] = 0.f;
      const bool zero = isqk ? (rb == 1 && cb == 0) : (rb == 0 && cb == 1);
      if (!zero) { const LAS unsigned char* ap = lds + GA_K + (32 * rb + l31) * 272 + hh * 16; const LAS unsigned char* bp = lds + (isqk ? GA_Q : GA_K) + (32 * cb + l31) * 272 + hh * 16;
#pragma unroll
          for (int ks = 0; ks < 8; ++ks) acc = __builtin_amdgcn_mfma_f32_32x32x16_bf16(*(const LAS bf16x8*)(ap + ks * 32), *(const LAS bf16x8*)(bp + ks * 32), acc, 0, 0, 0); }
      const int colx = 32 * cb + l31; const float gcol = gam[colx];
      if (!isqk) {
#pragma unroll
          for (int r = 0; r < 16; ++r) { const int cc = 32 * rb + 8 * (r >> 2) + 4 * hh + (r & 3); Amat[cc * GA_LD + colx] = (cc > colx) ? bet[cc] * acc[r] * fexp(gam[cc] - gcol) : 0.f; } }
      else {
#pragma unroll
          for (int r = 0; r < 16; ++r) { const int sp = 32 * rb + 8 * (r >> 2) + 4 * hh + (r & 3); acc[r] = (sp <= colx) ? acc[r] * fexp(gcol - gam[sp]) : 0.f; }
#pragma unroll
          for (int s = 0; s < 2; ++s) *(u32x4*)(img + IM_QK + ((((cb * 2 + rb) * 2 + s) * 64 + lane) * 16)) = pack8r(acc, s, 1.0f); } }
    LDS_BAR(); AMP_END(18) }
    { AMP_BEGIN(19)
    if (c.wave == 0) {
        const int blk = lane >> 4, cc = lane & 15; const LAS float* Ab = Amat + (16 * blk) * GA_LD + 16 * blk; float t[16]; const float lf = (float)cc;
#pragma unroll
        for (int i = 0; i < 16; ++i) { float s = fmaxf(1.0f - fabsf(lf - (float)i), 0.0f);
#pragma unroll
            for (int j = 0; j < i; ++j) s -= Ab[i * GA_LD + j] * t[j];
            t[i] = s; }
#pragma unroll
        for (int i = 0; i < 16; ++i) TF[(16 * blk + i) * GA_LD + 16 * blk + cc] = t[i];
    } else {
        for (int pid = c.tid - 64; pid < 2048; pid += NTHR - 64) { const int which = pid >> 10, f = (pid >> 6) & 15, ln = pid & 63, pl = ln & 31, ph = ln >> 5;
            if (which == 0) { const int ct = f >> 3, kt = (f >> 1) & 3, s = f & 1, cc = 32 * ct + pl; const float e = egam[cc];
                const LAS unsigned char* qp = lds + GA_Q + cc * 272 + (32 * kt + 16 * s + 4 * ph) * 2; const u32x2 a = *(const LAS u32x2*)qp, d = *(const LAS u32x2*)(qp + 16);
                u32x4 w; w.x = pg8::cvt_pk_bf16(bflo(a.x) * e, bfhi(a.x) * e); w.y = pg8::cvt_pk_bf16(bflo(a.y) * e, bfhi(a.y) * e); w.z = pg8::cvt_pk_bf16(bflo(d.x) * e, bfhi(d.x) * e); w.w = pg8::cvt_pk_bf16(bflo(d.y) * e, bfhi(d.y) * e);
                *(u32x4*)(img + IM_QD + (f * 64 + ln) * 16) = w; }
            else { const int kt = f >> 2, ctp = (f >> 1) & 1, s = f & 1, dk = 32 * kt + pl, c0 = 32 * ctp + 16 * s + 4 * ph; float v[8];
#pragma unroll
                for (int j = 0; j < 8; ++j) { const int cc = c0 + 8 * (j >> 2) + (j & 3); v[j] = bf1(*(const LAS bf16_t*)(lds + GA_K + cc * 272 + dk * 2)) * ekd[cc]; }
                u32x4 w; w.x = pg8::cvt_pk_bf16(v[0], v[1]); w.y = pg8::cvt_pk_bf16(v[2], v[3]); w.z = pg8::cvt_pk_bf16(v[4], v[5]); w.w = pg8::cvt_pk_bf16(v[6], v[7]);
                *(u32x4*)(img + IM_KDT + (f * 64 + ln) * 16) = w; } }
    }
    LDS_BAR(); AMP_END(19) }
    { AMP_BEGIN(20)
    { const int i15 = lane & 15, kq = lane >> 4; LAS float* XS = (LAS float*)(lds + GA_XS) + (c.wave < 3 ? c.wave : 0) * 16 * 17;
#pragma unroll 1
      for (int bi = 1; bi < 4; ++bi) {
          if (c.wave < bi) { const int cb = c.wave; f32x4 x = {0.f, 0.f, 0.f, 0.f};
#pragma unroll 1
              for (int bj = cb; bj < bi; ++bj)
#pragma unroll
                  for (int kk = 0; kk < 4; ++kk) x = __builtin_amdgcn_mfma_f32_16x16x4f32(Amat[(16 * bi + i15) * GA_LD + 16 * bj + 4 * kk + kq], TF[(16 * bj + 4 * kk + kq) * GA_LD + 16 * cb + i15], x, 0, 0, 0);
#pragma unroll
              for (int r = 0; r < 4; ++r) XS[(4 * kq + r) * 17 + i15] = x[r];
              asm volatile("s_waitcnt lgkmcnt(0)" ::: "memory");
              f32x4 t = {0.f, 0.f, 0.f, 0.f};
#pragma unroll
              for (int kk = 0; kk < 4; ++kk) t = __builtin_amdgcn_mfma_f32_16x16x4f32(TF[(16 * bi + i15) * GA_LD + 16 * bi + 4 * kk + kq], XS[(4 * kk + kq) * 17 + i15], t, 0, 0, 0);
#pragma unroll
              for (int r = 0; r < 4; ++r) TF[(16 * bi + 4 * kq + r) * GA_LD + 16 * cb + i15] = -t[r]; }
          LDS_BAR(); } }
    AMP_END(20) }
    { AMP_BEGIN(21)
    { const int row = c.tid >> 3, c8 = (c.tid & 7) * 8; f32x4 a, d;
#pragma unroll
      for (int j = 0; j < 4; ++j) { a[j] = (c8 <= (row | 15)) ? TF[row * GA_LD + c8 + j] : 0.f; d[j] = (c8 <= (row | 15)) ? TF[row * GA_LD + c8 + 4 + j] : 0.f; }
      *(LAS u32x4*)(lds + GA_T + row * 144 + c8 * 2) = pack8(a, d); }
    LDS_BAR();
    { const int kt = c.wave >> 1, ct = c.wave & 1; f32x16 acc;
#pragma unroll
      for (int r = 0; r < 16; ++r) acc[r] = 0.f;
      const LAS unsigned char* ap = lds + GA_KBT + (32 * kt + l31) * 144; const LAS unsigned char* bp = lds + GA_T + (32 * ct + l31) * 144 + hh * 16; const int swz = (4 * kt + (l31 >> 3)) & 7;
#pragma unroll
      for (int ks = 0; ks < 4; ++ks) acc = __builtin_amdgcn_mfma_f32_32x32x16_bf16(*(const LAS bf16x8*)(ap + (((hh + 2 * ks) ^ swz) << 4)), *(const LAS bf16x8*)(bp + ks * 32), acc, 0, 0, 0);
#pragma unroll
      for (int s = 0; s < 2; ++s) *(u32x4*)(img + IM_W + ((((ct * 4 + kt) * 2 + s) * 64 + lane) * 16)) = pack8r(acc, s, -1.0f); }
    { const int ct = c.wave >> 2, vt = c.wave & 3; f32x16 acc;
#pragma unroll
      for (int r = 0; r < 16; ++r) acc[r] = 0.f;
      const LAS unsigned char* ap = lds + GA_T + (32 * ct + l31) * 144 + hh * 16; const LAS unsigned char* bp = lds + GA_VBT + (32 * vt + l31) * 144; const int swz = (4 * vt + (l31 >> 3)) & 7;
#pragma unroll
      for (int ks = 0; ks < 4; ++ks) acc = __builtin_amdgcn_mfma_f32_32x32x16_bf16(*(const LAS bf16x8*)(ap + ks * 32), *(const LAS bf16x8*)(bp + (((hh + 2 * ks) ^ swz) << 4)), acc, 0, 0, 0);
#pragma unroll
      for (int s = 0; s < 2; ++s) *(u32x4*)(img + IM_UV + (((ct * 4 + vt) * 64 + lane) * 32 + s * 16)) = pack8r(acc, s, 1.0f); }
    LDS_BAR(); AMP_END(21) }
}
__device__ __forceinline__ void gdn_a_units(const P& p, Ctx& c, int g, int bh) {
    { const int h = bh & 7; const float* cw = p.in[I_CONVW]; LAS float* cwl = (LAS float*)(c.lds + GA_CW);
      for (int i = c.tid; i < 3 * 128; i += NTHR) { const int which = i >> 7, ch = i & 127; const f32x4 w4 = *(const f32x4*)(cw + (size_t)(which * 1024 + h * 128 + ch) * 4); LAS float* o = cwl + which * 512 + ch; o[0] = w4.x; o[128] = w4.y; o[256] = w4.z; o[384] = w4.w; } }
    GdnRaw R; gdn_a_prefetch(c, g, bh * 8, R);
    LDS_BAR();
    c.lane = lane_fresh(); c.tid = c.wave * 64 + c.lane;
    gdn_a_unit(p, c, g, bh * 8, R, bh * 8 + 1);
#pragma unroll 1
    for (int n = 1; n < 8; ++n) { const int u = bh * 8 + n, un = n < 7 ? u + 1 : -1;
        c.lane = lane_fresh(); c.tid = c.wave * 64 + c.lane;
        gdn_a_unit(p, c, g, u, R, un); }
}

constexpr int GS_S = 0, GS_U = 32768, GS_O = 49152, GS_WQ = 66560, GS_KK = 99328;
__device__ __forceinline__ void gdn_scan_unit(const P& p, const Ctx& c, int g, int bh) {
    const int b = bh >> 3, h = bh & 7, ct = c.wave >> 2, vt = c.wave & 3, lane = c.lane, l31 = lane & 31, hh = lane >> 5;
    LAS unsigned char* lds = c.lds;
    const bf16_t* ZS = (const bf16_t*)(c.ws + WS_ZS); bf16_t* OG = (bf16_t*)(c.ws + WS_OG); const float* GT = (const float*)(c.ws + WS_GT);
    float* SC = (float*)(c.ws + WS_SC) + (size_t)bh * 128 * 128; const float* Sin = g == 0 ? (const float*)(c.ws + WS_S1) + (size_t)h * 128 * 128 : SC;
    f32x16 S0, S1;
#pragma unroll
    for (int r = 0; r < 16; ++r) { const int dk = 8 * (r >> 2) + 4 * hh + (r & 3); S0[r] = Sin[(size_t)(64 * ct + dk) * 128 + 32 * vt + l31]; S1[r] = Sin[(size_t)(64 * ct + 32 + dk) * 128 + 32 * vt + l31]; }
#pragma unroll
    for (int s = 0; s < 2; ++s) { *(LAS u32x4*)(lds + GS_S + ((((2 * ct) * 4 + vt) * 2 + s) * 64 + lane) * 16) = pack8r(S0, s, 1.0f); *(LAS u32x4*)(lds + GS_S + ((((2 * ct + 1) * 4 + vt) * 2 + s) * 64 + lane) * 16) = pack8r(S1, s, 1.0f); }
    const unsigned char* img0 = c.ws + WS_IMG + (size_t)(bh * 8) * UNIT_BYTES;
    u32x4 t0[4], t1[3], uv0, uv1; float gtn;
    { const unsigned char* img = img0;
#pragma unroll
      for (int i = 0; i < 4; ++i) t0[i] = *(const u32x4*)(img + IM_W + (size_t)(i * NTHR + c.tid) * 16);
#pragma unroll
      for (int i = 0; i < 3; ++i) t1[i] = *(const u32x4*)(img + IM_QK + (size_t)(i * NTHR + c.tid) * 16);
      uv0 = *(const u32x4*)(img + IM_UV + ((ct * 4 + vt) * 64 + lane) * 32); uv1 = *(const u32x4*)(img + IM_UV + ((ct * 4 + vt) * 64 + lane) * 32 + 16);
      gtn = __hip_atomic_load(GT + bh * 8, __ATOMIC_RELAXED, __HIP_MEMORY_SCOPE_AGENT); }
    auto chunk = [&](const int n) __attribute__((always_inline)) {
#pragma unroll
        for (int i = 0; i < 4; ++i) *(LAS u32x4*)(lds + GS_WQ + (i * NTHR + c.tid) * 16) = t0[i];
#pragma unroll
        for (int i = 0; i < 3; ++i) *(LAS u32x4*)(lds + GS_KK + (i * NTHR + c.tid) * 16) = t1[i];
        f32x16 U, O;
        U[0] = bflo(uv0.x); U[1] = bfhi(uv0.x); U[2] = bflo(uv0.y); U[3] = bfhi(uv0.y); U[4] = bflo(uv0.z); U[5] = bfhi(uv0.z); U[6] = bflo(uv0.w); U[7] = bfhi(uv0.w);
        U[8] = bflo(uv1.x); U[9] = bfhi(uv1.x); U[10] = bflo(uv1.y); U[11] = bfhi(uv1.y); U[12] = bflo(uv1.z); U[13] = bfhi(uv1.z); U[14] = bflo(uv1.w); U[15] = bfhi(uv1.w);
        const float gt = gtn;
#pragma unroll
        for (int r = 0; r < 16; ++r) O[r] = 0.f;
        LDS_BAR();
        { const unsigned char* img = img0 + (size_t)(n < 7 ? n + 1 : 7) * UNIT_BYTES;
#pragma unroll
          for (int i = 0; i < 4; ++i) t0[i] = *(const u32x4*)(img + IM_W + (size_t)(i * NTHR + c.tid) * 16);
#pragma unroll
          for (int i = 0; i < 3; ++i) t1[i] = *(const u32x4*)(img + IM_QK + (size_t)(i * NTHR + c.tid) * 16);
          uv0 = *(const u32x4*)(img + IM_UV + ((ct * 4 + vt) * 64 + lane) * 32); uv1 = *(const u32x4*)(img + IM_UV + ((ct * 4 + vt) * 64 + lane) * 32 + 16);
          gtn = __hip_atomic_load(GT + bh * 8 + (n < 7 ? n + 1 : 7), __ATOMIC_RELAXED, __HIP_MEMORY_SCOPE_AGENT); }
        const int zc = c.tid >> 3, zseg = c.tid & 7; const size_t zrow = (size_t)b * TSL + n * 64 + zc;
        const u32x4 z0 = *(const u32x4*)(ZS + zrow * D + h * 128 + zseg * 16), z1 = *(const u32x4*)(ZS + zrow * D + h * 128 + zseg * 16 + 8);
        f32x4 nwv[4];
#pragma unroll
        for (int j = 0; j < 4; ++j) nwv[j] = *(const f32x4*)(p.in[I_GNW] + zseg * 16 + 4 * j);
#pragma unroll
        for (int kt = 0; kt < 4; ++kt)
#pragma unroll
            for (int s = 0; s < 2; ++s) { const bf16x8 sb = *(const LAS bf16x8*)(lds + GS_S + (((kt * 4 + vt) * 2 + s) * 64 + lane) * 16);
                const bf16x8 aw = *(const LAS bf16x8*)(lds + GS_WQ + (((ct * 4 + kt) * 2 + s) * 64 + lane) * 16), aq = *(const LAS bf16x8*)(lds + GS_WQ + 16384 + (((ct * 4 + kt) * 2 + s) * 64 + lane) * 16);
                U = __builtin_amdgcn_mfma_f32_32x32x16_bf16(aw, sb, U, 0, 0, 0); O = __builtin_amdgcn_mfma_f32_32x32x16_bf16(aq, sb, O, 0, 0, 0); }
#pragma unroll
        for (int s = 0; s < 2; ++s) *(LAS u32x4*)(lds + GS_U + (((ct * 4 + vt) * 2 + s) * 64 + lane) * 16) = pack8r(U, s, 1.0f);
        LDS_BAR();
#pragma unroll
        for (int r = 0; r < 16; ++r) { S0[r] *= gt; S1[r] *= gt; }
#pragma unroll
        for (int cp = 0; cp < 2; ++cp)
#pragma unroll
            for (int s = 0; s < 2; ++s) { const bf16x8 ub = *(const LAS bf16x8*)(lds + GS_U + (((cp * 4 + vt) * 2 + s) * 64 + lane) * 16);
                const bf16x8 aqk = *(const LAS bf16x8*)(lds + GS_KK + (((ct * 2 + cp) * 2 + s) * 64 + lane) * 16);
                const bf16x8 ak0 = *(const LAS bf16x8*)(lds + GS_KK + 8192 + ((((2 * ct) * 2 + cp) * 2 + s) * 64 + lane) * 16), ak1 = *(const LAS bf16x8*)(lds + GS_KK + 8192 + ((((2 * ct + 1) * 2 + cp) * 2 + s) * 64 + lane) * 16);
                O = __builtin_amdgcn_mfma_f32_32x32x16_bf16(aqk, ub, O, 0, 0, 0); S0 = __builtin_amdgcn_mfma_f32_32x32x16_bf16(ak0, ub, S0, 0, 0, 0); S1 = __builtin_amdgcn_mfma_f32_32x32x16_bf16(ak1, ub, S1, 0, 0, 0); }
#pragma unroll
        for (int r = 0; r < 16; ++r) { const int cc = 32 * ct + 8 * (r >> 2) + 4 * hh + (r & 3); *(LAS bf16_t*)(lds + GS_O + cc * 272 + (32 * vt + l31) * 2) = (bf16_t)f2bf(O[r]); }
#pragma unroll
        for (int s = 0; s < 2; ++s) { *(LAS u32x4*)(lds + GS_S + ((((2 * ct) * 4 + vt) * 2 + s) * 64 + lane) * 16) = pack8r(S0, s, 1.0f); *(LAS u32x4*)(lds + GS_S + ((((2 * ct + 1) * 4 + vt) * 2 + s) * 64 + lane) * 16) = pack8r(S1, s, 1.0f); }
        LDS_BAR();
        { f32x4 o[4]; float ss = 0.f;
          const u32x4 w0 = *(const LAS u32x4*)(lds + GS_O + zc * 272 + zseg * 32), w1 = *(const LAS u32x4*)(lds + GS_O + zc * 272 + zseg * 32 + 16);
          unpack8(w0, o[0], o[1]); unpack8(w1, o[2], o[3]);
#pragma unroll
          for (int j = 0; j < 4; ++j) ss += (o[j].x * o[j].x + o[j].y * o[j].y) + (o[j].z * o[j].z + o[j].w * o[j].w);
          ss += sx<1>(ss); ss += sx<2>(ss); ss += sx<4>(ss);
          const float rn = frsq(ss * (1.f / 128.f) + RMS_EPS);
          f32x4 z[4]; unpack8(z0, z[0], z[1]); unpack8(z1, z[2], z[3]);
#pragma unroll
          for (int j = 0; j < 4; ++j) o[j] = o[j] * rn * nwv[j] * z[j];
          { u32x4 w8; w8.x = pack4_fp8(o[0].x * 16.f, o[0].y * 16.f, o[0].z * 16.f, o[0].w * 16.f); w8.y = pack4_fp8(o[1].x * 16.f, o[1].y * 16.f, o[1].z * 16.f, o[1].w * 16.f); w8.z = pack4_fp8(o[2].x * 16.f, o[2].y * 16.f, o[2].z * 16.f, o[2].w * 16.f); w8.w = pack4_fp8(o[3].x * 16.f, o[3].y * 16.f, o[3].z * 16.f, o[3].w * 16.f);
            *(u32x4*)((unsigned char*)OG + zrow * D + h * 128 + zseg * 16) = w8; } }
    };
    chunk(0);
#pragma unroll 1
    for (int n = 1; n < 8; ++n) chunk(n);
    { int l2 = l31, h2 = hh; asm volatile("" : "+v"(l2), "+v"(h2));
#pragma unroll
      for (int r = 0; r < 16; ++r) { const int dk = 8 * (r >> 2) + 4 * h2 + (r & 3); SC[(size_t)(64 * ct + dk) * 128 + 32 * vt + l2] = S0[r]; SC[(size_t)(64 * ct + 32 + dk) * 128 + 32 * vt + l2] = S1[r]; } }
    __syncthreads();
}


constexpr int NPH_G = 11, NPHASES = 1 + NG * NPH_G;
__global__ void __launch_bounds__(NTHR, 2) fwd(P p) {
    extern __shared__ __attribute__((aligned(16))) unsigned char lds_raw[];
    Ctx c; c.lds = (LAS unsigned char*)lds_raw; c.MISC = (volatile LAS unsigned*)(c.lds + MISC_OFF);
    c.tid = threadIdx.x; c.lane = c.tid & 63; c.wave = __builtin_amdgcn_readfirstlane(c.tid >> 6); c.G = gridDim.x; c.ws = p.ws;
    { const int bx = blockIdx.x; const int vcu = (c.G % 8 == 0) ? (bx % 8) * (c.G / 8) + bx / 8 : bx; c.gw = vcu * NWAVES + c.wave; c.NGW = c.G * NWAVES; }
    unsigned* ctl = (unsigned*)(p.ws + WS_CTL);
    if (c.tid < 16) c.MISC[c.tid] = 0u;
    __syncthreads();
#if MK_SINGLE
    XcdBarrier bar = xcd_barrier_post(ctl + CW_BAR, c.MISC, c.tid == 0);
#define SEAM(k) do { if (IN(k) && IN((k) + 1)) { FRESH(); xcd_barrier(bar, c.tid == 0); } } while (0)
#else
#define SEAM(k) do { } while (0)
#endif
#ifndef PHASE_MASK
#define PHASE_MASK 0xFFFF
#endif
#define IN(k) (p.ph_lo <= (k) && (k) < p.ph_hi)
#define ON(j) (((PHASE_MASK) >> (j)) & 1)
    const int bx = blockIdx.x;
#if defined(__HIP_DEVICE_COMPILE__)
    typedef const P __attribute__((address_space(4)))* KP;
    KP kp0 = (KP)__builtin_amdgcn_kernarg_segment_ptr();
#define PLOAD() KP kp_ = kp0; asm volatile("" : "+s"(kp_)); const P q = *kp_;
#else
#define PLOAD() const P q = p;
#endif
#define FRESH() do { c.lane = lane_fresh(); c.tid = c.wave * 64 + c.lane; } while (0)
    { AMP_BEGIN(11) if (ON(11) && IN(0)) { FRESH(); PLOAD(); phase_prep(q, c); __syncthreads(); FRESH(); stage_gb(c, q.in[I_ELG], q.in[I_ELB], (LAS float*)(c.lds + GB_EMB)); __syncthreads(); phase_ln0(q, c, 0, c.gw, c.NGW, GB_EMB); }
    SEAM(0); AMP_END(11) }
    for (int g = 0; g < NG; ++g) {
        const int pb = 1 + g * NPH_G;
        { AMP_BEGIN(1)
        if (ON(1) && IN(pb + 1)) { FRESH(); PLOAD();
#if G1_FP8
            SchedStd S; S.init(TOK, N1, D, c.G, bx, q.ws + WS_H0Q, q.ws + WS_WIN);
#else
            SchedStd S; S.init(TOK, N1, 2 * D, c.G, bx, q.ws + WS_H0, q.ws + WS_WIN);
#endif
            if (g == 0 && bx >= 256 - NHG) { meta_state(q, c, bx - (256 - NHG), c.lds); FRESH(); }
            EpiG1 E{(bf16_t*)(q.ws + WS_QKVG), (bf16_t*)(q.ws + WS_ZS), (bf16_t*)(q.ws + WS_QS), (bf16_t*)(q.ws + WS_KSF), (bf16_t*)(q.ws + WS_VSF), (bf16_t*)(q.ws + WS_SG), (bf16_t*)(q.ws + WS_SS), g, G1_FP8 ? W8_INV : 1.0f,
                    (float*)(q.ws + WS_BETA), (float*)(q.ws + WS_LOGG), q.in[I_ALOG], q.in[I_DTB]};
#if G1_FP8
            pg8::gemm_phase<EpiG1, SchedStd, true, true, true>(c.lds, D, S, E, c.wave);
#else
            pg8::gemm_phase<EpiG1, SchedStd, true, true>(c.lds, 2 * D, S, E, c.wave);
#endif
            if (bx >= 192) { FRESH(); const int base = MW_PRO + g * MW_TAIL; moe_convert(q, c, base + (bx - 192) * NWAVES + c.wave, 64 * NWAVES, base + MW_TAIL); }
        }
        SEAM(pb + 1); AMP_END(1) }
        { AMP_BEGIN(2)
        if (ON(2) && IN(pb + 2)) { FRESH(); PLOAD();
            { AMP_BEGIN(12) for (int bh = bx; bh < BATCH * NHG; bh += c.G) { { AMP_BEGIN(14) gdn_a_units(q, c, g, bh); AMP_END(14) }
                asm volatile("s_waitcnt vmcnt(0)" ::: "memory"); __syncthreads();
                FRESH(); gdn_scan_unit(q, c, g, bh); } AMP_END(12) }
            { AMP_BEGIN(13) for (int u = bx; u < BATCH * NHK * 4; u += c.G) { FRESH(); swa_unit(q, c, g, u); } AMP_END(13) }
        }
        SEAM(pb + 2); AMP_END(2) }
        { AMP_BEGIN(4)
        if (ON(4) && IN(pb + 4)) { FRESH(); PLOAD();
            EpiBr E{(const bf16_t*)(q.ws + WS_SG), (const bf16_t*)(q.ws + WS_SS), (bf16_t*)(q.ws + WS_Y), q.ws + WS_Y8};
            { SchedStd S; S.init(TOK, D, D, c.G, bx, q.ws + WS_OG, q.ws + WS_WBG); EpiBr0 E0{E, 1.0f / (16.0f * 64.0f)}; pg8::gemm_phase<EpiBr0, SchedStd, false, true, true>(c.lds, D, S, E0, c.wave); }
            FRESH(); __syncthreads();
            { SchedStd S; S.init(TOK, D, D, c.G, bx, q.ws + WS_OSW, q.ws + WS_WBS); EpiBr1 E1{E, 1.0f / (16.0f * 64.0f)}; pg8::gemm_phase<EpiBr1, SchedStd, false, true, true>(c.lds, D, S, E1, c.wave); }
        }
        SEAM(pb + 4); AMP_END(4) }
        { AMP_BEGIN(5)
        if (ON(5) && IN(pb + 5)) { FRESH(); PLOAD();
            SchedStd S; S.init(TOK, D, D, c.G, bx, q.ws + WS_Y8, q.ws + WS_WOUT);
            EpiOut E{(const bf16_t*)(q.ws + WS_H0), (bf16_t*)(q.ws + WS_PRE1), 1.0f / (16.0f * 64.0f)};
            pg8::gemm_phase<EpiOut, SchedStd, false, true, true>(c.lds, D, S, E, c.wave);
        }
        SEAM(pb + 5); AMP_END(5) }
        { AMP_BEGIN(6)
        if (ON(6) && IN(pb + 6)) { FRESH(); PLOAD(); phase_ln1_router(q, c, g, g + 1 < NG ? g + 1 : -1); }
        SEAM(pb + 6); AMP_END(6) }
        if ((g % NP) == NP - 1) {
        const int pr = g / NP;
        { AMP_BEGIN(8)
        if (ON(8) && IN(pb + 8)) { FRESH(); PLOAD();
            const int ntiles = moe_tables(c, pr);
            LAS unsigned short* tokt = (LAS unsigned short*)(c.lds + RING_BYTES);
            const int* RTOK = (const int*)(q.ws + WS_RTOK); const int nwg_ = ntiles * 8;
#pragma unroll 1
            for (int win = 0; win < 2; ++win) {
                { int tv[9];
#pragma unroll
                  for (int k = 0; k < 9; ++k) { const int it = c.tid + NTHR * k, i = it >> 8, R = it & 255, L = (i + 17 * win) * c.G + bx; tv[k] = 0;
                      if (i < 17 && L < nwg_) { const int rt = xcd_chunk(L, nwg_) >> 3, e = (int)((volatile LAS unsigned char*)(c.MISC + MI_TE))[rt]; const unsigned pos = (unsigned)(rt * 256 + R) - c.MISC[MI_OFF + e];
                          if (pos < c.MISC[MI_CNT + e]) tv[k] = RTOK[(size_t)e * TOKP + pos]; } }
#pragma unroll
                  for (int k = 0; k < 9; ++k) { const int it = c.tid + NTHR * k, i = it >> 8, L = (i + 17 * win) * c.G + bx; if (i < 17 && L < nwg_) tokt[it] = (unsigned short)tv[k]; } }
                __syncthreads();
                SchedMoeG S; S.init(ntiles, 2 * DFF, D, c.G, bx, q.ws + WS_H1Q, q.ws + WS_W1, c.MISC + MI_TE); S.tokt = tokt; S.i0 = 17 * win; S.ni = 17;
                EpiMoe1 E{q.in[I_B1], q.ws + WS_HID};
                pg8::gemm_phase<EpiMoe1, SchedMoeG, true, true, true, true>(c.lds, D, S, E, c.wave);
                FRESH(); __syncthreads(); }
        }
        SEAM(pb + 8); AMP_END(8) }
        { AMP_BEGIN(9)
        if (ON(9) && IN(pb + 9)) { FRESH(); PLOAD();
            const int ntiles = (int)(c.MISC[MI_OFF + NEXP] >> 8);
            SchedMoe S; S.init(ntiles, D, DFF, c.G, bx, q.ws + WS_HID, q.ws + WS_W2, c.MISC + MI_TE);
            EpiMoe2 E{q.in[I_B2], (const float*)(q.ws + WS_RWW), q.ws + WS_YS, c.MISC};
            pg8::gemm_phase<EpiMoe2, SchedMoe, true, true, true>(c.lds, DFF, S, E, c.wave);
        }
        SEAM(pb + 9); AMP_END(9) }
        { AMP_BEGIN(10)
        if (ON(10) && IN(pb + 10)) { FRESH(); PLOAD(); stage_gb(c, q.in[I_L2G], q.in[I_L2B], (LAS float*)(c.lds + GB_LN2)); __syncthreads();
            phase_combine(q, c, pr); }
        SEAM(pb + 10); AMP_END(10) }
        }
    }
#if defined(EXTRA_BARRIERS) && MK_SINGLE
    for (int xb = 0; xb < EXTRA_BARRIERS; ++xb) { FRESH(); xcd_barrier(bar, c.tid == 0); }
#endif
#undef IN
#undef PLOAD
#undef FRESH
#undef SEAM
}

extern "C" void kernel_launch(void* const* d_in, const int* in_sizes, int n_in, void* d_out, int out_size, void* d_ws, size_t ws_size, hipStream_t stream) {
    static int grid = 0;
    if (grid == 0) {
        if (n_in != 23 || in_sizes[0] != BATCH * SEQ * D || out_size != BATCH * SEQ * D || ws_size < WS_END) {
            fprintf(stderr, "kernel_launch: unexpected shapes (n_in %d, in0 %d, out %d, ws %zu, need %zu); nothing launched\n", n_in, n_in > 0 ? in_sizes[0] : -1, out_size, ws_size, (size_t)WS_END); grid = -1; return; }
        int dev = 0, cus = 0;
        if (hipGetDevice(&dev) != hipSuccess || hipDeviceGetAttribute(&cus, hipDeviceAttributeMultiprocessorCount, dev) != hipSuccess) { grid = -1; return; }
        if (hipFuncSetAttribute((const void*)fwd, hipFuncAttributeMaxDynamicSharedMemorySize, LDS_BYTES) != hipSuccess) { fprintf(stderr, "kernel_launch: hipFuncSetAttribute failed\n"); grid = -1; return; }
        int per_cu = 0; (void)hipOccupancyMaxActiveBlocksPerMultiprocessor(&per_cu, (const void*)fwd, NTHR, LDS_BYTES); (void)hipGetLastError();
        if (cus != 256) { fprintf(stderr, "kernel_launch: built for a 256-CU device (one workgroup per CU, 64 token rows of a slice per workgroup in the router phase); found %d CUs; nothing launched\n", cus); grid = -1; return; }
        grid = cus;
    }
    if (grid < 0) return;
    if (hipMemsetAsync((char*)d_ws + WS_CTL, 0, CTL_ZERO_BYTES, stream) != hipSuccess) return;
    P a{};
    for (int i = 0; i < 23; ++i) a.in[i] = (const float*)d_in[i];
    a.out = (float*)d_out; a.ws = (unsigned char*)d_ws;
#if MK_SINGLE
    a.ph_lo = 0; a.ph_hi = NPHASES;
    hipLaunchKernelGGL(fwd, dim3(grid), dim3(NTHR), LDS_BYTES, stream, a);
#else
    for (int ph = 0; ph < NPHASES; ++ph) { a.ph_lo = ph; a.ph_hi = ph + 1; hipLaunchKernelGGL(fwd, dim3(grid), dim3(NTHR), LDS_BYTES, stream, a); }
#endif
}
```
